# Optimizing an MI355X kernel written in HIP

```python
import jax, jax.numpy as jnp
from jax import lax
import numpy as np

D_MODEL = 1024
BATCH = 8
SEQ = 4096
DEPTH = 1

RWKV_HEAD_DIM = 64
RWKV_DIM = D_MODEL // 2
RWKV_HEADS = RWKV_DIM // RWKV_HEAD_DIM
DECAY_RANK = 64
ICLR_RANK = 64
GATE_RANK = 128
GN_EPS = 64e-5
ATTN_HEAD_DIM = 64
ATTN_DIM = D_MODEL // 2
ATTN_HEADS = ATTN_DIM // ATTN_HEAD_DIM
MOBA_BLOCK = 256
MOBA_TOPK = 3
Q_BLOCK = 128
ROPE_THETA = 500000.0
ROPE_DIM = ATTN_HEAD_DIM // 4
NEG_INF = -1e30
N_BRANCHES = 2
N_EXPERTS = 32
TOP_K = 4
D_EXPERT = D_MODEL
SWIGLU_LIMIT = 7.0
SWIGLU_ALPHA = 1.702
EXPERT_ROW_BLOCK = 128
DEEPNORM_ALPHA = (2.0 * DEPTH) ** 0.25
DEEPNORM_BETA = (8.0 * DEPTH) ** -0.25
LN_EPS = 1e-5
RWKV_COLS = 3 * RWKV_DIM + DECAY_RANK + ICLR_RANK + GATE_RANK
ATTN_COLS = 3 * ATTN_DIM
GATE_COLS = N_BRANCHES * D_MODEL
IN_COLS = RWKV_COLS + ATTN_COLS + GATE_COLS
RWKV_SPLITS = (RWKV_DIM, 2 * RWKV_DIM, 3 * RWKV_DIM, 3 * RWKV_DIM + DECAY_RANK, 3 * RWKV_DIM + DECAY_RANK + ICLR_RANK)

kernel_name = 'rwkv7_moba_gated_hybrid_moe_block'


def layer_norm(x, g, b):
    xf = x.astype(jnp.float32)
    mu = jnp.mean(xf, axis=-1, keepdims=True)
    var = jnp.mean(jnp.square(xf - mu), axis=-1, keepdims=True)
    return ((xf - mu) * lax.rsqrt(var + LN_EPS) * g + b).astype(x.dtype)


def rwkv7_time_mix(p, shift_mix, decay_w0, decay_up, iclr_a0, iclr_up, gate_up, k_k, k_a, r_k, gn_g, gn_b):
    B, T, _ = p.shape
    H, N = RWKV_HEADS, RWKV_HEAD_DIM
    prev = jnp.pad(p[:, :-1], ((0, 0), (1, 0), (0, 0)))
    p = p + (prev - p) * shift_mix
    r, k, v, xw, xa, xg = jnp.split(p, RWKV_SPLITS, axis=-1)
    w_raw = (decay_w0 + jnp.tanh(xw) @ decay_up).astype(jnp.float32)
    decay = jnp.exp(-jnp.exp(-jax.nn.softplus(-w_raw) - 0.5))
    a = jax.nn.sigmoid(iclr_a0 + xa @ iclr_up)
    g = jax.nn.sigmoid(xg) @ gate_up
    kk = (k * k_k).reshape(B, T, H, N).astype(jnp.float32)
    kk = kk / jnp.maximum(jnp.linalg.norm(kk, axis=-1, keepdims=True), 1e-12)
    k = k * (1.0 + (a - 1.0) * k_a)

    def heads(t):
        return t.reshape(B, T, H, N).astype(jnp.float32)

    r_h, k_h, v_h, w_h, a_h = heads(r), heads(k), heads(v), heads(decay), heads(a)

    def step(S, inp):
        r_t, w_t, k_t, v_t, kk_t, a_t = inp
        sa = jnp.einsum('bhvk,bhk->bhv', S, -kk_t)
        S = (S * w_t[:, :, None, :]
             + sa[..., None] * (kk_t * a_t)[:, :, None, :]
             + v_t[..., None] * k_t[:, :, None, :])
        return S, jnp.einsum('bhvk,bhk->bhv', S, r_t)

    xs = tuple(jnp.moveaxis(t, 1, 0) for t in (r_h, w_h, k_h, v_h, kk, a_h))
    S0 = jnp.zeros((B, H, N, N), jnp.float32)
    _, ys = lax.scan(step, S0, xs)
    y = jnp.moveaxis(ys, 0, 1)
    mu = jnp.mean(y, axis=-1, keepdims=True)
    var = jnp.mean(jnp.square(y - mu), axis=-1, keepdims=True)
    y = ((y - mu) * lax.rsqrt(var + GN_EPS)).reshape(B, T, RWKV_DIM) * gn_g + gn_b
    bonus = jnp.sum(r_h * k_h * r_k, axis=-1, keepdims=True) * v_h
    y = y + bonus.reshape(B, T, RWKV_DIM)
    return (y * g).astype(p.dtype)


def partial_rope(t, pos):
    half = ROPE_DIM // 2
    inv_freq = jnp.power(ROPE_THETA, -jnp.arange(0, ROPE_DIM, 2, dtype=jnp.float32) / ROPE_DIM)
    ang = pos.astype(jnp.float32)[:, None] * inv_freq[None, :]
    cos = jnp.cos(ang)[None, :, None, :]
    sin = jnp.sin(ang)[None, :, None, :]
    tf = t[..., :ROPE_DIM].astype(jnp.float32)
    x1, x2 = tf[..., :half], tf[..., half:]
    rot = jnp.concatenate([x1 * cos - x2 * sin, x2 * cos + x1 * sin], axis=-1).astype(t.dtype)
    return jnp.concatenate([rot, t[..., ROPE_DIM:]], axis=-1)


def moba_attention(q, k, v):
    B, T, H, Dh = q.shape
    n_kblk = -(-T // MOBA_BLOCK)
    n_qblk = T // Q_BLOCK
    topk = min(MOBA_TOPK, n_kblk)
    pad = n_kblk * MOBA_BLOCK - T

    def to_blocks(t):
        t = jnp.pad(t, ((0, 0), (0, pad), (0, 0), (0, 0)))
        return t.reshape(B, n_kblk, MOBA_BLOCK, H, Dh).transpose(0, 3, 1, 2, 4)

    k_blocks = to_blocks(k)
    v_blocks = to_blocks(v)
    k_mean = jnp.mean(k_blocks.astype(jnp.float32), axis=3)
    q_blocks = q.reshape(B, n_qblk, Q_BLOCK, H, Dh).transpose(0, 1, 3, 2, 4).reshape(B * n_qblk, H, Q_BLOCK, Dh)
    b_ids = jnp.repeat(jnp.arange(B, dtype=jnp.int32), n_qblk)
    qb_ids = jnp.tile(jnp.arange(n_qblk, dtype=jnp.int32), B)
    scale = Dh ** -0.5
    head_ids = jnp.arange(H)[:, None, None]
    blk_ids = jnp.arange(n_kblk)

    def one_block(args):
        q_blk, b, qb = args
        kb, vb, km = k_blocks[b], v_blocks[b], k_mean[b]
        q_start = qb * Q_BLOCK
        own = q_start // MOBA_BLOCK
        gate = jnp.einsum('hqd,hnd->hqn', q_blk.astype(jnp.float32), km)
        gate = jnp.where(blk_ids < own, gate, NEG_INF)
        _, sel = lax.top_k(gate, topk)
        sel_valid = sel < own
        kg = kb[head_ids, sel]
        vg = vb[head_ids, sel]
        s_sel = jnp.einsum('hqd,hqnkd->hqnk', q_blk, kg, preferred_element_type=jnp.float32) * scale
        s_sel = jnp.where(sel_valid[..., None], s_sel, NEG_INF).reshape(H, Q_BLOCK, topk * MOBA_BLOCK)
        ko = lax.dynamic_index_in_dim(kb, own, axis=1, keepdims=False)
        vo = lax.dynamic_index_in_dim(vb, own, axis=1, keepdims=False)
        s_own = jnp.einsum('hqd,hkd->hqk', q_blk, ko, preferred_element_type=jnp.float32) * scale
        q_pos = q_start + jnp.arange(Q_BLOCK)
        k_pos = own * MOBA_BLOCK + jnp.arange(MOBA_BLOCK)
        s_own = jnp.where(k_pos[None, None, :] <= q_pos[None, :, None], s_own, NEG_INF)
        probs = jax.nn.softmax(jnp.concatenate([s_sel, s_own], axis=-1), axis=-1)
        p_sel = probs[..., :topk * MOBA_BLOCK].reshape(H, Q_BLOCK, topk, MOBA_BLOCK).astype(vb.dtype)
        p_own = probs[..., topk * MOBA_BLOCK:].astype(vb.dtype)
        return jnp.einsum('hqnk,hqnkd->hqd', p_sel, vg) + jnp.einsum('hqk,hkd->hqd', p_own, vo)

    out = lax.map(one_block, (q_blocks, b_ids, qb_ids))
    return out.reshape(B, n_qblk, H, Q_BLOCK, Dh).transpose(0, 1, 3, 2, 4).reshape(B, T, H * Dh)


def token_mixer(x, w_in, shift_mix, decay_w0, decay_up, iclr_a0, iclr_up, gate_up, k_k, k_a, r_k,
                gn_g, gn_b, w_branch_rwkv, w_branch_attn, w_out):
    B, T, _ = x.shape
    proj = jnp.einsum('btd,dc->btc', x, w_in)
    p_rwkv = proj[..., :RWKV_COLS]
    p_attn = proj[..., RWKV_COLS:RWKV_COLS + ATTN_COLS]
    p_gate = proj[..., RWKV_COLS + ATTN_COLS:]
    y_rwkv = rwkv7_time_mix(p_rwkv, shift_mix, decay_w0, decay_up, iclr_a0, iclr_up, gate_up,
                            k_k, k_a, r_k, gn_g, gn_b) @ w_branch_rwkv
    q, k, v = jnp.split(p_attn, 3, axis=-1)
    q, k, v = (t.reshape(B, T, ATTN_HEADS, ATTN_HEAD_DIM) for t in (q, k, v))
    pos = jnp.arange(T)
    q, k = partial_rope(q, pos), partial_rope(k, pos)
    y_attn = moba_attention(q, k, v) @ w_branch_attn
    gates = jax.nn.sigmoid(p_gate).reshape(B, T, N_BRANCHES, D_MODEL)
    merged = gates[:, :, 0] * y_rwkv + gates[:, :, 1] * y_attn
    return merged @ w_out


def moe_ffn(x, router_w, router_b, expert_w_in, expert_b_in, expert_w_out, expert_b_out):
    B, T, D = x.shape
    xf = x.reshape(B * T, D)
    n_tok = B * T
    logits = (xf @ router_w + router_b).astype(jnp.float32)
    top_val, top_idx = lax.top_k(logits, TOP_K)
    weights = jax.nn.softmax(top_val, axis=-1)
    n_assign = n_tok * TOP_K
    flat_e = top_idx.reshape(-1)
    flat_tok = jnp.repeat(jnp.arange(n_tok, dtype=jnp.int32), TOP_K)
    flat_w = weights.reshape(-1)
    order = jnp.argsort(flat_e)
    sorted_e, sorted_tok, sorted_w = flat_e[order], flat_tok[order], flat_w[order]
    counts = jnp.bincount(flat_e, length=N_EXPERTS)
    starts = jnp.cumsum(counts) - counts
    padded = (counts + EXPERT_ROW_BLOCK - 1) // EXPERT_ROW_BLOCK * EXPERT_ROW_BLOCK
    p_ends = jnp.cumsum(padded)
    p_starts = p_ends - padded
    dest = p_starts[sorted_e] + jnp.arange(n_assign) - starts[sorted_e]
    n_rblk = -(-n_assign // EXPERT_ROW_BLOCK) + N_EXPERTS
    n_rows = n_rblk * EXPERT_ROW_BLOCK
    row_tok = jnp.zeros((n_rows,), jnp.int32).at[dest].set(sorted_tok)
    row_w = jnp.zeros((n_rows,), jnp.float32).at[dest].set(sorted_w)
    blk_start = jnp.arange(n_rblk) * EXPERT_ROW_BLOCK
    blk_e = jnp.minimum(jnp.sum(blk_start[:, None] >= p_ends[None, :], axis=1), N_EXPERTS - 1)

    def expert_block(args):
        toks, e = args
        h = xf[toks] @ expert_w_in[e] + expert_b_in[e]
        gate_h = jnp.minimum(h[:, :D_EXPERT], SWIGLU_LIMIT)
        lin_h = jnp.clip(h[:, D_EXPERT:], -SWIGLU_LIMIT, SWIGLU_LIMIT)
        act = gate_h * jax.nn.sigmoid(SWIGLU_ALPHA * gate_h) * (lin_h + 1.0)
        return act @ expert_w_out[e] + expert_b_out[e]

    ys = lax.map(expert_block, (row_tok.reshape(n_rblk, EXPERT_ROW_BLOCK), blk_e)).reshape(n_rows, D)
    out = jax.ops.segment_sum(ys * row_w[:, None].astype(ys.dtype), row_tok, num_segments=n_tok)
    return out.reshape(B, T, D).astype(x.dtype)


def setup_inputs(seed: int = 0) -> dict:
    key = jax.random.key(seed)
    ks = jax.random.split(key, 26)
    L, D, E, F = DEPTH, D_MODEL, N_EXPERTS, D_EXPERT
    nrm = lambda k, shape, s: jax.random.normal(k, shape, jnp.float32) * s
    return {
        'x': jax.random.normal(ks[0], (BATCH, SEQ, D), jnp.float32),
        'ln1_g': 1.0 + nrm(ks[1], (L, D), 0.01),
        'ln1_b': nrm(ks[2], (L, D), 0.01),
        'ln2_g': 1.0 + nrm(ks[3], (L, D), 0.01),
        'ln2_b': nrm(ks[4], (L, D), 0.01),
        'w_in': nrm(ks[5], (L, D, IN_COLS), D ** -0.5),
        'shift_mix': jax.random.uniform(ks[6], (L, RWKV_COLS), jnp.float32),
        'decay_w0': jax.random.uniform(ks[7], (L, RWKV_DIM), jnp.float32, -6.5, -1.5),
        'decay_up': nrm(ks[8], (L, DECAY_RANK, RWKV_DIM), 0.1 * DECAY_RANK ** -0.5),
        'iclr_a0': nrm(ks[9], (L, RWKV_DIM), 0.1),
        'iclr_up': nrm(ks[10], (L, ICLR_RANK, RWKV_DIM), 0.1 * ICLR_RANK ** -0.5),
        'gate_up': nrm(ks[11], (L, GATE_RANK, RWKV_DIM), GATE_RANK ** -0.5),
        'k_k': 0.85 + nrm(ks[12], (L, RWKV_DIM), 0.05),
        'k_a': 1.0 + nrm(ks[13], (L, RWKV_DIM), 0.05),
        'r_k': nrm(ks[14], (L, RWKV_HEADS, RWKV_HEAD_DIM), 0.1),
        'gn_g': 1.0 + nrm(ks[15], (L, RWKV_DIM), 0.01),
        'gn_b': nrm(ks[16], (L, RWKV_DIM), 0.01),
        'w_branch_rwkv': nrm(ks[17], (L, RWKV_DIM, D), RWKV_DIM ** -0.5),
        'w_branch_attn': nrm(ks[18], (L, ATTN_DIM, D), ATTN_DIM ** -0.5),
        'w_out': nrm(ks[19], (L, D, D), DEEPNORM_BETA * D ** -0.5),
        'router_w': nrm(ks[20], (L, D, E), D ** -0.5),
        'router_b': nrm(ks[21], (L, E), 0.01),
        'expert_w_in': nrm(ks[22], (L, E, D, 2 * F), D ** -0.5),
        'expert_b_in': nrm(ks[23], (L, E, 2 * F), 0.01),
        'expert_w_out': nrm(ks[24], (L, E, F, D), DEEPNORM_BETA * F ** -0.5),
        'expert_b_out': nrm(ks[25], (L, E, D), 0.01),
    }


def reference(x, ln1_g, ln1_b, ln2_g, ln2_b, w_in, shift_mix, decay_w0, decay_up, iclr_a0, iclr_up,
              gate_up, k_k, k_a, r_k, gn_g, gn_b, w_branch_rwkv, w_branch_attn, w_out,
              router_w, router_b, expert_w_in, expert_b_in, expert_w_out, expert_b_out):
    for i in range(DEPTH):
        mix = token_mixer(x, w_in[i], shift_mix[i], decay_w0[i], decay_up[i], iclr_a0[i], iclr_up[i],
                          gate_up[i], k_k[i], k_a[i], r_k[i], gn_g[i], gn_b[i],
                          w_branch_rwkv[i], w_branch_attn[i], w_out[i])
        x = layer_norm(DEEPNORM_ALPHA * x + mix, ln1_g[i], ln1_b[i])
        ffn = moe_ffn(x, router_w[i], router_b[i], expert_w_in[i], expert_b_in[i],
                      expert_w_out[i], expert_b_out[i])
        x = layer_norm(DEEPNORM_ALPHA * x + ffn, ln2_g[i], ln2_b[i])
    return x
```

```cpp
#include <hip/hip_runtime.h>
#include <hip/hip_cooperative_groups.h>
#include <cstdio>
#include <cstdint>
namespace cg = cooperative_groups;

namespace pg8 {
#define PG8_LAS __attribute__((address_space(3)))
typedef unsigned short bf16_t;
typedef short bf16x8 __attribute__((ext_vector_type(8)));
typedef float f32x4 __attribute__((ext_vector_type(4)));
typedef float f32x2 __attribute__((ext_vector_type(2)));
typedef unsigned u32x4 __attribute__((ext_vector_type(4)));
typedef unsigned u32x2 __attribute__((ext_vector_type(2)));
constexpr int BM = 256, BK = 64, HALF = 128, HTB = HALF * BK * 2  , STAGE_BYTES = 8 * HTB, NXCD = 8, WGM = 8;

__host__ __device__ __forceinline__ int lds_byte(int r, int c) { const int st = (r >> 4) * 2 + (c >> 5), rr = r & 15, cc = c & 31, ob = rr * 64 + cc * 2; return st * 1024 + (ob ^ (((ob >> 9) & 1) << 5)); }
__host__ __device__ __forceinline__ void stage_rc(int b, int& R, int& C) { const int st = b / 1024, sb = b % 1024, swz = sb ^ (((sb >> 9) & 1) << 5); R = (st >> 1) * 16 + swz / 64; C = (st & 1) * 32 + (swz % 64) / 2; }
__host__ __device__ __forceinline__ int perm32(int rho) { const int n = rho >> 4, i = rho & 15; return 8 * (i >> 2) + 4 * n + (i & 3); }

struct Unit { int pm, pn, aux; const char* A; const char* B; };

struct DenseOrder {
    int nM, nN, nwg, G, c; const char* A; const char* B; size_t tstep;
    __device__ __forceinline__ void init(int M, int N, int K, int G_, int c_, const void* A_, const void* B_) { nM = M / BM; nN = N / BM; nwg = nM * nN; G = G_; c = c_; A = (const char*)A_; B = (const char*)B_; tstep = (size_t)BM * K * 2; }
    __device__ __forceinline__ bool next(int i, Unit& u) const {
        const long L = (long)i * G + c; if (L >= nwg) return false;
        int wgid = (int)L; { const int q = nwg / NXCD, r = nwg % NXCD, xcd = wgid % NXCD, off = wgid / NXCD; wgid = (xcd < r ? xcd * (q + 1) : r * (q + 1) + (xcd - r) * q) + off; }
        const int nig = WGM * nN, gid = wgid / nig, fm = gid * WGM, gsz = (nM - fm) < WGM ? (nM - fm) : WGM;
        u.pm = fm + ((wgid % nig) % gsz); u.pn = (wgid % nig) / gsz; u.aux = 0;
        u.A = A + (size_t)u.pm * tstep; u.B = B + (size_t)u.pn * tstep; return true;
    }
    __device__ __forceinline__ void a_ready(const Unit&) const {}
    __device__ __forceinline__ void done(const Unit&) const {}
};
struct MoeOrder {
    const int* tile_e; int ntiles, npn, G, c; const char* A; const char* B; size_t tstep, estride;
    __device__ __forceinline__ bool next(int i, Unit& u) const {
        const long L = (long)i * G + c; if (L >= (long)ntiles * npn) return false;
        const int tile = (int)(L / npn), pn = (int)(L % npn); const int e = tile_e[tile];
        u.pm = tile; u.pn = pn; u.aux = e; u.A = A + (size_t)tile * tstep; u.B = B + (size_t)e * estride + (size_t)pn * tstep; return true;
    }
    __device__ __forceinline__ void a_ready(const Unit&) const {}
    __device__ __forceinline__ void done(const Unit&) const {}
};

__device__ __forceinline__ unsigned cvt_pk_bf16(float lo, float hi) { unsigned r; asm volatile("v_cvt_pk_bf16_f32 %0, %1, %2" : "=v"(r) : "v"(lo), "v"(hi)); return r; }
__device__ __forceinline__ float bf_lo(unsigned w) { return __builtin_bit_cast(float, w << 16); }
__device__ __forceinline__ float bf_hi(unsigned w) { return __builtin_bit_cast(float, w & 0xffff0000u); }
__device__ __forceinline__ float sigm(float x) { return 1.0f / (1.0f + __expf(-x)); }

__device__ __forceinline__ void st8(bf16_t* p, f32x4 v0, f32x4 v1) { u32x4 w; w.x = cvt_pk_bf16(v0[0], v0[1]); w.y = cvt_pk_bf16(v0[2], v0[3]); w.z = cvt_pk_bf16(v1[0], v1[1]); w.w = cvt_pk_bf16(v1[2], v1[3]); *(u32x4*)p = w; }

struct EpiPlainBf16 {
    static constexpr bool PERM = true, AFTER_DRAIN = false;
    bf16_t* O; int ldc;
    __device__ __forceinline__ void operator()(const f32x4 (&acc)[2][2][4][2], const Unit& u, int wr, int wc, int fr, int fq) const {
        const int row0 = u.pm * BM + wr * 64 + fr, col0 = u.pn * BM + wc * 32 + 8 * fq;
#pragma unroll
        for (int ai = 0; ai < 2; ++ai)
#pragma unroll
            for (int m = 0; m < 4; ++m) { bf16_t* rowp = O + (size_t)(row0 + ai * HALF + m * 16) * ldc + col0;
#pragma unroll
                for (int bj = 0; bj < 2; ++bj) st8(rowp + bj * HALF, acc[ai][bj][m][0], acc[ai][bj][m][1]); }
    }
};
struct EpiInProj {
    static constexpr bool PERM = true, AFTER_DRAIN = false;
    bf16_t *rkv, *lr, *q, *k, *v, *g;
    __device__ __forceinline__ void operator()(const f32x4 (&acc)[2][2][4][2], const Unit& u, int wr, int wc, int fr, int fq) const {
        const int pn = u.pn; bf16_t* base; int ldc, colt;
        if (pn < 6) { base = rkv; ldc = 1536; colt = pn * 256; } else if (pn == 6) { base = lr; ldc = 256; colt = 0; }
        else if (pn < 9) { base = q; ldc = 512; colt = (pn - 7) * 256; } else if (pn < 11) { base = k; ldc = 512; colt = (pn - 9) * 256; }
        else if (pn < 13) { base = v; ldc = 512; colt = (pn - 11) * 256; } else { base = g; ldc = 2048; colt = (pn - 13) * 256; }
        const int row0 = u.pm * BM + wr * 64 + fr, col0 = colt + wc * 32 + 8 * fq;
#pragma unroll
        for (int ai = 0; ai < 2; ++ai)
#pragma unroll
            for (int m = 0; m < 4; ++m) { bf16_t* rowp = base + (size_t)(row0 + ai * HALF + m * 16) * ldc + col0;
#pragma unroll
                for (int bj = 0; bj < 2; ++bj) st8(rowp + bj * HALF, acc[ai][bj][m][0], acc[ai][bj][m][1]); }
    }
};
struct EpiGateF32 {
    static constexpr bool PERM = true, AFTER_DRAIN = false;
    float* T; const bf16_t* G; int goff;
    __device__ __forceinline__ void operator()(const f32x4 (&acc)[2][2][4][2], const Unit& u, int wr, int wc, int fr, int fq) const {
        const int row0 = u.pm * BM + wr * 64 + fr, col0 = u.pn * BM + wc * 32 + 8 * fq;
#pragma unroll
        for (int ai = 0; ai < 2; ++ai)
#pragma unroll
            for (int m = 0; m < 4; ++m) { const size_t row = (size_t)(row0 + ai * HALF + m * 16);
#pragma unroll
                for (int bj = 0; bj < 2; ++bj) { const int col = col0 + bj * HALF; const u32x4 gw = *(const u32x4*)(G + row * 2048 + goff + col);
                    f32x4 a = acc[ai][bj][m][0], b = acc[ai][bj][m][1];
                    a[0] *= sigm(bf_lo(gw.x)); a[1] *= sigm(bf_hi(gw.x)); a[2] *= sigm(bf_lo(gw.y)); a[3] *= sigm(bf_hi(gw.y));
                    b[0] *= sigm(bf_lo(gw.z)); b[1] *= sigm(bf_hi(gw.z)); b[2] *= sigm(bf_lo(gw.w)); b[3] *= sigm(bf_hi(gw.w));
                    *(f32x4*)(T + row * 1024 + col) = a; *(f32x4*)(T + row * 1024 + col + 4) = b; } }
    }
};
struct EpiGateAddBf16 {
    static constexpr bool PERM = true, AFTER_DRAIN = false;
    const float* T; const bf16_t* G; int goff; bf16_t* O;
    __device__ __forceinline__ void operator()(const f32x4 (&acc)[2][2][4][2], const Unit& u, int wr, int wc, int fr, int fq) const {
        const int row0 = u.pm * BM + wr * 64 + fr, col0 = u.pn * BM + wc * 32 + 8 * fq;
#pragma unroll
        for (int ai = 0; ai < 2; ++ai)
#pragma unroll
            for (int m = 0; m < 4; ++m) { const size_t row = (size_t)(row0 + ai * HALF + m * 16);
#pragma unroll
                for (int bj = 0; bj < 2; ++bj) { const int col = col0 + bj * HALF; const u32x4 gw = *(const u32x4*)(G + row * 2048 + goff + col);
                    f32x4 a = acc[ai][bj][m][0], b = acc[ai][bj][m][1]; const f32x4 ta = *(const f32x4*)(T + row * 1024 + col), tb = *(const f32x4*)(T + row * 1024 + col + 4);
                    a[0] = ta[0] + a[0] * sigm(bf_lo(gw.x)); a[1] = ta[1] + a[1] * sigm(bf_hi(gw.x)); a[2] = ta[2] + a[2] * sigm(bf_lo(gw.y)); a[3] = ta[3] + a[3] * sigm(bf_hi(gw.y));
                    b[0] = tb[0] + b[0] * sigm(bf_lo(gw.z)); b[1] = tb[1] + b[1] * sigm(bf_hi(gw.z)); b[2] = tb[2] + b[2] * sigm(bf_lo(gw.w)); b[3] = tb[3] + b[3] * sigm(bf_hi(gw.w));
                    st8(O + row * 1024 + col, a, b); } }
    }
};
struct EpiResF32 {
    static constexpr bool PERM = false, AFTER_DRAIN = false;
    float* C; const float* X; float alpha;
    __device__ __forceinline__ void operator()(const f32x4 (&acc)[2][2][4][2], const Unit& u, int wr, int wc, int fr, int fq) const {
        const int row0 = u.pm * BM + wr * 64 + fr, col0 = u.pn * BM + wc * 32 + 4 * fq;
#pragma unroll
        for (int ai = 0; ai < 2; ++ai)
#pragma unroll
            for (int m = 0; m < 4; ++m) { const size_t off = (size_t)(row0 + ai * HALF + m * 16) * 1024 + col0;
#pragma unroll
                for (int bj = 0; bj < 2; ++bj)
#pragma unroll
                    for (int n = 0; n < 2; ++n) { const f32x4 xv = *(const f32x4*)(X + off + bj * HALF + n * 16); *(f32x4*)(C + off + bj * HALF + n * 16) = acc[ai][bj][m][n] + xv * alpha; } }
    }
};
struct EpiSwiglu {
    static constexpr bool PERM = true, AFTER_DRAIN = false;
    bf16_t* O; const float* bin;
    __device__ __forceinline__ void operator()(const f32x4 (&acc)[2][2][4][2], const Unit& u, int wr, int wc, int fr, int fq) const {
        const int row0 = u.pm * BM + wr * 64 + fr, c0 = u.pn * HALF + wc * 32 + 8 * fq; const float* bb = bin + (size_t)u.aux * 2048 + c0;
        const f32x4 bg0 = *(const f32x4*)(bb), bg1 = *(const f32x4*)(bb + 4), bl0 = *(const f32x4*)(bb + 1024), bl1 = *(const f32x4*)(bb + 1028);
#pragma unroll
        for (int ai = 0; ai < 2; ++ai)
#pragma unroll
            for (int m = 0; m < 4; ++m) { const size_t row = (size_t)(row0 + ai * HALF + m * 16);
                f32x4 o0, o1; const f32x4 g0 = acc[ai][0][m][0] + bg0, g1 = acc[ai][0][m][1] + bg1, l0 = acc[ai][1][m][0] + bl0, l1 = acc[ai][1][m][1] + bl1;
#pragma unroll
                for (int j = 0; j < 4; ++j) { const float ga = fminf(g0[j], 7.0f), la = fminf(fmaxf(l0[j], -7.0f), 7.0f); o0[j] = ga * sigm(1.702f * ga) * (la + 1.0f);
                                              const float gb = fminf(g1[j], 7.0f), lb = fminf(fmaxf(l1[j], -7.0f), 7.0f); o1[j] = gb * sigm(1.702f * gb) * (lb + 1.0f); }
                st8(O + row * 1024 + c0, o0, o1); }
    }
};
struct EpiMoe2 {
    static constexpr bool PERM = true, AFTER_DRAIN = false;
    bf16_t* O; const float* bout; const float* roww;
    __device__ __forceinline__ void operator()(const f32x4 (&acc)[2][2][4][2], const Unit& u, int wr, int wc, int fr, int fq) const {
        const int row0 = u.pm * BM + wr * 64 + fr, col0 = u.pn * BM + wc * 32 + 8 * fq; const float* bb = bout + (size_t)u.aux * 1024 + col0;
        f32x4 bv[2][2];
#pragma unroll
        for (int bj = 0; bj < 2; ++bj) { bv[bj][0] = *(const f32x4*)(bb + bj * HALF); bv[bj][1] = *(const f32x4*)(bb + bj * HALF + 4); }
#pragma unroll
        for (int ai = 0; ai < 2; ++ai)
#pragma unroll
            for (int m = 0; m < 4; ++m) { const size_t row = (size_t)(row0 + ai * HALF + m * 16); const float w = roww[row];
#pragma unroll
                for (int bj = 0; bj < 2; ++bj) st8(O + row * 1024 + col0 + bj * HALF, (acc[ai][bj][m][0] + bv[bj][0]) * w, (acc[ai][bj][m][1] + bv[bj][1]) * w); }
    }
};

template <class Epi, class Sched, bool ALIGN_EPI = false, bool SP2 = false>
__device__ __forceinline__ void gemm_phase(PG8_LAS unsigned char* lds, const int K, const Sched& S, const Epi& E) {
    const int tid = threadIdx.x, wid = __builtin_amdgcn_readfirstlane(tid >> 6), lane = tid & 63, wr = wid >> 2, wc = wid & 3, fr = lane & 15, fq = lane >> 4;
    const int nt = K / BK;
    unsigned voffA[2], voffB[2];
#pragma unroll
    for (int i = 0; i < 2; ++i) { int R, C; stage_rc(tid * 16 + i * 8192, R, C); const int Rb = Epi::PERM ? ((R & ~31) + perm32(R & 31)) : R;
        voffA[i] = (unsigned)(R * K + C) * 2u; voffB[i] = (unsigned)(Rb * K + C) * 2u; }
    const size_t kstep = (size_t)(BK * 2);
    const size_t hstep = (size_t)HALF * K * 2;
    const unsigned ldsw = (unsigned)wid * 1024u;
    const int aoff = lds_byte(wr * 64 + fr, fq * 8), boff = lds_byte(wc * 32 + fr, fq * 8);
#define PG8_SA(b, h) (((b) * 2 + (h)) * HTB)
#define PG8_SB(b, h) ((4 + (b) * 2 + (h)) * HTB)
#define PG8_STAGE(bufoff, gbase, voff) do { _Pragma("unroll") for (int _i = 0; _i < 2; ++_i) \
        __builtin_amdgcn_global_load_lds((const unsigned*)((const char*)(gbase) + (voff)[_i]), (PG8_LAS unsigned*)(lds + (bufoff) + ldsw + _i * 8192), 16, 0, 0); } while (0)
#define PG8_LDA(dst, b, h) do { _Pragma("unroll") for (int m = 0; m < 4; ++m) _Pragma("unroll") for (int k = 0; k < 2; ++k) dst[m][k] = *(const PG8_LAS bf16x8*)(lds + PG8_SA(b, h) + aoff + m * 2048 + k * 1024); } while (0)
#define PG8_LDB(dst, b, h) do { _Pragma("unroll") for (int n = 0; n < 2; ++n) _Pragma("unroll") for (int k = 0; k < 2; ++k) dst[n][k] = *(const PG8_LAS bf16x8*)(lds + PG8_SB(b, h) + boff + n * 2048 + k * 1024); } while (0)
#define PG8_MMA(ai, bj, At, Bt) do { __builtin_amdgcn_s_setprio(1); _Pragma("unroll") for (int m = 0; m < 4; ++m) _Pragma("unroll") for (int n = 0; n < 2; ++n) _Pragma("unroll") for (int k = 0; k < 2; ++k) \
        acc[ai][bj][m][n] = __builtin_amdgcn_mfma_f32_16x16x32_bf16(Bt[n][k], At[m][k], acc[ai][bj][m][n], 0, 0, 0); __builtin_amdgcn_s_setprio(0); } while (0)
#define PG8_WAIT_V(n) asm volatile("s_waitcnt vmcnt(" #n ")" ::: "memory")
#define PG8_WAIT_L(n) asm volatile("s_waitcnt lgkmcnt(" #n ")" ::: "memory")
#define PG8_BAR __builtin_amdgcn_s_barrier()
#define PG8_SCHED __builtin_amdgcn_sched_barrier(0)
    Unit cur, nxt; int ui = 0;
    if (!S.next(0, cur)) return;
    f32x4 acc[2][2][4][2];
#pragma unroll
    for (int a = 0; a < 2; ++a)
#pragma unroll
        for (int b = 0; b < 2; ++b)
#pragma unroll
            for (int m = 0; m < 4; ++m)
#pragma unroll
                for (int n = 0; n < 2; ++n) acc[a][b][m][n] = (f32x4){0.f, 0.f, 0.f, 0.f};
    bf16x8 At[4][2], B0[2][2], B1[2][2];
    const char* cA = cur.A; const char* cB = cur.B;
    S.a_ready(cur);
    if constexpr (SP2) {
        PG8_STAGE(PG8_SB(0, 0), cB, voffB); PG8_STAGE(PG8_SB(0, 1), cB + hstep, voffB); PG8_STAGE(PG8_SA(0, 0), cA, voffA); PG8_STAGE(PG8_SA(0, 1), cA + hstep, voffA);
        if (wr == 1) PG8_BAR;
        PG8_WAIT_V(2); PG8_BAR;
        PG8_STAGE(PG8_SB(1, 0), cB + kstep, voffB); PG8_STAGE(PG8_SA(1, 0), cA + kstep, voffA); PG8_STAGE(PG8_SB(1, 1), cB + hstep + kstep, voffB);
        PG8_WAIT_V(6); PG8_BAR;
    } else {
        PG8_STAGE(PG8_SB(0, 0), cB, voffB); PG8_STAGE(PG8_SA(0, 0), cA, voffA); PG8_STAGE(PG8_SB(0, 1), cB + hstep, voffB); PG8_STAGE(PG8_SA(0, 1), cA + hstep, voffA);
        if (wr == 1) PG8_BAR;
        PG8_WAIT_V(4); PG8_BAR;
        PG8_STAGE(PG8_SB(1, 0), cB + kstep, voffB); PG8_STAGE(PG8_SA(1, 0), cA + kstep, voffA); PG8_STAGE(PG8_SB(1, 1), cB + hstep + kstep, voffB);
        PG8_WAIT_V(6); PG8_BAR;
    }
    for (;;) {
        const bool has_next = S.next(ui + 1, nxt);
        const char* nA = has_next ? nxt.A : cA; const char* nB = has_next ? nxt.B : cB;
#pragma unroll 1
        for (int t = 0; t < nt; t += 2) {
            const bool last = (t == nt - 2);
            const char* a1 = cA + (size_t)(t + 1) * kstep;
            const char* a2 = last ? nA : cA + (size_t)(t + 2) * kstep; const char* b2 = last ? nB : cB + (size_t)(t + 2) * kstep;
            const char* a3 = a2 + kstep; const char* b3 = b2 + kstep;
            if (last && has_next) S.a_ready(nxt);
            if constexpr (SP2) {
            PG8_LDB(B0, 0, 0); PG8_LDB(B1, 0, 1); PG8_SCHED; PG8_LDA(At, 0, 0); PG8_STAGE(PG8_SA(1, 1), a1 + hstep, voffA);
            PG8_WAIT_V(8); PG8_WAIT_L(0); PG8_BAR; PG8_MMA(0, 0, At, B0); PG8_MMA(0, 1, At, B1); PG8_BAR; PG8_SCHED;
            PG8_LDA(At, 0, 1); PG8_STAGE(PG8_SB(0, 0), b2, voffB); PG8_STAGE(PG8_SB(0, 1), b2 + hstep, voffB); PG8_STAGE(PG8_SA(0, 0), a2, voffA);
            PG8_WAIT_V(8); PG8_WAIT_L(0); PG8_BAR; PG8_MMA(1, 0, At, B0); PG8_MMA(1, 1, At, B1); PG8_BAR; PG8_SCHED;
            PG8_LDB(B0, 1, 0); PG8_LDB(B1, 1, 1); PG8_SCHED; PG8_LDA(At, 1, 0); PG8_STAGE(PG8_SA(0, 1), a2 + hstep, voffA);
            PG8_WAIT_V(8); PG8_WAIT_L(0); PG8_BAR; PG8_MMA(0, 0, At, B0); PG8_MMA(0, 1, At, B1); PG8_BAR; PG8_SCHED;
            PG8_LDA(At, 1, 1); PG8_STAGE(PG8_SB(1, 0), b3, voffB); PG8_STAGE(PG8_SB(1, 1), b3 + hstep, voffB); PG8_STAGE(PG8_SA(1, 0), a3, voffA);
            PG8_WAIT_V(8); PG8_WAIT_L(0); PG8_BAR; PG8_MMA(1, 0, At, B0); PG8_MMA(1, 1, At, B1); PG8_BAR; PG8_SCHED;
            } else {
            PG8_LDB(B0, 0, 0); PG8_SCHED; PG8_LDA(At, 0, 0); PG8_STAGE(PG8_SA(1, 1), a1 + hstep, voffA);
            PG8_WAIT_L(8); PG8_BAR; PG8_WAIT_L(0); PG8_MMA(0, 0, At, B0); PG8_BAR; PG8_SCHED;
            PG8_LDB(B1, 0, 1); PG8_STAGE(PG8_SB(0, 0), b2, voffB);
            PG8_BAR; PG8_WAIT_L(0); PG8_MMA(0, 1, At, B1); PG8_BAR;
            PG8_LDA(At, 0, 1); PG8_STAGE(PG8_SA(0, 0), a2, voffA);
            PG8_BAR; PG8_WAIT_L(0); PG8_MMA(1, 0, At, B0); PG8_BAR; PG8_SCHED;
            PG8_STAGE(PG8_SB(0, 1), b2 + hstep, voffB);
            PG8_WAIT_V(6); PG8_BAR; PG8_MMA(1, 1, At, B1); PG8_BAR;
            PG8_LDB(B0, 1, 0); PG8_SCHED; PG8_LDA(At, 1, 0); PG8_STAGE(PG8_SA(0, 1), a2 + hstep, voffA);
            PG8_WAIT_L(8); PG8_BAR; PG8_WAIT_L(0); PG8_MMA(0, 0, At, B0); PG8_BAR; PG8_SCHED;
            PG8_LDB(B1, 1, 1); PG8_STAGE(PG8_SB(1, 0), b3, voffB);
            PG8_BAR; PG8_WAIT_L(0); PG8_MMA(0, 1, At, B1); PG8_BAR;
            PG8_LDA(At, 1, 1); PG8_STAGE(PG8_SA(1, 0), a3, voffA);
            PG8_BAR; PG8_WAIT_L(0); PG8_MMA(1, 0, At, B0); PG8_BAR; PG8_SCHED;
            PG8_STAGE(PG8_SB(1, 1), b3 + hstep, voffB);
            PG8_WAIT_V(6); PG8_BAR; PG8_MMA(1, 1, At, B1); PG8_BAR;
            }
        }
        if constexpr (ALIGN_EPI) { if (wr == 0) PG8_BAR; }
        if constexpr (!Epi::AFTER_DRAIN) { E(acc, cur, wr, wc, fr, fq); S.done(cur); }
        if (!has_next) break;
#pragma unroll
        for (int a = 0; a < 2; ++a)
#pragma unroll
            for (int b = 0; b < 2; ++b)
#pragma unroll
                for (int m = 0; m < 4; ++m)
#pragma unroll
                    for (int n = 0; n < 2; ++n) acc[a][b][m][n] = (f32x4){0.f, 0.f, 0.f, 0.f};
        cur = nxt; cA = nA; cB = nB; ++ui;
        if constexpr (ALIGN_EPI) { if (wr == 1) PG8_BAR; }
    }
    PG8_WAIT_V(0);
    if constexpr (!ALIGN_EPI) { if (wr == 0) PG8_BAR; }
    PG8_BAR;
    if constexpr (Epi::AFTER_DRAIN) { E.fused(acc, cur, wr, wc, fr, fq, lds, wid, lane); S.done(cur); }
#undef PG8_SA
#undef PG8_SB
#undef PG8_STAGE
#undef PG8_LDA
#undef PG8_LDB
#undef PG8_MMA
#undef PG8_WAIT_V
#undef PG8_WAIT_L
#undef PG8_BAR
#undef PG8_SCHED
}
}


#define LAS __attribute__((address_space(3)))
typedef unsigned short bf16;
typedef float f32x4 __attribute__((ext_vector_type(4)));
typedef float f32x2 __attribute__((ext_vector_type(2)));
typedef float f32x16 __attribute__((ext_vector_type(16)));
typedef unsigned u32x4 __attribute__((ext_vector_type(4)));
typedef unsigned u32x2 __attribute__((ext_vector_type(2)));
typedef short bf16x8 __attribute__((ext_vector_type(8)));
typedef short s16x4 __attribute__((ext_vector_type(4)));

constexpr int NB = 8, SEQ = 4096, DMODEL = 1024, MTOK = NB * SEQ, NHEAD = 8, HDIM = 64, BRD = 512;
constexpr int NEXP = 32, TOPK = 4, MAXTILES = 544, MAXSLOTS = MAXTILES * 256;
constexpr float DN_ALPHA = 1.189207115002721f, LN_EPS = 1e-5f, GN_EPS = 64e-5f;
constexpr int NWAVES = 8, NTHREADS = 512;
constexpr int LDS_BYTES = 155648;

constexpr size_t MiB = 1u << 20;
constexpr size_t WS_CTL = 0, CTL_BYTES = 64 * 1024;
constexpr size_t WS_WIN_T = 1 * MiB, WS_WLORA_T = 12 * MiB, WS_WR_T = 13 * MiB, WS_WA_T = 14 * MiB, WS_WO_T = 15 * MiB, WS_W1T = 17 * MiB, WS_W2T = 145 * MiB;
constexpr size_t WS_KMEAN = 209 * MiB, WS_TOKE = 210 * MiB, WS_TOKW = 210 * MiB + 512 * 1024, WS_SLOTOF = 211 * MiB, WS_ROWTOK = 212 * MiB, WS_ROWW = 213 * MiB;
constexpr size_t WS_D = 216 * MiB;
constexpr size_t WS_PG = WS_D, WS_PQ = WS_D + 128 * MiB, WS_PK = WS_D + 160 * MiB, WS_PAV = WS_D + 192 * MiB, WS_PRKV = WS_D + 224 * MiB, WS_PLR = WS_D + 320 * MiB;
constexpr size_t WS_LORA = WS_D + 320 * MiB, WS_ALORA = WS_D + 416 * MiB, WS_XB = WS_D + 432 * MiB, WS_SOP = WS_D + 416 * MiB;
constexpr size_t WS_YRAW = WS_D + 224 * MiB, WS_YRWKV = WS_D + 288 * MiB, WS_TMP = WS_D + 416 * MiB, WS_MERGED = WS_D + 544 * MiB, WS_XPRE = WS_D + 608 * MiB;
constexpr size_t WS_X1 = WS_D, WS_X1B = WS_D + 128 * MiB, WS_XPERM = WS_D + 192 * MiB, WS_ACT = WS_D + 464 * MiB, WS_YBUF = WS_D + 192 * MiB;
constexpr size_t WS_END = WS_D + 800 * MiB;
constexpr int CW_COUNT = 0, CW_NTILES = 64, CW_TILE_E = 128, CW_WGBASE = 1024;

struct Params { const float* in[26]; float* out; unsigned char* ws; int ph_lo, ph_hi; };
struct Ctx { LAS unsigned char* lds; int tid, lane, wave, gw, ngw, G, bid; };

__device__ __forceinline__ unsigned f2bf(float f) { unsigned u = __builtin_bit_cast(unsigned, f); return (u + 0x7fffu + ((u >> 16) & 1u)) >> 16; }
__device__ __forceinline__ unsigned pk2(float lo, float hi) { return f2bf(lo) | (f2bf(hi) << 16); }
__device__ __forceinline__ float bf2f(bf16 v) { return __builtin_bit_cast(float, (unsigned)v << 16); }
__device__ __forceinline__ float bflo(unsigned w) { return __builtin_bit_cast(float, w << 16); }
__device__ __forceinline__ float bfhi(unsigned w) { return __builtin_bit_cast(float, w & 0xffff0000u); }
__device__ __forceinline__ float wave_sum(float v) {
#pragma unroll
    for (int o = 1; o < 64; o <<= 1) v += __shfl_xor(v, o);
    return v;
}
__device__ __forceinline__ float sigmf(float x) { return 1.0f / (1.0f + __expf(-x)); }

__device__ __forceinline__ void transpose_item(const float* W, int K, int N, bf16* WT, int k0, int n0, int dst_row0, LAS float* scr, int lane) {
#pragma unroll 8
    for (int i = 0; i < 32; ++i) { const int kk = 2 * i + (lane >> 5); scr[kk * 33 + (lane & 31)] = W[(size_t)(k0 + kk) * N + n0 + (lane & 31)]; }
    asm volatile("s_waitcnt lgkmcnt(0)" ::: "memory");
    const int c = lane & 7;
#pragma unroll
    for (int j = 0; j < 4; ++j) { const int n = (lane >> 3) + 8 * j; const LAS float* s = scr + (8 * c) * 33 + n;
        u32x4 o; o.x = pk2(s[0 * 33], s[1 * 33]); o.y = pk2(s[2 * 33], s[3 * 33]); o.z = pk2(s[4 * 33], s[5 * 33]); o.w = pk2(s[6 * 33], s[7 * 33]);
        *(u32x4*)(WT + (size_t)(dst_row0 + n) * K + k0 + 8 * c) = o; }
    asm volatile("s_waitcnt lgkmcnt(0)" ::: "memory");
}
__device__ __forceinline__ void phase0(const Params& p, const Ctx& c) {
    unsigned char* ws = p.ws;
    LAS float* scr = (LAS float*)(c.lds + c.wave * 16384);
    constexpr int I0 = 16 * 168, I1 = 8 * 32, I2 = 8 * 32, I3 = 16 * 32, I4 = 32 * 1024, I5 = 32 * 512, NIT = I0 + I1 + I2 + I3 + I4 + I5;
    for (int it = c.gw; it < NIT; it += c.ngw) {
        int r = it;
        if (r < I0) { transpose_item(p.in[5], 1024, 5376, (bf16*)(ws + WS_WIN_T), 64 * (r / 168), 32 * (r % 168), 32 * (r % 168), scr, c.lane); continue; } r -= I0;
        if (r < I1) { transpose_item(p.in[17], 512, 1024, (bf16*)(ws + WS_WR_T), 64 * (r / 32), 32 * (r % 32), 32 * (r % 32), scr, c.lane); continue; } r -= I1;
        if (r < I2) { transpose_item(p.in[18], 512, 1024, (bf16*)(ws + WS_WA_T), 64 * (r / 32), 32 * (r % 32), 32 * (r % 32), scr, c.lane); continue; } r -= I2;
        if (r < I3) { transpose_item(p.in[19], 1024, 1024, (bf16*)(ws + WS_WO_T), 64 * (r / 32), 32 * (r % 32), 32 * (r % 32), scr, c.lane); continue; } r -= I3;
        if (r < I4) { const int e = r >> 10, rr = r & 1023, n0 = 32 * (rr & 63);
            const int dst = n0 < 1024 ? (n0 >> 7) * 256 + (n0 & 127) : ((n0 - 1024) >> 7) * 256 + 128 + ((n0 - 1024) & 127);
            transpose_item(p.in[22] + (size_t)e * 1024 * 2048, 1024, 2048, (bf16*)(ws + WS_W1T) + (size_t)e * 2048 * 1024, 64 * (rr >> 6), n0, dst, scr, c.lane); continue; } r -= I4;
        { const int e = r >> 9, rr = r & 511; transpose_item(p.in[24] + (size_t)e * 1024 * 1024, 1024, 1024, (bf16*)(ws + WS_W2T) + (size_t)e * 1024 * 1024, 64 * (rr >> 5), 32 * (rr & 31), 32 * (rr & 31), scr, c.lane); }
    }
    const int gt = c.bid * NTHREADS + c.tid, ngt = c.G * NTHREADS;
    { bf16* WL = (bf16*)(ws + WS_WLORA_T); const float* du = p.in[8]; const float* iu = p.in[10]; const float* gu = p.in[11];
      for (int i = gt; i < 1536 * 256; i += ngt) { const int n = i >> 8, k = i & 255; float v = 0.f;
          if (n < 512) { if (k < 64) v = du[k * 512 + n]; } else if (n < 1024) { if (k >= 64 && k < 128) v = iu[(k - 64) * 512 + (n - 512)]; } else { if (k >= 128) v = gu[(k - 128) * 512 + (n - 1024)]; }
          WL[i] = (bf16)f2bf(v); } }
    { const f32x4* x4 = (const f32x4*)p.in[0]; u32x2* o = (u32x2*)(ws + WS_XB);
      for (int i = gt; i < MTOK * DMODEL / 4; i += ngt) { const f32x4 v = x4[i]; u32x2 w; w.x = pk2(v[0], v[1]); w.y = pk2(v[2], v[3]); o[i] = w; } }
}

__device__ __forceinline__ void phase2(const Params& p, const Ctx& c) {
    unsigned char* ws = p.ws;
    { const bf16* PLR = (const bf16*)(ws + WS_PLR); bf16* AL = (bf16*)(ws + WS_ALORA); const float* mix = p.in[6] + 1536;
      const int j0 = c.lane * 4; const f32x4 mx = *(const f32x4*)(mix + j0);
      for (int m = c.gw; m < MTOK; m += c.ngw) {
          const u32x2 cu = *(const u32x2*)(PLR + (size_t)m * 256 + j0); u32x2 pv; pv.x = 0u; pv.y = 0u;
          if ((m & (SEQ - 1)) != 0) pv = *(const u32x2*)(PLR + (size_t)(m - 1) * 256 + j0);
          float s[4] = {bflo(cu.x), bfhi(cu.x), bflo(cu.y), bfhi(cu.y)}; const float q[4] = {bflo(pv.x), bfhi(pv.x), bflo(pv.y), bfhi(pv.y)};
#pragma unroll
          for (int i = 0; i < 4; ++i) { s[i] = s[i] + (q[i] - s[i]) * mx[i]; if (c.lane < 16) s[i] = tanhf(s[i]); else if (c.lane >= 32) s[i] = sigmf(s[i]); }
          u32x2 o; o.x = pk2(s[0], s[1]); o.y = pk2(s[2], s[3]); *(u32x2*)(AL + (size_t)m * 256 + j0) = o; } }
    for (int item = c.bid; item < NB * 16; item += c.G) {
        const int b = item >> 4, blk = item & 15; bf16* Q = (bf16*)(ws + WS_PQ); bf16* K = (bf16*)(ws + WS_PK); float* KM = (float*)(ws + WS_KMEAN);
        const size_t m0 = (size_t)b * SEQ + blk * 256;
        { const int col = c.tid, h = col >> 6, d = col & 63; float s0 = 0.f, s1 = 0.f;
          if (d < 8) { const float invf = powf(500000.0f, -(float)d * 0.125f);
#pragma unroll 4
              for (int tok = 0; tok < 256; ++tok) { float sn, cs; sincosf((float)(blk * 256 + tok) * invf, &sn, &cs);
                  const float y1 = bf2f(K[(m0 + tok) * 512 + col]), y2 = bf2f(K[(m0 + tok) * 512 + col + 8]); s0 += y1 * cs - y2 * sn; s1 += y2 * cs + y1 * sn; }
              float* km = KM + ((size_t)((b * 8 + h) * 16 + blk)) * 64; km[d] = s0 * (1.0f / 256.0f); km[d + 8] = s1 * (1.0f / 256.0f);
          } else if (d >= 16) {
#pragma unroll 8
              for (int tok = 0; tok < 256; ++tok) s0 += bf2f(K[(m0 + tok) * 512 + col]);
              KM[((size_t)((b * 8 + h) * 16 + blk)) * 64 + d] = s0 * (1.0f / 256.0f); } }
        __syncthreads();
#pragma unroll 4
        for (int it = 0; it < 64; ++it) { const int task = it * NTHREADS + c.tid; const int i = task & 7, h = (task >> 3) & 7, which = (task >> 6) & 1, tok = task >> 7;
            bf16* P = (which ? K : Q) + (m0 + tok) * 512 + h * 64 + i; const float invf = powf(500000.0f, -(float)i * 0.125f);
            float sn, cs; sincosf((float)(blk * 256 + tok) * invf, &sn, &cs); const float x1 = bf2f(P[0]), x2 = bf2f(P[8]);
            P[0] = (bf16)f2bf(x1 * cs - x2 * sn); P[8] = (bf16)f2bf(x2 * cs + x1 * sn); }
        __syncthreads();
    }
}

__device__ __forceinline__ void phase4(const Params& p, const Ctx& c) {
    unsigned char* ws = p.ws; const bf16* RKV = (const bf16*)(ws + WS_PRKV); const bf16* LO = (const bf16*)(ws + WS_LORA); float* SOP = (float*)(ws + WS_SOP);
    const float* mix = p.in[6]; const float* w0 = p.in[7]; const float* a0 = p.in[9]; const float* kk_ = p.in[12]; const float* ka_ = p.in[13];
    for (int idx = c.gw; idx < MTOK * NHEAD; idx += c.ngw) {
        const int m = idx >> 3, h = idx & 7, ch = h * 64 + c.lane, t = m & (SEQ - 1), b = m >> 12;
        const bf16* row = RKV + (size_t)m * 1536; float r = bf2f(row[ch]), k = bf2f(row[512 + ch]), v = bf2f(row[1024 + ch]); float rp = 0.f, kp = 0.f, vp = 0.f;
        if (t != 0) { rp = bf2f(row[ch - 1536]); kp = bf2f(row[512 + ch - 1536]); vp = bf2f(row[1024 + ch - 1536]); }
        r += (rp - r) * mix[ch]; k += (kp - k) * mix[512 + ch]; v += (vp - v) * mix[1024 + ch];
        const float lw = bf2f(LO[(size_t)m * 1536 + ch]), la = bf2f(LO[(size_t)m * 1536 + 512 + ch]);
        const float z = -(w0[ch] + lw); const float sp = z > 20.f ? z : log1pf(expf(z)); const float dec = expf(-expf(-sp - 0.5f));
        const float a = 1.0f / (1.0f + expf(-(a0[ch] + la)));
        const float kkv = k * kk_[ch]; const float ss = wave_sum(kkv * kkv); const float kk = kkv / fmaxf(sqrtf(ss), 1e-12f);
        const float kmod = k * (1.0f + (a - 1.0f) * ka_[ch]);
        float* o = SOP + ((size_t)(b * 8 + h) * SEQ + t) * 384 + c.lane;
        o[0] = -kk; o[64] = kk * a; o[128] = dec; o[192] = kmod; o[256] = r; o[320] = v;
    }
}

template <int CTRL> __device__ __forceinline__ float dppf(float x) { return __builtin_bit_cast(float, __builtin_amdgcn_update_dpp(0, __builtin_bit_cast(int, x), CTRL, 0xF, 0xF, true)); }
__device__ __forceinline__ float row16_sum(float x) {
    x += dppf<0xB1>(x);
    x += dppf<0x4E>(x);
    x += dppf<0x141>(x);
    x += dppf<0x140>(x);
    return x;
}
constexpr int SCAN_TC = 32, SCAN_CHUNK_F = SCAN_TC * 384;
__device__ __forceinline__ void scan_item(const Params& p, const Ctx& c, int item) {
    const int bh = item >> 2, rg = item & 3, b = bh >> 3, h = bh & 7;
    const float* SOP = (const float*)(p.ws + WS_SOP) + (size_t)bh * SEQ * 384; float* YR = (float*)(p.ws + WS_YRAW);
    LAS float* buf = (LAS float*)c.lds;
    const int rowl = c.wave * 4 + (c.lane >> 4), kq = c.lane & 15, rowg = rg * 16 + rowl;
    f32x4 st[6];
#pragma unroll
    for (int i = 0; i < 6; ++i) st[i] = *(const f32x4*)(SOP + (size_t)(i * NTHREADS + c.tid) * 4);
#pragma unroll
    for (int i = 0; i < 6; ++i) *(LAS f32x4*)(buf + (i * NTHREADS + c.tid) * 4) = st[i];
    __syncthreads();
    f32x4 S = {0.f, 0.f, 0.f, 0.f};
    constexpr int NC = SEQ / SCAN_TC;
    for (int ch = 0; ch < NC; ++ch) {
        if (ch + 1 < NC) {
#pragma unroll
            for (int i = 0; i < 6; ++i) st[i] = *(const f32x4*)(SOP + (size_t)(ch + 1) * SCAN_CHUNK_F + (size_t)(i * NTHREADS + c.tid) * 4);
        }
        if (c.wave < 4) {
            const LAS float* cb = buf + (ch & 1) * SCAN_CHUNK_F;
            float* yo = YR + ((size_t)b * SEQ + (size_t)ch * SCAN_TC) * 512 + h * 64 + rowg;
#pragma unroll 4
            for (int tt = 0; tt < SCAN_TC; ++tt) {
                const LAS float* op = cb + tt * 384;
                const f32x4 nk = *(const LAS f32x4*)(op + 4 * kq), ka = *(const LAS f32x4*)(op + 64 + 4 * kq), w = *(const LAS f32x4*)(op + 128 + 4 * kq);
                const f32x4 km = *(const LAS f32x4*)(op + 192 + 4 * kq), rr = *(const LAS f32x4*)(op + 256 + 4 * kq); const float v = op[320 + rowg];
                float sa = (S[0] * nk[0] + S[1] * nk[1]) + (S[2] * nk[2] + S[3] * nk[3]);
                sa = row16_sum(sa);
                S = S * w + (ka * sa + km * v);
                float y = (S[0] * rr[0] + S[1] * rr[1]) + (S[2] * rr[2] + S[3] * rr[3]);
                y = row16_sum(y);
                if (kq == 0) yo[(size_t)tt * 512] = y;
            }
        }
        if (ch + 1 < NC) {
            LAS float* nb = buf + ((ch + 1) & 1) * SCAN_CHUNK_F;
#pragma unroll
            for (int i = 0; i < 6; ++i) *(LAS f32x4*)(nb + (i * NTHREADS + c.tid) * 4) = st[i];
        }
        __syncthreads();
    }
}

namespace att {
constexpr int L_K = 0, L_V = 16384, L_KM = 32768, L_SEL = 36864, L_WS = 37888;
constexpr float C2 = 0.125f * 1.4426950408889634f;
__device__ __forceinline__ int crow(int r, int hi) { return (r & 3) + 8 * (r >> 2) + 4 * hi; }
typedef __bf16 bf16x2_t __attribute__((ext_vector_type(2)));
__device__ __forceinline__ unsigned cvtpk(float lo, float hi) { f32x2 v = {lo, hi}; bf16x2_t b = __builtin_convertvector(v, bf16x2_t); return __builtin_bit_cast(unsigned, b); }
typedef short v4i16_t __attribute__((ext_vector_type(4)));
__device__ __forceinline__ s16x4 vtr(const LAS unsigned char* p) { return __builtin_bit_cast(s16x4, __builtin_amdgcn_ds_read_tr16_b64_v4i16((LAS v4i16_t*)p)); }

__device__ __forceinline__ void unit(const Params& p, const Ctx& c, int b, int h, int qb) {
    const int tid = c.tid, lane = c.lane, wid = c.wave, r32 = lane & 31, hi = lane >> 5;
    bf16* Q = (bf16*)(p.ws + WS_PQ); const bf16* K = (const bf16*)(p.ws + WS_PK); const bf16* V = (const bf16*)(p.ws + WS_PAV); const float* KMg = (const float*)(p.ws + WS_KMEAN);
    const size_t rowbase = (size_t)b * SEQ; const int q0 = qb * 256;
    LAS unsigned char* lds = c.lds; LAS float* kml = (LAS float*)(lds + L_KM); LAS unsigned* sell = (LAS unsigned*)(lds + L_SEL); LAS float* wsf = (LAS float*)(lds + L_WS) + wid * 64;
    for (int i = tid; i < qb * 64; i += NTHREADS) kml[i] = KMg[(size_t)((b * 8 + h) * 16) * 64 + i];
    __syncthreads();
    if (tid < 256) {
        const bf16* qrow = Q + (rowbase + q0 + tid) * 512 + h * 64; float qv[64];
#pragma unroll
        for (int i = 0; i < 8; ++i) { const u32x4 w = *(const u32x4*)(qrow + 8 * i); qv[8 * i] = bflo(w.x); qv[8 * i + 1] = bfhi(w.x); qv[8 * i + 2] = bflo(w.y); qv[8 * i + 3] = bfhi(w.y); qv[8 * i + 4] = bflo(w.z); qv[8 * i + 5] = bfhi(w.z); qv[8 * i + 6] = bflo(w.w); qv[8 * i + 7] = bfhi(w.w); }
        float v0 = -INFINITY, v1 = -INFINITY, v2 = -INFINITY; int i0 = -1, i1 = -1, i2 = -1;
        for (int j = 0; j < qb; ++j) { float g = 0.f;
#pragma unroll
            for (int d = 0; d < 64; d += 4) { const f32x4 km = *(const LAS f32x4*)(kml + j * 64 + d); g += qv[d] * km[0] + qv[d + 1] * km[1] + qv[d + 2] * km[2] + qv[d + 3] * km[3]; }
            if (g > v0) { v2 = v1; i2 = i1; v1 = v0; i1 = i0; v0 = g; i0 = j; } else if (g > v1) { v2 = v1; i2 = i1; v1 = g; i1 = j; } else if (g > v2) { v2 = g; i2 = j; } }
        unsigned msk = 0u; if (i0 >= 0) msk |= 1u << i0; if (i1 >= 0) msk |= 1u << i1; if (i2 >= 0) msk |= 1u << i2;
        sell[tid] = msk;
    }
    __syncthreads();
    const bf16* Qw = Q + (rowbase + q0 + wid * 32) * 512 + h * 64; bf16x8 qr[4];
#pragma unroll
    for (int d0 = 0; d0 < 4; ++d0) qr[d0] = *(const bf16x8*)(Qw + (size_t)r32 * 512 + d0 * 16 + hi * 8);
    const unsigned mysel = sell[wid * 32 + r32]; const int qrel = wid * 32 + r32;
    float m_run = -INFINITY, l_run = 0.f; f32x16 o0 = {}, o1 = {};
    const int krow = tid & 63, kch = tid >> 6; const bf16* ksrc = K + (rowbase + krow) * 512 + h * 64 + kch * 8; const int kdst = kch * 1024 + krow * 16;
    const int vrow = 16 * (wid & 3) + (lane >> 2), vcol = (wid >> 2) * 32 + (lane & 3) * 8; const bf16* vsrc = V + (rowbase + vrow) * 512 + h * 64 + vcol; const int vdst = wid * 1024 + lane * 16;
    const int kfo = hi * 1024 + r32 * 16; const int vfo = ((lane >> 4) & 1) * 32 + (lane & 3) * 8 + (4 * hi + ((lane & 15) >> 2)) * 64;
    const int ntile = 4 * qb + 4;
    u32x4 kreg = *(const u32x4*)(ksrc), vreg = *(const u32x4*)(vsrc);
    for (int it = 0; it < ntile; ++it) {
        LAS unsigned char* Ks = lds + L_K + (it & 1) * 8192; LAS unsigned char* Vs = lds + L_V + (it & 1) * 8192;
        *(LAS u32x4*)(Ks + kdst) = kreg; *(LAS u32x4*)(Vs + vdst) = vreg;
        __syncthreads();
        if (it + 1 < ntile) { kreg = *(const u32x4*)(ksrc + (size_t)(it + 1) * 64 * 512); vreg = *(const u32x4*)(vsrc + (size_t)(it + 1) * 64 * 512); }
        const int blk = it >> 2; const bool band = blk == qb; const int jb = it & 3;
        bool lane_on = band ? (64 * jb <= qrel) : (((mysel >> blk) & 1u) != 0u);
        if (__any(lane_on)) {
            f32x16 p0 = {}, p1 = {};
#pragma unroll
            for (int d0 = 0; d0 < 4; ++d0) { const bf16x8 k0 = *(const LAS bf16x8*)(Ks + kfo + d0 * 2048), k1 = *(const LAS bf16x8*)(Ks + kfo + d0 * 2048 + 512);
                p0 = __builtin_amdgcn_mfma_f32_32x32x16_bf16(k0, qr[d0], p0, 0, 0, 0); p1 = __builtin_amdgcn_mfma_f32_32x32x16_bf16(k1, qr[d0], p1, 0, 0, 0); }
#pragma unroll
            for (int r = 0; r < 16; ++r) { const int kv = 64 * jb + crow(r, hi);
                const bool ok0 = band ? (kv <= qrel) : lane_on, ok1 = band ? (kv + 32 <= qrel) : lane_on;
                p0[r] = ok0 ? p0[r] * C2 : -INFINITY; p1[r] = ok1 ? p1[r] * C2 : -INFINITY; }
            float rm = fmaxf(p0[0], p1[0]);
#pragma unroll
            for (int r = 1; r < 16; ++r) rm = fmaxf(rm, fmaxf(p0[r], p1[r]));
            rm = fmaxf(rm, __shfl_xor(rm, 32));
            const float m_new = fmaxf(m_run, rm); const float m_use = (m_new == -INFINITY) ? 0.f : m_new;
            const float alpha = __builtin_amdgcn_exp2f(m_run - m_use);
            float ps = 0.f;
#pragma unroll
            for (int r = 0; r < 16; ++r) { p0[r] = __builtin_amdgcn_exp2f(p0[r] - m_use); p1[r] = __builtin_amdgcn_exp2f(p1[r] - m_use); ps += p0[r] + p1[r]; }
            l_run = l_run * alpha + ps; m_run = m_new;
            if (__any(alpha != 1.0f)) {
                if (hi == 0) wsf[r32] = alpha;
                asm volatile("s_waitcnt lgkmcnt(0)" ::: "memory");
#pragma unroll
                for (int r = 0; r < 16; ++r) { const float f = wsf[crow(r, hi)]; o0[r] *= f; o1[r] *= f; }
                asm volatile("s_waitcnt lgkmcnt(0)" ::: "memory");
            }
            u32x4 pw[4];
            pw[0] = (u32x4){cvtpk(p0[0], p0[1]), cvtpk(p0[2], p0[3]), cvtpk(p0[4], p0[5]), cvtpk(p0[6], p0[7])};
            pw[1] = (u32x4){cvtpk(p0[8], p0[9]), cvtpk(p0[10], p0[11]), cvtpk(p0[12], p0[13]), cvtpk(p0[14], p0[15])};
            pw[2] = (u32x4){cvtpk(p1[0], p1[1]), cvtpk(p1[2], p1[3]), cvtpk(p1[4], p1[5]), cvtpk(p1[6], p1[7])};
            pw[3] = (u32x4){cvtpk(p1[8], p1[9]), cvtpk(p1[10], p1[11]), cvtpk(p1[12], p1[13]), cvtpk(p1[14], p1[15])};
#pragma unroll
            for (int ks = 0; ks < 4; ++ks) {
                const s16x4 a0 = vtr(Vs + vfo + ks * 1024), a1 = vtr(Vs + vfo + ks * 1024 + 512), b0 = vtr(Vs + vfo + 4096 + ks * 1024), b1 = vtr(Vs + vfo + 4096 + ks * 1024 + 512);
                const bf16x8 va = {a0[0], a0[1], a0[2], a0[3], a1[0], a1[1], a1[2], a1[3]}, vb = {b0[0], b0[1], b0[2], b0[3], b1[0], b1[1], b1[2], b1[3]};
                const bf16x8 pa = __builtin_bit_cast(bf16x8, pw[ks]);
                o0 = __builtin_amdgcn_mfma_f32_32x32x16_bf16(pa, va, o0, 0, 0, 0); o1 = __builtin_amdgcn_mfma_f32_32x32x16_bf16(pa, vb, o1, 0, 0, 0);
            }
        }
    }
    l_run += __shfl_xor(l_run, 32);
    if (hi == 0) wsf[32 + r32] = l_run;
    asm volatile("s_waitcnt lgkmcnt(0)" ::: "memory");
    bf16* Ow = Q + (rowbase + q0 + wid * 32) * 512 + h * 64;
#pragma unroll
    for (int r = 0; r < 16; ++r) { const int qr_ = crow(r, hi); const float rl = 1.0f / wsf[32 + qr_];
        Ow[(size_t)qr_ * 512 + r32] = (bf16)f2bf(o0[r] * rl); Ow[(size_t)qr_ * 512 + 32 + r32] = (bf16)f2bf(o1[r] * rl); }
    __syncthreads();
}
}

__device__ __forceinline__ void phase6(const Params& p, const Ctx& c) {
    unsigned char* ws = p.ws; const float* YR = (const float*)(ws + WS_YRAW); const float* SOP = (const float*)(ws + WS_SOP); const bf16* LO = (const bf16*)(ws + WS_LORA); bf16* YO = (bf16*)(ws + WS_YRWKV);
    const float* rk = p.in[14]; const float* gg = p.in[15]; const float* gb = p.in[16];
    for (int idx = c.gw; idx < MTOK * NHEAD; idx += c.ngw) {
        const int m = idx >> 3, h = idx & 7, ch = h * 64 + c.lane, t = m & (SEQ - 1), b = m >> 12;
        const float y = YR[(size_t)m * 512 + ch]; const float mu = wave_sum(y) * (1.0f / 64.0f); const float d = y - mu; const float var = wave_sum(d * d) * (1.0f / 64.0f);
        const float yn = d * rsqrtf(var + GN_EPS) * gg[ch] + gb[ch];
        const float* o = SOP + ((size_t)(b * 8 + h) * SEQ + t) * 384 + c.lane; const float kmod = o[192], r = o[256], v = o[320];
        const float bonus = wave_sum(r * kmod * rk[ch]) * v; const float g = bf2f(LO[(size_t)m * 1536 + 1024 + ch]);
        YO[(size_t)m * 512 + ch] = (bf16)f2bf((yn + bonus) * g);
    }
}

constexpr int RW_PITCH = 36;
constexpr int L_HIST = 1024 * RW_PITCH * 4;
__device__ __forceinline__ void phase9(const Params& p, const Ctx& c) {
    unsigned char* ws = p.ws; const float* XP = (const float*)(ws + WS_XPRE); float* X1 = (float*)(ws + WS_X1); bf16* X1B = (bf16*)(ws + WS_X1B);
    int* ctl = (int*)(ws + WS_CTL); int* TOKE = (int*)(ws + WS_TOKE); float* TOKW = (float*)(ws + WS_TOKW);
    const float* g1 = p.in[1]; const float* b1 = p.in[2]; const float* RW = p.in[20]; const float* RB = p.in[21];
    LAS float* rw = (LAS float*)c.lds; LAS int* hist = (LAS int*)(c.lds + L_HIST);
    for (int i = c.tid; i < 1024 * 8; i += NTHREADS) { const int row = i >> 3, q = i & 7; *(LAS f32x4*)(rw + row * RW_PITCH + 4 * q) = *(const f32x4*)(RW + row * 32 + 4 * q); }
    if (c.tid < 32) hist[c.tid] = 0;
    __syncthreads();
    for (int m = c.gw; m < MTOK; m += c.ngw) {
        const f32x4* xr = (const f32x4*)(XP + (size_t)m * 1024) + c.lane; f32x4 v[4]; float s = 0.f;
#pragma unroll
        for (int j = 0; j < 4; ++j) { v[j] = xr[64 * j]; s += (v[j][0] + v[j][1]) + (v[j][2] + v[j][3]); }
        const float mean = wave_sum(s) * (1.0f / 1024.0f); float s2 = 0.f;
#pragma unroll
        for (int j = 0; j < 4; ++j) { v[j] = v[j] - mean; s2 += (v[j][0] * v[j][0] + v[j][1] * v[j][1]) + (v[j][2] * v[j][2] + v[j][3] * v[j][3]); }
        const float rstd = 1.0f / sqrtf(wave_sum(s2) * (1.0f / 1024.0f) + LN_EPS);
        float acc[32];
#pragma unroll
        for (int e = 0; e < 32; ++e) acc[e] = 0.f;
#pragma unroll
        for (int j = 0; j < 4; ++j) { const int col = 256 * j + 4 * c.lane; const f32x4 gv = *(const f32x4*)(g1 + col), bv = *(const f32x4*)(b1 + col);
            v[j] = v[j] * rstd * gv + bv;
            *(f32x4*)(X1 + (size_t)m * 1024 + col) = v[j]; u32x2 w; w.x = pk2(v[j][0], v[j][1]); w.y = pk2(v[j][2], v[j][3]); *(u32x2*)(X1B + (size_t)m * 1024 + col) = w;
#pragma unroll
            for (int i = 0; i < 4; ++i) { const LAS float* wr_ = rw + (col + i) * RW_PITCH; const float xv = v[j][i];
#pragma unroll
                for (int q = 0; q < 8; ++q) { const f32x4 w4 = *(const LAS f32x4*)(wr_ + 4 * q); acc[4 * q] += xv * w4[0]; acc[4 * q + 1] += xv * w4[1]; acc[4 * q + 2] += xv * w4[2]; acc[4 * q + 3] += xv * w4[3]; } } }
#pragma unroll
        for (int e = 0; e < 32; ++e) acc[e] = wave_sum(acc[e]) + RB[e];
        float tv[4]; int ti[4]; unsigned used = 0u;
#pragma unroll
        for (int k = 0; k < 4; ++k) { float bv = -INFINITY; int bi = 0;
#pragma unroll
            for (int e = 0; e < 32; ++e) { const bool ok = ((used >> e) & 1u) == 0u && acc[e] > bv; bv = ok ? acc[e] : bv; bi = ok ? e : bi; }
            tv[k] = bv; ti[k] = bi; used |= 1u << bi; }
        const float e1 = __expf(tv[1] - tv[0]), e2 = __expf(tv[2] - tv[0]), e3 = __expf(tv[3] - tv[0]); const float inv = 1.0f / (1.0f + e1 + e2 + e3);
        if (c.lane < 4) { const int e = c.lane == 0 ? ti[0] : c.lane == 1 ? ti[1] : c.lane == 2 ? ti[2] : ti[3]; const float w = (c.lane == 0 ? 1.0f : c.lane == 1 ? e1 : c.lane == 2 ? e2 : e3) * inv;
            const int pos = __hip_atomic_fetch_add(hist + e, 1, __ATOMIC_RELAXED, __HIP_MEMORY_SCOPE_WORKGROUP);
            TOKE[m * 4 + c.lane] = e | (pos << 8); TOKW[m * 4 + c.lane] = w; }
    }
    __syncthreads();
    if (c.tid < 32) { const int base = atomicAdd(ctl + CW_COUNT + c.tid, hist[c.tid]); ctl[CW_WGBASE + c.bid * 32 + c.tid] = base; }
}

__device__ __forceinline__ void phase10(const Params& p, const Ctx& c) {
    unsigned char* ws = p.ws; int* ctl = (int*)(ws + WS_CTL); const int* TOKE = (const int*)(ws + WS_TOKE); const float* TOKW = (const float*)(ws + WS_TOKW);
    int* SLOTOF = (int*)(ws + WS_SLOTOF); float* ROWW = (float*)(ws + WS_ROWW); const bf16* X1B = (const bf16*)(ws + WS_X1B); bf16* XPM = (bf16*)(ws + WS_XPERM);
    LAS int* pst = (LAS int*)(c.lds + L_HIST + 128);
    if (c.tid == 0) { int acc = 0;
        for (int e = 0; e < 32; ++e) { const int cnt = __hip_atomic_load(ctl + CW_COUNT + e, __ATOMIC_RELAXED, __HIP_MEMORY_SCOPE_AGENT); const int nt = (cnt + 255) >> 8;
            pst[e] = acc * 256 + ctl[CW_WGBASE + c.bid * 32 + e];
            if (c.bid == 0) for (int t = 0; t < nt; ++t) ctl[CW_TILE_E + acc + t] = e;
            acc += nt; }
        if (c.bid == 0) ctl[CW_NTILES] = acc; }
    __syncthreads();
    for (int m = c.gw; m < MTOK; m += c.ngw) {
        int slot = 0;
        if (c.lane < 4) { const int ew = TOKE[m * 4 + c.lane]; slot = pst[ew & 255] + (ew >> 8); SLOTOF[m * 4 + c.lane] = slot; ROWW[slot] = TOKW[m * 4 + c.lane]; }
        const u32x4* src = (const u32x4*)(X1B + (size_t)m * 1024); const u32x4 a = src[c.lane], b2 = src[64 + c.lane];
#pragma unroll
        for (int k = 0; k < 4; ++k) { const int sk = __shfl(slot, k); u32x4* dst = (u32x4*)(XPM + (size_t)sk * 1024); dst[c.lane] = a; dst[64 + c.lane] = b2; }
    }
}

__device__ __forceinline__ void phase14(const Params& p, const Ctx& c) {
    unsigned char* ws = p.ws; const float* X1 = (const float*)(ws + WS_X1); const bf16* YB = (const bf16*)(ws + WS_YBUF); const int* SLOTOF = (const int*)(ws + WS_SLOTOF);
    const float* g2 = p.in[3]; const float* b2 = p.in[4];
    for (int m = c.gw; m < MTOK; m += c.ngw) {
        const int s0 = SLOTOF[m * 4], s1 = SLOTOF[m * 4 + 1], s2_ = SLOTOF[m * 4 + 2], s3 = SLOTOF[m * 4 + 3];
        f32x4 v[4]; float s = 0.f;
#pragma unroll
        for (int j = 0; j < 4; ++j) { const int col = 256 * j + 4 * c.lane; v[j] = *(const f32x4*)(X1 + (size_t)m * 1024 + col) * DN_ALPHA;
            const u32x2 a = *(const u32x2*)(YB + (size_t)s0 * 1024 + col), b = *(const u32x2*)(YB + (size_t)s1 * 1024 + col), cc = *(const u32x2*)(YB + (size_t)s2_ * 1024 + col), d = *(const u32x2*)(YB + (size_t)s3 * 1024 + col);
            v[j][0] += ((bflo(a.x) + bflo(b.x)) + bflo(cc.x)) + bflo(d.x); v[j][1] += ((bfhi(a.x) + bfhi(b.x)) + bfhi(cc.x)) + bfhi(d.x);
            v[j][2] += ((bflo(a.y) + bflo(b.y)) + bflo(cc.y)) + bflo(d.y); v[j][3] += ((bfhi(a.y) + bfhi(b.y)) + bfhi(cc.y)) + bfhi(d.y);
            s += (v[j][0] + v[j][1]) + (v[j][2] + v[j][3]); }
        const float mean = wave_sum(s) * (1.0f / 1024.0f); float q = 0.f;
#pragma unroll
        for (int j = 0; j < 4; ++j) { v[j] = v[j] - mean; q += (v[j][0] * v[j][0] + v[j][1] * v[j][1]) + (v[j][2] * v[j][2] + v[j][3] * v[j][3]); }
        const float rstd = 1.0f / sqrtf(wave_sum(q) * (1.0f / 1024.0f) + LN_EPS);
#pragma unroll
        for (int j = 0; j < 4; ++j) { const int col = 256 * j + 4 * c.lane; *(f32x4*)(p.out + (size_t)m * 1024 + col) = v[j] * rstd * *(const f32x4*)(g2 + col) + *(const f32x4*)(b2 + col); }
    }
}

constexpr int NPHASE = 15;
#ifndef MK_SPLIT
#define MK_SPLIT 0
#endif
__global__ void __launch_bounds__(NTHREADS, 2) fwd_megakernel(Params p) {
    extern __shared__ __attribute__((aligned(16))) unsigned char lds_raw[];
    Ctx c; c.lds = (LAS unsigned char*)lds_raw; c.tid = threadIdx.x; c.lane = c.tid & 63; c.wave = __builtin_amdgcn_readfirstlane(c.tid >> 6);
    c.G = gridDim.x; c.bid = blockIdx.x; c.gw = c.bid * NWAVES + c.wave; c.ngw = c.G * NWAVES;
    unsigned char* ws = p.ws;
    const int lo = p.ph_lo, hi = p.ph_hi;
#ifdef ONLY_PHASE
#define IN(k) ((k) == ONLY_PHASE && lo <= (k) && (k) < hi)
#else
#define IN(k) (lo <= (k) && (k) < hi)
#endif
#if MK_SPLIT
#define SEAM(k) do { } while (0)
#else
    cg::grid_group grid = cg::this_grid();
#define SEAM(k) do { if (IN(k) && IN((k) + 1)) grid.sync(); } while (0)
#endif
    if (IN(0)) phase0(p, c);
    SEAM(0);
    if (IN(1)) { pg8::DenseOrder S; S.init(MTOK, 5376, 1024, c.G, c.bid, ws + WS_XB, ws + WS_WIN_T);
        pg8::EpiInProj E{(bf16*)(ws + WS_PRKV), (bf16*)(ws + WS_PLR), (bf16*)(ws + WS_PQ), (bf16*)(ws + WS_PK), (bf16*)(ws + WS_PAV), (bf16*)(ws + WS_PG)};
        pg8::gemm_phase<pg8::EpiInProj, pg8::DenseOrder, true, true>(c.lds, 1024, S, E); }
    SEAM(1);
    if (IN(2)) phase2(p, c);
    SEAM(2);
    if (IN(3)) { pg8::DenseOrder S; S.init(MTOK, 1536, 256, c.G, c.bid, ws + WS_ALORA, ws + WS_WLORA_T);
        pg8::EpiPlainBf16 E{(bf16*)(ws + WS_LORA), 1536};
        pg8::gemm_phase<pg8::EpiPlainBf16, pg8::DenseOrder, true, true>(c.lds, 256, S, E); }
    SEAM(3);
    if (IN(4)) phase4(p, c);
    SEAM(4);
    if (IN(5)) {
        for (int item = c.bid; item < 256; item += c.G) scan_item(p, c, item);
        for (int v = c.bid; v < 256; v += c.G) { const int bh = v >> 2, s = v & 3;
#pragma unroll 1
            for (int i = 0; i < 4; ++i) { const int qb = (i == 0) ? s : (i == 1) ? 7 - s : (i == 2) ? 8 + s : 15 - s; att::unit(p, c, bh >> 3, bh & 7, qb); } }
    }
    SEAM(5);
    if (IN(6)) phase6(p, c);
    SEAM(6);
    if (IN(7)) { pg8::DenseOrder S; S.init(MTOK, 1024, 512, c.G, c.bid, ws + WS_YRWKV, ws + WS_WR_T);
        pg8::EpiGateF32 E{(float*)(ws + WS_TMP), (const bf16*)(ws + WS_PG), 0};
        pg8::gemm_phase<pg8::EpiGateF32, pg8::DenseOrder, true, true>(c.lds, 512, S, E); }
    SEAM(7);
    if (IN(8)) { pg8::DenseOrder S; S.init(MTOK, 1024, 512, c.G, c.bid, ws + WS_PQ, ws + WS_WA_T);
        pg8::EpiGateAddBf16 E{(const float*)(ws + WS_TMP), (const bf16*)(ws + WS_PG), 1024, (bf16*)(ws + WS_MERGED)};
        pg8::gemm_phase<pg8::EpiGateAddBf16, pg8::DenseOrder, true, true>(c.lds, 512, S, E); }
    SEAM(8);
    if (IN(9)) { pg8::DenseOrder S; S.init(MTOK, 1024, 1024, c.G, c.bid, ws + WS_MERGED, ws + WS_WO_T);
        pg8::EpiResF32 E{(float*)(ws + WS_XPRE), p.in[0], DN_ALPHA};
        pg8::gemm_phase<pg8::EpiResF32, pg8::DenseOrder, true, true>(c.lds, 1024, S, E); }
    SEAM(9);
    if (IN(10)) phase9(p, c);
    SEAM(10);
    if (IN(11)) phase10(p, c);
    SEAM(11);
    if (IN(12)) { const int* ctl = (const int*)(ws + WS_CTL);
        pg8::MoeOrder S{ctl + CW_TILE_E, ctl[CW_NTILES], 8, c.G, c.bid, (const char*)(ws + WS_XPERM), (const char*)(ws + WS_W1T), (size_t)256 * 1024 * 2, (size_t)2048 * 1024 * 2};
        pg8::EpiSwiglu E{(bf16*)(ws + WS_ACT), p.in[23]};
        pg8::gemm_phase<pg8::EpiSwiglu, pg8::MoeOrder, true, true>(c.lds, 1024, S, E); }
    SEAM(12);
    if (IN(13)) { const int* ctl = (const int*)(ws + WS_CTL);
        pg8::MoeOrder S{ctl + CW_TILE_E, ctl[CW_NTILES], 4, c.G, c.bid, (const char*)(ws + WS_ACT), (const char*)(ws + WS_W2T), (size_t)256 * 1024 * 2, (size_t)1024 * 1024 * 2};
        pg8::EpiMoe2 E{(bf16*)(ws + WS_YBUF), p.in[25], (const float*)(ws + WS_ROWW)};
        pg8::gemm_phase<pg8::EpiMoe2, pg8::MoeOrder, true, true>(c.lds, 1024, S, E); }
    SEAM(13);
    if (IN(14)) phase14(p, c);
#undef IN
#undef SEAM
}

extern "C" void kernel_launch(void* const* d_in, const int* in_sizes, int n_in, void* d_out, int out_size, void* d_ws, size_t ws_size, hipStream_t stream) {
    static int grid = 0;
    if (grid == 0) {
        if (n_in != 26 || in_sizes[0] != MTOK * DMODEL || out_size != MTOK * DMODEL || ws_size < WS_END) {
            fprintf(stderr, "kernel_launch: unexpected shapes / workspace (n_in %d, in0 %d, out %d, ws %zu, need %zu); nothing launched\n", n_in, n_in > 0 ? in_sizes[0] : -1, out_size, ws_size, (size_t)WS_END); grid = -1; return; }
        int dev = 0, cus = 0, per_cu = 0;
        hipGetDevice(&dev); hipDeviceGetAttribute(&cus, hipDeviceAttributeMultiprocessorCount, dev);
        hipFuncSetAttribute((const void*)fwd_megakernel, hipFuncAttributeMaxDynamicSharedMemorySize, LDS_BYTES);
        hipOccupancyMaxActiveBlocksPerMultiprocessor(&per_cu, (const void*)fwd_megakernel, NTHREADS, LDS_BYTES);
        (void)hipGetLastError();
        if (per_cu < 1) { fprintf(stderr, "kernel_launch: occupancy query says %d blocks per CU\n", per_cu); per_cu = 1; }
        grid = cus;
    }
    if (grid < 0) return;
    hipMemsetAsync((char*)d_ws + WS_CTL, 0, CTL_BYTES, stream);
    Params p{};
    for (int i = 0; i < 26; ++i) p.in[i] = (const float*)d_in[i];
    p.out = (float*)d_out; p.ws = (unsigned char*)d_ws;
#if MK_SPLIT
    for (int ph = 0; ph < NPHASE; ++ph) { p.ph_lo = ph; p.ph_hi = ph + 1; hipLaunchKernelGGL(fwd_megakernel, dim3(grid), dim3(NTHREADS), LDS_BYTES, stream, p); }
#else
    p.ph_lo = 0; p.ph_hi = NPHASE;
    void* args[] = {&p};
    hipError_t e = hipLaunchCooperativeKernel((const void*)fwd_megakernel, dim3(grid), dim3(NTHREADS), args, LDS_BYTES, stream);
    if (e != hipSuccess) fprintf(stderr, "cooperative launch failed: %s (grid %d)\n", hipGetErrorString(e), grid);
#endif
}
```

```cpp
#include <hip/hip_runtime.h>
#include <hip/hip_cooperative_groups.h>
#include <cstdio>
#include <cstdint>
namespace cg = cooperative_groups;

namespace pg8 {
#define PG8_LAS __attribute__((address_space(3)))
typedef unsigned short bf16_t;
typedef short bf16x8 __attribute__((ext_vector_type(8)));
typedef float f32x4 __attribute__((ext_vector_type(4)));
typedef float f32x2 __attribute__((ext_vector_type(2)));
typedef unsigned u32x4 __attribute__((ext_vector_type(4)));
typedef unsigned u32x2 __attribute__((ext_vector_type(2)));
constexpr int BM = 256, BK = 64, HALF = 128, HTB = HALF * BK * 2  , STAGE_BYTES = 8 * HTB, NXCD = 8, WGM = 8;

__host__ __device__ __forceinline__ int lds_byte(int r, int c) { const int st = (r >> 4) * 2 + (c >> 5), rr = r & 15, cc = c & 31, ob = rr * 64 + cc * 2; return st * 1024 + (ob ^ (((ob >> 9) & 1) << 5)); }
__host__ __device__ __forceinline__ void stage_rc(int b, int& R, int& C) { const int st = b / 1024, sb = b % 1024, swz = sb ^ (((sb >> 9) & 1) << 5); R = (st >> 1) * 16 + swz / 64; C = (st & 1) * 32 + (swz % 64) / 2; }
__host__ __device__ __forceinline__ int perm32(int rho) { const int n = rho >> 4, i = rho & 15; return 8 * (i >> 2) + 4 * n + (i & 3); }

struct Unit { int pm, pn, aux; const char* A; const char* B; };

struct DenseOrder {
    int nM, nN, nwg, G, c; const char* A; const char* B; size_t tstep;
    __device__ __forceinline__ void init(int M, int N, int K, int G_, int c_, const void* A_, const void* B_) { nM = M / BM; nN = N / BM; nwg = nM * nN; G = G_; c = c_; A = (const char*)A_; B = (const char*)B_; tstep = (size_t)BM * K * 2; }
    __device__ __forceinline__ bool next(int i, Unit& u) const {
        const long L = (long)i * G + c; if (L >= nwg) return false;
        int wgid = (int)L; { const int q = nwg / NXCD, r = nwg % NXCD, xcd = wgid % NXCD, off = wgid / NXCD; wgid = (xcd < r ? xcd * (q + 1) : r * (q + 1) + (xcd - r) * q) + off; }
        const int nig = WGM * nN, gid = wgid / nig, fm = gid * WGM, gsz = (nM - fm) < WGM ? (nM - fm) : WGM;
        u.pm = fm + ((wgid % nig) % gsz); u.pn = (wgid % nig) / gsz; u.aux = 0;
        u.A = A + (size_t)u.pm * tstep; u.B = B + (size_t)u.pn * tstep; return true;
    }
    __device__ __forceinline__ void a_ready(const Unit&) const {}
    __device__ __forceinline__ void done(const Unit&) const {}
};
struct MoeOrder {
    const int* tile_e; int ntiles, npn, G, c; const char* A; const char* B; size_t tstep, estride;
    __device__ __forceinline__ bool next(int i, Unit& u) const {
        const long L = (long)i * G + c; if (L >= (long)ntiles * npn) return false;
        const int tile = (int)(L / npn), pn = (int)(L % npn); const int e = tile_e[tile];
        u.pm = tile; u.pn = pn; u.aux = e; u.A = A + (size_t)tile * tstep; u.B = B + (size_t)e * estride + (size_t)pn * tstep; return true;
    }
    __device__ __forceinline__ void a_ready(const Unit&) const {}
    __device__ __forceinline__ void done(const Unit&) const {}
};

__device__ __forceinline__ unsigned cvt_pk_bf16(float lo, float hi) { unsigned r; asm volatile("v_cvt_pk_bf16_f32 %0, %1, %2" : "=v"(r) : "v"(lo), "v"(hi)); return r; }
__device__ __forceinline__ float bf_lo(unsigned w) { return __builtin_bit_cast(float, w << 16); }
__device__ __forceinline__ float bf_hi(unsigned w) { return __builtin_bit_cast(float, w & 0xffff0000u); }
__device__ __forceinline__ float sigm(float x) { return 1.0f / (1.0f + __expf(-x)); }

__device__ __forceinline__ void st8(bf16_t* p, f32x4 v0, f32x4 v1) { u32x4 w; w.x = cvt_pk_bf16(v0[0], v0[1]); w.y = cvt_pk_bf16(v0[2], v0[3]); w.z = cvt_pk_bf16(v1[0], v1[1]); w.w = cvt_pk_bf16(v1[2], v1[3]); *(u32x4*)p = w; }

struct EpiPlainBf16 {
    static constexpr bool PERM = true, AFTER_DRAIN = false;
    bf16_t* O; int ldc;
    __device__ __forceinline__ void operator()(const f32x4 (&acc)[2][2][4][2], const Unit& u, int wr, int wc, int fr, int fq) const {
        const int row0 = u.pm * BM + wr * 64 + fr, col0 = u.pn * BM + wc * 32 + 8 * fq;
#pragma unroll
        for (int ai = 0; ai < 2; ++ai)
#pragma unroll
            for (int m = 0; m < 4; ++m) { bf16_t* rowp = O + (size_t)(row0 + ai * HALF + m * 16) * ldc + col0;
#pragma unroll
                for (int bj = 0; bj < 2; ++bj) st8(rowp + bj * HALF, acc[ai][bj][m][0], acc[ai][bj][m][1]); }
    }
};
struct EpiInProj {
    static constexpr bool PERM = true, AFTER_DRAIN = false;
    bf16_t *rkv, *lr, *q, *k, *v, *g;
    __device__ __forceinline__ void operator()(const f32x4 (&acc)[2][2][4][2], const Unit& u, int wr, int wc, int fr, int fq) const {
        const int pn = u.pn; bf16_t* base; int ldc, colt;
        if (pn < 6) { base = rkv; ldc = 1536; colt = pn * 256; } else if (pn == 6) { base = lr; ldc = 256; colt = 0; }
        else if (pn < 9) { base = q; ldc = 512; colt = (pn - 7) * 256; } else if (pn < 11) { base = k; ldc = 512; colt = (pn - 9) * 256; }
        else if (pn < 13) { base = v; ldc = 512; colt = (pn - 11) * 256; } else { base = g; ldc = 2048; colt = (pn - 13) * 256; }
        const int row0 = u.pm * BM + wr * 64 + fr, col0 = colt + wc * 32 + 8 * fq;
#pragma unroll
        for (int ai = 0; ai < 2; ++ai)
#pragma unroll
            for (int m = 0; m < 4; ++m) { bf16_t* rowp = base + (size_t)(row0 + ai * HALF + m * 16) * ldc + col0;
#pragma unroll
                for (int bj = 0; bj < 2; ++bj) st8(rowp + bj * HALF, acc[ai][bj][m][0], acc[ai][bj][m][1]); }
    }
};
struct EpiGateF32 {
    static constexpr bool PERM = true, AFTER_DRAIN = false;
    float* T; const bf16_t* G; int goff;
    __device__ __forceinline__ void operator()(const f32x4 (&acc)[2][2][4][2], const Unit& u, int wr, int wc, int fr, int fq) const {
        const int row0 = u.pm * BM + wr * 64 + fr, col0 = u.pn * BM + wc * 32 + 8 * fq;
#pragma unroll
        for (int ai = 0; ai < 2; ++ai)
#pragma unroll
            for (int m = 0; m < 4; ++m) { const size_t row = (size_t)(row0 + ai * HALF + m * 16);
#pragma unroll
                for (int bj = 0; bj < 2; ++bj) { const int col = col0 + bj * HALF; const u32x4 gw = *(const u32x4*)(G + row * 2048 + goff + col);
                    f32x4 a = acc[ai][bj][m][0], b = acc[ai][bj][m][1];
                    a[0] *= sigm(bf_lo(gw.x)); a[1] *= sigm(bf_hi(gw.x)); a[2] *= sigm(bf_lo(gw.y)); a[3] *= sigm(bf_hi(gw.y));
                    b[0] *= sigm(bf_lo(gw.z)); b[1] *= sigm(bf_hi(gw.z)); b[2] *= sigm(bf_lo(gw.w)); b[3] *= sigm(bf_hi(gw.w));
                    *(f32x4*)(T + row * 1024 + col) = a; *(f32x4*)(T + row * 1024 + col + 4) = b; } }
    }
};
struct EpiGateAddBf16 {
    static constexpr bool PERM = true, AFTER_DRAIN = false;
    const float* T; const bf16_t* G; int goff; bf16_t* O;
    __device__ __forceinline__ void operator()(const f32x4 (&acc)[2][2][4][2], const Unit& u, int wr, int wc, int fr, int fq) const {
        const int row0 = u.pm * BM + wr * 64 + fr, col0 = u.pn * BM + wc * 32 + 8 * fq;
#pragma unroll
        for (int ai = 0; ai < 2; ++ai)
#pragma unroll
            for (int m = 0; m < 4; ++m) { const size_t row = (size_t)(row0 + ai * HALF + m * 16);
#pragma unroll
                for (int bj = 0; bj < 2; ++bj) { const int col = col0 + bj * HALF; const u32x4 gw = *(const u32x4*)(G + row * 2048 + goff + col);
                    f32x4 a = acc[ai][bj][m][0], b = acc[ai][bj][m][1]; const f32x4 ta = *(const f32x4*)(T + row * 1024 + col), tb = *(const f32x4*)(T + row * 1024 + col + 4);
                    a[0] = ta[0] + a[0] * sigm(bf_lo(gw.x)); a[1] = ta[1] + a[1] * sigm(bf_hi(gw.x)); a[2] = ta[2] + a[2] * sigm(bf_lo(gw.y)); a[3] = ta[3] + a[3] * sigm(bf_hi(gw.y));
                    b[0] = tb[0] + b[0] * sigm(bf_lo(gw.z)); b[1] = tb[1] + b[1] * sigm(bf_hi(gw.z)); b[2] = tb[2] + b[2] * sigm(bf_lo(gw.w)); b[3] = tb[3] + b[3] * sigm(bf_hi(gw.w));
                    st8(O + row * 1024 + col, a, b); } }
    }
};
struct EpiResF32 {
    static constexpr bool PERM = false, AFTER_DRAIN = false;
    float* C; const float* X; float alpha;
    __device__ __forceinline__ void operator()(const f32x4 (&acc)[2][2][4][2], const Unit& u, int wr, int wc, int fr, int fq) const {
        const int row0 = u.pm * BM + wr * 64 + fr, col0 = u.pn * BM + wc * 32 + 4 * fq;
#pragma unroll
        for (int ai = 0; ai < 2; ++ai)
#pragma unroll
            for (int m = 0; m < 4; ++m) { const size_t off = (size_t)(row0 + ai * HALF + m * 16) * 1024 + col0;
#pragma unroll
                for (int bj = 0; bj < 2; ++bj)
#pragma unroll
                    for (int n = 0; n < 2; ++n) { const f32x4 xv = *(const f32x4*)(X + off + bj * HALF + n * 16); *(f32x4*)(C + off + bj * HALF + n * 16) = acc[ai][bj][m][n] + xv * alpha; } }
    }
};
struct EpiSwiglu {
    static constexpr bool PERM = true, AFTER_DRAIN = false;
    bf16_t* O; const float* bin;
    __device__ __forceinline__ void operator()(const f32x4 (&acc)[2][2][4][2], const Unit& u, int wr, int wc, int fr, int fq) const {
        const int row0 = u.pm * BM + wr * 64 + fr, c0 = u.pn * HALF + wc * 32 + 8 * fq; const float* bb = bin + (size_t)u.aux * 2048 + c0;
        const f32x4 bg0 = *(const f32x4*)(bb), bg1 = *(const f32x4*)(bb + 4), bl0 = *(const f32x4*)(bb + 1024), bl1 = *(const f32x4*)(bb + 1028);
#pragma unroll
        for (int ai = 0; ai < 2; ++ai)
#pragma unroll
            for (int m = 0; m < 4; ++m) { const size_t row = (size_t)(row0 + ai * HALF + m * 16);
                f32x4 o0, o1; const f32x4 g0 = acc[ai][0][m][0] + bg0, g1 = acc[ai][0][m][1] + bg1, l0 = acc[ai][1][m][0] + bl0, l1 = acc[ai][1][m][1] + bl1;
#pragma unroll
                for (int j = 0; j < 4; ++j) { const float ga = fminf(g0[j], 7.0f), la = fminf(fmaxf(l0[j], -7.0f), 7.0f); o0[j] = ga * sigm(1.702f * ga) * (la + 1.0f);
                                              const float gb = fminf(g1[j], 7.0f), lb = fminf(fmaxf(l1[j], -7.0f), 7.0f); o1[j] = gb * sigm(1.702f * gb) * (lb + 1.0f); }
                st8(O + row * 1024 + c0, o0, o1); }
    }
};
struct EpiMoe2 {
    static constexpr bool PERM = true, AFTER_DRAIN = false;
    bf16_t* O; const float* bout; const float* roww;
    __device__ __forceinline__ void operator()(const f32x4 (&acc)[2][2][4][2], const Unit& u, int wr, int wc, int fr, int fq) const {
        const int row0 = u.pm * BM + wr * 64 + fr, col0 = u.pn * BM + wc * 32 + 8 * fq; const float* bb = bout + (size_t)u.aux * 1024 + col0;
        f32x4 bv[2][2];
#pragma unroll
        for (int bj = 0; bj < 2; ++bj) { bv[bj][0] = *(const f32x4*)(bb + bj * HALF); bv[bj][1] = *(const f32x4*)(bb + bj * HALF + 4); }
#pragma unroll
        for (int ai = 0; ai < 2; ++ai)
#pragma unroll
            for (int m = 0; m < 4; ++m) { const size_t row = (size_t)(row0 + ai * HALF + m * 16); const float w = roww[row];
#pragma unroll
                for (int bj = 0; bj < 2; ++bj) st8(O + row * 1024 + col0 + bj * HALF, (acc[ai][bj][m][0] + bv[bj][0]) * w, (acc[ai][bj][m][1] + bv[bj][1]) * w); }
    }
};

template <class Epi, class Sched, bool ALIGN_EPI = false, bool SP2 = false>
__device__ __forceinline__ void gemm_phase(PG8_LAS unsigned char* lds, const int K, const Sched& S, const Epi& E) {
    const int tid = threadIdx.x, wid = __builtin_amdgcn_readfirstlane(tid >> 6), lane = tid & 63, wr = wid >> 2, wc = wid & 3, fr = lane & 15, fq = lane >> 4;
    const int nt = K / BK;
    unsigned voffA[2], voffB[2];
#pragma unroll
    for (int i = 0; i < 2; ++i) { int R, C; stage_rc(tid * 16 + i * 8192, R, C); const int Rb = Epi::PERM ? ((R & ~31) + perm32(R & 31)) : R;
        voffA[i] = (unsigned)(R * K + C) * 2u; voffB[i] = (unsigned)(Rb * K + C) * 2u; }
    const size_t kstep = (size_t)(BK * 2);
    const size_t hstep = (size_t)HALF * K * 2;
    const unsigned ldsw = (unsigned)wid * 1024u;
    const int aoff = lds_byte(wr * 64 + fr, fq * 8), boff = lds_byte(wc * 32 + fr, fq * 8);
#define PG8_SA(b, h) (((b) * 2 + (h)) * HTB)
#define PG8_SB(b, h) ((4 + (b) * 2 + (h)) * HTB)
#define PG8_STAGE(bufoff, gbase, voff) do { _Pragma("unroll") for (int _i = 0; _i < 2; ++_i) \
        __builtin_amdgcn_global_load_lds((const unsigned*)((const char*)(gbase) + (voff)[_i]), (PG8_LAS unsigned*)(lds + (bufoff) + ldsw + _i * 8192), 16, 0, 0); } while (0)
#define PG8_LDA(dst, b, h) do { _Pragma("unroll") for (int m = 0; m < 4; ++m) _Pragma("unroll") for (int k = 0; k < 2; ++k) dst[m][k] = *(const PG8_LAS bf16x8*)(lds + PG8_SA(b, h) + aoff + m * 2048 + k * 1024); } while (0)
#define PG8_LDB(dst, b, h) do { _Pragma("unroll") for (int n = 0; n < 2; ++n) _Pragma("unroll") for (int k = 0; k < 2; ++k) dst[n][k] = *(const PG8_LAS bf16x8*)(lds + PG8_SB(b, h) + boff + n * 2048 + k * 1024); } while (0)
#define PG8_MMA(ai, bj, At, Bt) do { __builtin_amdgcn_s_setprio(1); _Pragma("unroll") for (int m = 0; m < 4; ++m) _Pragma("unroll") for (int n = 0; n < 2; ++n) _Pragma("unroll") for (int k = 0; k < 2; ++k) \
        acc[ai][bj][m][n] = __builtin_amdgcn_mfma_f32_16x16x32_bf16(Bt[n][k], At[m][k], acc[ai][bj][m][n], 0, 0, 0); __builtin_amdgcn_s_setprio(0); } while (0)
#define PG8_WAIT_V(n) asm volatile("s_waitcnt vmcnt(" #n ")" ::: "memory")
#define PG8_WAIT_L(n) asm volatile("s_waitcnt lgkmcnt(" #n ")" ::: "memory")
#define PG8_BAR __builtin_amdgcn_s_barrier()
#define PG8_SCHED __builtin_amdgcn_sched_barrier(0)
    Unit cur, nxt; int ui = 0;
    if (!S.next(0, cur)) return;
    f32x4 acc[2][2][4][2];
#pragma unroll
    for (int a = 0; a < 2; ++a)
#pragma unroll
        for (int b = 0; b < 2; ++b)
#pragma unroll
            for (int m = 0; m < 4; ++m)
#pragma unroll
                for (int n = 0; n < 2; ++n) acc[a][b][m][n] = (f32x4){0.f, 0.f, 0.f, 0.f};
    bf16x8 At[4][2], B0[2][2], B1[2][2];
    const char* cA = cur.A; const char* cB = cur.B;
    S.a_ready(cur);
    if constexpr (SP2) {
        PG8_STAGE(PG8_SB(0, 0), cB, voffB); PG8_STAGE(PG8_SB(0, 1), cB + hstep, voffB); PG8_STAGE(PG8_SA(0, 0), cA, voffA); PG8_STAGE(PG8_SA(0, 1), cA + hstep, voffA);
        if (wr == 1) PG8_BAR;
        PG8_WAIT_V(2); PG8_BAR;
        PG8_STAGE(PG8_SB(1, 0), cB + kstep, voffB); PG8_STAGE(PG8_SA(1, 0), cA + kstep, voffA); PG8_STAGE(PG8_SB(1, 1), cB + hstep + kstep, voffB);
        PG8_WAIT_V(6); PG8_BAR;
    } else {
        PG8_STAGE(PG8_SB(0, 0), cB, voffB); PG8_STAGE(PG8_SA(0, 0), cA, voffA); PG8_STAGE(PG8_SB(0, 1), cB + hstep, voffB); PG8_STAGE(PG8_SA(0, 1), cA + hstep, voffA);
        if (wr == 1) PG8_BAR;
        PG8_WAIT_V(4); PG8_BAR;
        PG8_STAGE(PG8_SB(1, 0), cB + kstep, voffB); PG8_STAGE(PG8_SA(1, 0), cA + kstep, voffA); PG8_STAGE(PG8_SB(1, 1), cB + hstep + kstep, voffB);
        PG8_WAIT_V(6); PG8_BAR;
    }
    for (;;) {
        const bool has_next = S.next(ui + 1, nxt);
        const char* nA = has_next ? nxt.A : cA; const char* nB = has_next ? nxt.B : cB;
#pragma unroll 1
        for (int t = 0; t < nt; t += 2) {
            const bool last = (t == nt - 2);
            const char* a1 = cA + (size_t)(t + 1) * kstep;
            const char* a2 = last ? nA : cA + (size_t)(t + 2) * kstep; const char* b2 = last ? nB : cB + (size_t)(t + 2) * kstep;
            const char* a3 = a2 + kstep; const char* b3 = b2 + kstep;
            if (last && has_next) S.a_ready(nxt);
            if constexpr (SP2) {
            PG8_LDB(B0, 0, 0); PG8_LDB(B1, 0, 1); PG8_SCHED; PG8_LDA(At, 0, 0); PG8_STAGE(PG8_SA(1, 1), a1 + hstep, voffA);
            PG8_WAIT_V(8); PG8_WAIT_L(0); PG8_BAR; PG8_MMA(0, 0, At, B0); PG8_MMA(0, 1, At, B1); PG8_BAR; PG8_SCHED;
            PG8_LDA(At, 0, 1); PG8_STAGE(PG8_SB(0, 0), b2, voffB); PG8_STAGE(PG8_SB(0, 1), b2 + hstep, voffB); PG8_STAGE(PG8_SA(0, 0), a2, voffA);
            PG8_WAIT_V(8); PG8_WAIT_L(0); PG8_BAR; PG8_MMA(1, 0, At, B0); PG8_MMA(1, 1, At, B1); PG8_BAR; PG8_SCHED;
            PG8_LDB(B0, 1, 0); PG8_LDB(B1, 1, 1); PG8_SCHED; PG8_LDA(At, 1, 0); PG8_STAGE(PG8_SA(0, 1), a2 + hstep, voffA);
            PG8_WAIT_V(8); PG8_WAIT_L(0); PG8_BAR; PG8_MMA(0, 0, At, B0); PG8_MMA(0, 1, At, B1); PG8_BAR; PG8_SCHED;
            PG8_LDA(At, 1, 1); PG8_STAGE(PG8_SB(1, 0), b3, voffB); PG8_STAGE(PG8_SB(1, 1), b3 + hstep, voffB); PG8_STAGE(PG8_SA(1, 0), a3, voffA);
            PG8_WAIT_V(8); PG8_WAIT_L(0); PG8_BAR; PG8_MMA(1, 0, At, B0); PG8_MMA(1, 1, At, B1); PG8_BAR; PG8_SCHED;
            } else {
            PG8_LDB(B0, 0, 0); PG8_SCHED; PG8_LDA(At, 0, 0); PG8_STAGE(PG8_SA(1, 1), a1 + hstep, voffA);
            PG8_WAIT_L(8); PG8_BAR; PG8_WAIT_L(0); PG8_MMA(0, 0, At, B0); PG8_BAR; PG8_SCHED;
            PG8_LDB(B1, 0, 1); PG8_STAGE(PG8_SB(0, 0), b2, voffB);
            PG8_BAR; PG8_WAIT_L(0); PG8_MMA(0, 1, At, B1); PG8_BAR;
            PG8_LDA(At, 0, 1); PG8_STAGE(PG8_SA(0, 0), a2, voffA);
            PG8_BAR; PG8_WAIT_L(0); PG8_MMA(1, 0, At, B0); PG8_BAR; PG8_SCHED;
            PG8_STAGE(PG8_SB(0, 1), b2 + hstep, voffB);
            PG8_WAIT_V(6); PG8_BAR; PG8_MMA(1, 1, At, B1); PG8_BAR;
            PG8_LDB(B0, 1, 0); PG8_SCHED; PG8_LDA(At, 1, 0); PG8_STAGE(PG8_SA(0, 1), a2 + hstep, voffA);
            PG8_WAIT_L(8); PG8_BAR; PG8_WAIT_L(0); PG8_MMA(0, 0, At, B0); PG8_BAR; PG8_SCHED;
            PG8_LDB(B1, 1, 1); PG8_STAGE(PG8_SB(1, 0), b3, voffB);
            PG8_BAR; PG8_WAIT_L(0); PG8_MMA(0, 1, At, B1); PG8_BAR;
            PG8_LDA(At, 1, 1); PG8_STAGE(PG8_SA(1, 0), a3, voffA);
            PG8_BAR; PG8_WAIT_L(0); PG8_MMA(1, 0, At, B0); PG8_BAR; PG8_SCHED;
            PG8_STAGE(PG8_SB(1, 1), b3 + hstep, voffB);
            PG8_WAIT_V(6); PG8_BAR; PG8_MMA(1, 1, At, B1); PG8_BAR;
            }
        }
        if constexpr (ALIGN_EPI) { if (wr == 0) PG8_BAR; }
        if constexpr (!Epi::AFTER_DRAIN) { E(acc, cur, wr, wc, fr, fq); S.done(cur); }
        if (!has_next) break;
#pragma unroll
        for (int a = 0; a < 2; ++a)
#pragma unroll
            for (int b = 0; b < 2; ++b)
#pragma unroll
                for (int m = 0; m < 4; ++m)
#pragma unroll
                    for (int n = 0; n < 2; ++n) acc[a][b][m][n] = (f32x4){0.f, 0.f, 0.f, 0.f};
        cur = nxt; cA = nA; cB = nB; ++ui;
        if constexpr (ALIGN_EPI) { if (wr == 1) PG8_BAR; }
    }
    PG8_WAIT_V(0);
    if constexpr (!ALIGN_EPI) { if (wr == 0) PG8_BAR; }
    PG8_BAR;
    if constexpr (Epi::AFTER_DRAIN) { E.fused(acc, cur, wr, wc, fr, fq, lds, wid, lane); S.done(cur); }
#undef PG8_SA
#undef PG8_SB
#undef PG8_STAGE
#undef PG8_LDA
#undef PG8_LDB
#undef PG8_MMA
#undef PG8_WAIT_V
#undef PG8_WAIT_L
#undef PG8_BAR
#undef PG8_SCHED
}
}


#define LAS __attribute__((address_space(3)))
typedef unsigned short bf16;
typedef float f32x4 __attribute__((ext_vector_type(4)));
typedef float f32x2 __attribute__((ext_vector_type(2)));
typedef float f32x16 __attribute__((ext_vector_type(16)));
typedef unsigned u32x4 __attribute__((ext_vector_type(4)));
typedef unsigned u32x2 __attribute__((ext_vector_type(2)));
typedef short bf16x8 __attribute__((ext_vector_type(8)));
typedef short s16x4 __attribute__((ext_vector_type(4)));

constexpr int NB = 8, SEQ = 4096, DMODEL = 1024, MTOK = NB * SEQ, NHEAD = 8, HDIM = 64, BRD = 512;
constexpr int NEXP = 32, TOPK = 4, MAXTILES = 544, MAXSLOTS = MAXTILES * 256;
constexpr float DN_ALPHA = 1.189207115002721f, LN_EPS = 1e-5f, GN_EPS = 64e-5f;
constexpr int NWAVES = 8, NTHREADS = 512;
constexpr int LDS_BYTES = 155648;

constexpr size_t MiB = 1u << 20;
constexpr size_t WS_CTL = 0, CTL_BYTES = 128 * 1024;
constexpr size_t WS_WIN_T = 1 * MiB, WS_WLORA_T = 12 * MiB, WS_WR_T = 13 * MiB, WS_WA_T = 14 * MiB, WS_WO_T = 15 * MiB, WS_W1T = 17 * MiB, WS_W2T = 145 * MiB;
constexpr size_t WS_KMEAN = 209 * MiB, WS_TOKE = 210 * MiB, WS_TOKW = 210 * MiB + 512 * 1024, WS_SLOTOF = 211 * MiB, WS_ROWTOK = 212 * MiB, WS_ROWW = 213 * MiB;
constexpr size_t WS_D = 216 * MiB;
constexpr size_t WS_PG = WS_D, WS_PQ = WS_D + 128 * MiB, WS_PK = WS_D + 160 * MiB, WS_PAV = WS_D + 192 * MiB, WS_PRKV = WS_D + 224 * MiB, WS_PLR = WS_D + 320 * MiB;
constexpr size_t WS_LORA = WS_D + 320 * MiB, WS_ALORA = WS_D + 416 * MiB, WS_XB = WS_D + 432 * MiB, WS_BONUS = WS_D + 416 * MiB;
constexpr size_t WS_YRAW = WS_D + 480 * MiB, WS_YRWKV = WS_D + 288 * MiB, WS_TMP = WS_D + 416 * MiB, WS_MERGED = WS_D + 544 * MiB, WS_XPRE = WS_D + 608 * MiB;
constexpr size_t WS_X1 = WS_D, WS_X1B = WS_D + 128 * MiB, WS_XPERM = WS_D + 192 * MiB, WS_ACT = WS_D + 464 * MiB, WS_YBUF = WS_D + 192 * MiB;
constexpr size_t WS_END = WS_D + 800 * MiB;
constexpr int CW_COUNT = 0, CW_NTILES = 64, CW_TILE_E = 128, CW_WGBASE = 1024, CW_XBAR = 16384;

struct Params { const float* in[26]; float* out; unsigned char* ws; int ph_lo, ph_hi; };
struct Ctx { LAS unsigned char* lds; int tid, lane, wave, gw, ngw, G, bid; };

__device__ __forceinline__ unsigned f2bf(float f) { unsigned u = __builtin_bit_cast(unsigned, f); return (u + 0x7fffu + ((u >> 16) & 1u)) >> 16; }
__device__ __forceinline__ unsigned pk2(float lo, float hi) { return f2bf(lo) | (f2bf(hi) << 16); }
__device__ __forceinline__ float bf2f(bf16 v) { return __builtin_bit_cast(float, (unsigned)v << 16); }
__device__ __forceinline__ float bflo(unsigned w) { return __builtin_bit_cast(float, w << 16); }
__device__ __forceinline__ float bfhi(unsigned w) { return __builtin_bit_cast(float, w & 0xffff0000u); }
__device__ __forceinline__ float wave_sum(float v) {
#pragma unroll
    for (int o = 1; o < 64; o <<= 1) v += __shfl_xor(v, o);
    return v;
}
__device__ __forceinline__ float sigmf(float x) { return 1.0f / (1.0f + __expf(-x)); }

__device__ __forceinline__ void transpose_item(const float* W, int K, int N, bf16* WT, int k0, int n0, int dst_row0, LAS float* scr, int lane) {
#pragma unroll 8
    for (int i = 0; i < 32; ++i) { const int kk = 2 * i + (lane >> 5); scr[kk * 33 + (lane & 31)] = W[(size_t)(k0 + kk) * N + n0 + (lane & 31)]; }
    asm volatile("s_waitcnt lgkmcnt(0)" ::: "memory");
    const int c = lane & 7;
#pragma unroll
    for (int j = 0; j < 4; ++j) { const int n = (lane >> 3) + 8 * j; const LAS float* s = scr + (8 * c) * 33 + n;
        u32x4 o; o.x = pk2(s[0 * 33], s[1 * 33]); o.y = pk2(s[2 * 33], s[3 * 33]); o.z = pk2(s[4 * 33], s[5 * 33]); o.w = pk2(s[6 * 33], s[7 * 33]);
        *(u32x4*)(WT + (size_t)(dst_row0 + n) * K + k0 + 8 * c) = o; }
    asm volatile("s_waitcnt lgkmcnt(0)" ::: "memory");
}
__device__ __forceinline__ void phase0(const Params& p, const Ctx& c) {
    unsigned char* ws = p.ws;
    LAS float* scr = (LAS float*)(c.lds + c.wave * 16384);
    constexpr int I0 = 16 * 168, I1 = 8 * 32, I2 = 8 * 32, I3 = 16 * 32, I4 = 32 * 1024, I5 = 32 * 512, NIT = I0 + I1 + I2 + I3 + I4 + I5;
    for (int it = c.gw; it < NIT; it += c.ngw) {
        int r = it;
        if (r < I0) { transpose_item(p.in[5], 1024, 5376, (bf16*)(ws + WS_WIN_T), 64 * (r / 168), 32 * (r % 168), 32 * (r % 168), scr, c.lane); continue; } r -= I0;
        if (r < I1) { transpose_item(p.in[17], 512, 1024, (bf16*)(ws + WS_WR_T), 64 * (r / 32), 32 * (r % 32), 32 * (r % 32), scr, c.lane); continue; } r -= I1;
        if (r < I2) { transpose_item(p.in[18], 512, 1024, (bf16*)(ws + WS_WA_T), 64 * (r / 32), 32 * (r % 32), 32 * (r % 32), scr, c.lane); continue; } r -= I2;
        if (r < I3) { transpose_item(p.in[19], 1024, 1024, (bf16*)(ws + WS_WO_T), 64 * (r / 32), 32 * (r % 32), 32 * (r % 32), scr, c.lane); continue; } r -= I3;
        if (r < I4) { const int e = r >> 10, rr = r & 1023, n0 = 32 * (rr & 63);
            const int dst = n0 < 1024 ? (n0 >> 7) * 256 + (n0 & 127) : ((n0 - 1024) >> 7) * 256 + 128 + ((n0 - 1024) & 127);
            transpose_item(p.in[22] + (size_t)e * 1024 * 2048, 1024, 2048, (bf16*)(ws + WS_W1T) + (size_t)e * 2048 * 1024, 64 * (rr >> 6), n0, dst, scr, c.lane); continue; } r -= I4;
        { const int e = r >> 9, rr = r & 511; transpose_item(p.in[24] + (size_t)e * 1024 * 1024, 1024, 1024, (bf16*)(ws + WS_W2T) + (size_t)e * 1024 * 1024, 64 * (rr >> 5), 32 * (rr & 31), 32 * (rr & 31), scr, c.lane); }
    }
    const int gt = c.bid * NTHREADS + c.tid, ngt = c.G * NTHREADS;
    { bf16* WL = (bf16*)(ws + WS_WLORA_T); const float* du = p.in[8]; const float* iu = p.in[10]; const float* gu = p.in[11];
      for (int i = gt; i < 1536 * 256; i += ngt) { const int n = i >> 8, k = i & 255; float v = 0.f;
          if (n < 512) { if (k < 64) v = du[k * 512 + n]; } else if (n < 1024) { if (k >= 64 && k < 128) v = iu[(k - 64) * 512 + (n - 512)]; } else { if (k >= 128) v = gu[(k - 128) * 512 + (n - 1024)]; }
          WL[i] = (bf16)f2bf(v); } }
    { const f32x4* x4 = (const f32x4*)p.in[0]; u32x2* o = (u32x2*)(ws + WS_XB);
      for (int i = gt; i < MTOK * DMODEL / 4; i += ngt) { const f32x4 v = x4[i]; u32x2 w; w.x = pk2(v[0], v[1]); w.y = pk2(v[2], v[3]); o[i] = w; } }
}

__device__ __forceinline__ void phase2(const Params& p, const Ctx& c) {
    unsigned char* ws = p.ws;
    { const bf16* PLR = (const bf16*)(ws + WS_PLR); bf16* AL = (bf16*)(ws + WS_ALORA); const float* mix = p.in[6] + 1536;
      const int j0 = c.lane * 4; const f32x4 mx = *(const f32x4*)(mix + j0);
      for (int m = c.gw; m < MTOK; m += c.ngw) {
          const u32x2 cu = *(const u32x2*)(PLR + (size_t)m * 256 + j0); u32x2 pv; pv.x = 0u; pv.y = 0u;
          if ((m & (SEQ - 1)) != 0) pv = *(const u32x2*)(PLR + (size_t)(m - 1) * 256 + j0);
          float s[4] = {bflo(cu.x), bfhi(cu.x), bflo(cu.y), bfhi(cu.y)}; const float q[4] = {bflo(pv.x), bfhi(pv.x), bflo(pv.y), bfhi(pv.y)};
#pragma unroll
          for (int i = 0; i < 4; ++i) { s[i] = s[i] + (q[i] - s[i]) * mx[i]; if (c.lane < 16) s[i] = tanhf(s[i]); else if (c.lane >= 32) s[i] = sigmf(s[i]); }
          u32x2 o; o.x = pk2(s[0], s[1]); o.y = pk2(s[2], s[3]); *(u32x2*)(AL + (size_t)m * 256 + j0) = o; } }
    for (int item = c.bid; item < NB * 16; item += c.G) {
        const int b = item >> 4, blk = item & 15; bf16* Q = (bf16*)(ws + WS_PQ); bf16* K = (bf16*)(ws + WS_PK); float* KM = (float*)(ws + WS_KMEAN);
        const size_t m0 = (size_t)b * SEQ + blk * 256;
        { const int col = c.tid, h = col >> 6, d = col & 63; float s0 = 0.f, s1 = 0.f;
          if (d < 8) { const float invf = powf(500000.0f, -(float)d * 0.125f);
#pragma unroll 4
              for (int tok = 0; tok < 256; ++tok) { float sn, cs; sincosf((float)(blk * 256 + tok) * invf, &sn, &cs);
                  const float y1 = bf2f(K[(m0 + tok) * 512 + col]), y2 = bf2f(K[(m0 + tok) * 512 + col + 8]); s0 += y1 * cs - y2 * sn; s1 += y2 * cs + y1 * sn; }
              float* km = KM + ((size_t)((b * 8 + h) * 16 + blk)) * 64; km[d] = s0 * (1.0f / 256.0f); km[d + 8] = s1 * (1.0f / 256.0f);
          } else if (d >= 16) {
#pragma unroll 8
              for (int tok = 0; tok < 256; ++tok) s0 += bf2f(K[(m0 + tok) * 512 + col]);
              KM[((size_t)((b * 8 + h) * 16 + blk)) * 64 + d] = s0 * (1.0f / 256.0f); } }
        __syncthreads();
#pragma unroll 4
        for (int it = 0; it < 64; ++it) { const int task = it * NTHREADS + c.tid; const int i = task & 7, h = (task >> 3) & 7, which = (task >> 6) & 1, tok = task >> 7;
            bf16* P = (which ? K : Q) + (m0 + tok) * 512 + h * 64 + i; const float invf = powf(500000.0f, -(float)i * 0.125f);
            float sn, cs; sincosf((float)(blk * 256 + tok) * invf, &sn, &cs); const float x1 = bf2f(P[0]), x2 = bf2f(P[8]);
            P[0] = (bf16)f2bf(x1 * cs - x2 * sn); P[8] = (bf16)f2bf(x2 * cs + x1 * sn); }
        __syncthreads();
    }
}

template <int CTRL> __device__ __forceinline__ float dppf(float x) { return __builtin_bit_cast(float, __builtin_amdgcn_update_dpp(0, __builtin_bit_cast(int, x), CTRL, 0xF, 0xF, true)); }
__device__ __forceinline__ float row16_sum(float x) {
    x += dppf<0xB1>(x);
    x += dppf<0x4E>(x);
    x += dppf<0x141>(x);
    x += dppf<0x140>(x);
    return x;
}
constexpr int SCAN_TC = 32, SCAN_CHUNK_F = SCAN_TC * 384;
__device__ __forceinline__ f32x4 unpk4(u32x2 w) { return (f32x4){bflo(w.x), bfhi(w.x), bflo(w.y), bfhi(w.y)}; }
struct PrepConst { f32x4 mr, mk, mv, w0, a0, kk, ka, rk; };
__device__ __forceinline__ void prep_load(u32x2 (&raw)[8], const bf16* RKVh, const bf16* LOh, size_t m, bool has_prev) {
    const bf16* row = RKVh + m * 1536;
    raw[0] = *(const u32x2*)(row); raw[1] = *(const u32x2*)(row + 512); raw[2] = *(const u32x2*)(row + 1024);
    u32x2 z; z.x = 0u; z.y = 0u; raw[3] = z; raw[4] = z; raw[5] = z;
    if (has_prev) { raw[3] = *(const u32x2*)(row - 1536); raw[4] = *(const u32x2*)(row - 1536 + 512); raw[5] = *(const u32x2*)(row - 1536 + 1024); }
    raw[6] = *(const u32x2*)(LOh + m * 1536); raw[7] = *(const u32x2*)(LOh + m * 1536 + 512);
}
__device__ __forceinline__ void prep_pass(const u32x2 (&raw)[8], const PrepConst& k, LAS float* dst  , float* bonus  ) {
    f32x4 r = unpk4(raw[0]), kx = unpk4(raw[1]), v = unpk4(raw[2]); const f32x4 rp = unpk4(raw[3]), kp = unpk4(raw[4]), vp = unpk4(raw[5]), lw = unpk4(raw[6]), la = unpk4(raw[7]);
    r = r + (rp - r) * k.mr; kx = kx + (kp - kx) * k.mk; v = v + (vp - v) * k.mv;
    f32x4 dec, a;
#pragma unroll
    for (int i = 0; i < 4; ++i) { const float sg = 1.0f / (1.0f + __expf(-(k.w0[i] + lw[i]))); dec[i] = __expf(-0.6065306597126334f * sg); a[i] = 1.0f / (1.0f + __expf(-(k.a0[i] + la[i]))); }
    const f32x4 kkv = kx * k.kk; float ss = (kkv[0] * kkv[0] + kkv[1] * kkv[1]) + (kkv[2] * kkv[2] + kkv[3] * kkv[3]); ss = row16_sum(ss);
    const float inv = 1.0f / fmaxf(sqrtf(ss), 1e-12f); const f32x4 kk = kkv * inv; const f32x4 kmod = kx * ((a - 1.0f) * k.ka + 1.0f);
    const f32x4 rb = r * kmod * k.rk; float bs = (rb[0] + rb[1]) + (rb[2] + rb[3]); bs = row16_sum(bs);
    *(LAS f32x4*)(dst) = -kk; *(LAS f32x4*)(dst + 64) = kk * a; *(LAS f32x4*)(dst + 128) = dec; *(LAS f32x4*)(dst + 192) = kmod; *(LAS f32x4*)(dst + 256) = r; *(LAS f32x4*)(dst + 320) = v;
    if (bonus) *(f32x4*)bonus = v * bs;
}
__device__ __forceinline__ void scan_item(const Params& p, const Ctx& c, int item) {
    const int bh = item >> 2, rg = item & 3, b = bh >> 3, h = bh & 7;
    LAS float* buf = (LAS float*)c.lds;
    constexpr int NC = SEQ / SCAN_TC;
    const int pt = c.tid & 255, tl = pt >> 4, cq = pt & 15, ch0 = h * 64 + 4 * cq;
    const bf16* RKVh = (const bf16*)(p.ws + WS_PRKV) + ch0; const bf16* LOh = (const bf16*)(p.ws + WS_LORA) + ch0; float* BON = (float*)(p.ws + WS_BONUS) + ch0;
    const size_t mb = (size_t)b * SEQ;
    PrepConst pc; u32x2 raw0[8], raw1[8];
    const int rowl = (c.wave & 3) * 4 + (c.lane >> 4), kq = c.lane & 15, rowg = rg * 16 + rowl;
    f32x4 S = {0.f, 0.f, 0.f, 0.f};
    if (c.wave >= 4) {
        pc.mr = *(const f32x4*)(p.in[6] + ch0); pc.mk = *(const f32x4*)(p.in[6] + 512 + ch0); pc.mv = *(const f32x4*)(p.in[6] + 1024 + ch0);
        pc.w0 = *(const f32x4*)(p.in[7] + ch0); pc.a0 = *(const f32x4*)(p.in[9] + ch0); pc.kk = *(const f32x4*)(p.in[12] + ch0); pc.ka = *(const f32x4*)(p.in[13] + ch0); pc.rk = *(const f32x4*)(p.in[14] + ch0);
        prep_load(raw0, RKVh, LOh, mb + tl, tl != 0); prep_load(raw1, RKVh, LOh, mb + 16 + tl, true);
        prep_pass(raw0, pc, buf + tl * 384 + 4 * cq, rg == 0 ? BON + (mb + tl) * 512 : nullptr);
        prep_pass(raw1, pc, buf + (16 + tl) * 384 + 4 * cq, rg == 0 ? BON + (mb + 16 + tl) * 512 : nullptr);
        prep_load(raw0, RKVh, LOh, mb + SCAN_TC + tl, true); prep_load(raw1, RKVh, LOh, mb + SCAN_TC + 16 + tl, true);
    }
    __syncthreads();
    for (int ch = 0; ch < NC; ++ch) {
        if (c.wave < 4) {
            const LAS float* cb = buf + (ch & 1) * SCAN_CHUNK_F;
            float* yo = (float*)(p.ws + WS_YRAW) + (mb + (size_t)ch * SCAN_TC + kq) * 512 + h * 64 + rowg;
            f32x4 nk = *(const LAS f32x4*)(cb + 4 * kq), ka = *(const LAS f32x4*)(cb + 64 + 4 * kq), w = *(const LAS f32x4*)(cb + 128 + 4 * kq);
            f32x4 km = *(const LAS f32x4*)(cb + 192 + 4 * kq), rr = *(const LAS f32x4*)(cb + 256 + 4 * kq); float v = cb[320 + rowg];
            float ykeep = 0.f;
#pragma unroll
            for (int s = 0; s < SCAN_TC; ++s) {
                f32x4 nk2 = nk, ka2 = ka, w2 = w, km2 = km, rr2 = rr; float v2 = v;
                if (s + 1 < SCAN_TC) { const LAS float* op = cb + (s + 1) * 384;
                    nk2 = *(const LAS f32x4*)(op + 4 * kq); ka2 = *(const LAS f32x4*)(op + 64 + 4 * kq); w2 = *(const LAS f32x4*)(op + 128 + 4 * kq);
                    km2 = *(const LAS f32x4*)(op + 192 + 4 * kq); rr2 = *(const LAS f32x4*)(op + 256 + 4 * kq); v2 = op[320 + rowg]; }
                __builtin_amdgcn_sched_barrier(0);
                float sa = (S[0] * nk[0] + S[1] * nk[1]) + (S[2] * nk[2] + S[3] * nk[3]);
                const f32x4 T = S * w + km * v;
                sa = row16_sum(sa);
                S = T + ka * sa;
                float y = (S[0] * rr[0] + S[1] * rr[1]) + (S[2] * rr[2] + S[3] * rr[3]);
                y = row16_sum(y);
                ykeep = (kq == (s & 15)) ? y : ykeep;
                if ((s & 15) == 15) yo[(size_t)(s - 15) * 512] = ykeep;
                nk = nk2; ka = ka2; w = w2; km = km2; rr = rr2; v = v2;
            }
        } else if (ch + 1 < NC) {
            LAS float* nb = buf + ((ch + 1) & 1) * SCAN_CHUNK_F; const size_t m1 = mb + (size_t)(ch + 1) * SCAN_TC;
            prep_pass(raw0, pc, nb + tl * 384 + 4 * cq, rg == 0 ? BON + (m1 + tl) * 512 : nullptr);
            prep_pass(raw1, pc, nb + (16 + tl) * 384 + 4 * cq, rg == 0 ? BON + (m1 + 16 + tl) * 512 : nullptr);
            if (ch + 2 < NC) { prep_load(raw0, RKVh, LOh, m1 + SCAN_TC + tl, true); prep_load(raw1, RKVh, LOh, m1 + SCAN_TC + 16 + tl, true); }
        }
        __syncthreads();
    }
}

namespace att {
constexpr int L_K = 0, L_V = 16384, L_KM = 32768, L_SEL = 36864, L_WS = 37888;
constexpr float C2 = 0.125f * 1.4426950408889634f;
__device__ __forceinline__ int crow(int r, int hi) { return (r & 3) + 8 * (r >> 2) + 4 * hi; }
typedef __bf16 bf16x2_t __attribute__((ext_vector_type(2)));
__device__ __forceinline__ unsigned cvtpk(float lo, float hi) { f32x2 v = {lo, hi}; bf16x2_t b = __builtin_convertvector(v, bf16x2_t); return __builtin_bit_cast(unsigned, b); }
typedef short v4i16_t __attribute__((ext_vector_type(4)));
__device__ __forceinline__ s16x4 vtr(const LAS unsigned char* p) { return __builtin_bit_cast(s16x4, __builtin_amdgcn_ds_read_tr16_b64_v4i16((LAS v4i16_t*)p)); }

__device__ __forceinline__ void unit(const Params& p, const Ctx& c, int b, int h, int qb, bf16* Oout) {
    const int tid = c.tid, lane = c.lane, wid = c.wave, r32 = lane & 31, hi = lane >> 5;
    bf16* Q = (bf16*)(p.ws + WS_PQ); const bf16* K = (const bf16*)(p.ws + WS_PK); const bf16* V = (const bf16*)(p.ws + WS_PAV); const float* KMg = (const float*)(p.ws + WS_KMEAN);
    const size_t rowbase = (size_t)b * SEQ; const int q0 = qb * 256;
    LAS unsigned char* lds = c.lds; LAS float* kml = (LAS float*)(lds + L_KM); LAS unsigned* sell = (LAS unsigned*)(lds + L_SEL); LAS float* wsf = (LAS float*)(lds + L_WS) + wid * 64;
    for (int i = tid; i < qb * 64; i += NTHREADS) kml[i] = KMg[(size_t)((b * 8 + h) * 16) * 64 + i];
    __syncthreads();
    if (tid < 256) {
        const bf16* qrow = Q + (rowbase + q0 + tid) * 512 + h * 64; float qv[64];
#pragma unroll
        for (int i = 0; i < 8; ++i) { const u32x4 w = *(const u32x4*)(qrow + 8 * i); qv[8 * i] = bflo(w.x); qv[8 * i + 1] = bfhi(w.x); qv[8 * i + 2] = bflo(w.y); qv[8 * i + 3] = bfhi(w.y); qv[8 * i + 4] = bflo(w.z); qv[8 * i + 5] = bfhi(w.z); qv[8 * i + 6] = bflo(w.w); qv[8 * i + 7] = bfhi(w.w); }
        float v0 = -INFINITY, v1 = -INFINITY, v2 = -INFINITY; int i0 = -1, i1 = -1, i2 = -1;
        for (int j = 0; j < qb; ++j) { float g = 0.f;
#pragma unroll
            for (int d = 0; d < 64; d += 4) { const f32x4 km = *(const LAS f32x4*)(kml + j * 64 + d); g += qv[d] * km[0] + qv[d + 1] * km[1] + qv[d + 2] * km[2] + qv[d + 3] * km[3]; }
            if (g > v0) { v2 = v1; i2 = i1; v1 = v0; i1 = i0; v0 = g; i0 = j; } else if (g > v1) { v2 = v1; i2 = i1; v1 = g; i1 = j; } else if (g > v2) { v2 = g; i2 = j; } }
        unsigned msk = 0u; if (i0 >= 0) msk |= 1u << i0; if (i1 >= 0) msk |= 1u << i1; if (i2 >= 0) msk |= 1u << i2;
        sell[tid] = msk;
    }
    __syncthreads();
    const bf16* Qw = Q + (rowbase + q0 + wid * 32) * 512 + h * 64; bf16x8 qr[4];
#pragma unroll
    for (int d0 = 0; d0 < 4; ++d0) qr[d0] = *(const bf16x8*)(Qw + (size_t)r32 * 512 + d0 * 16 + hi * 8);
    const unsigned mysel = sell[wid * 32 + r32]; const int qrel = wid * 32 + r32;
    float m_run = -INFINITY, l_run = 0.f; f32x16 o0 = {}, o1 = {};
    const int krow = tid & 63, kch = tid >> 6; const bf16* ksrc = K + (rowbase + krow) * 512 + h * 64 + kch * 8; const int kdst = kch * 1024 + krow * 16;
    const int vrow = 16 * (wid & 3) + (lane >> 2), vcol = (wid >> 2) * 32 + (lane & 3) * 8; const bf16* vsrc = V + (rowbase + vrow) * 512 + h * 64 + vcol; const int vdst = wid * 1024 + lane * 16;
    const int kfo = hi * 1024 + r32 * 16; const int vfo = ((lane >> 4) & 1) * 32 + (lane & 3) * 8 + (4 * hi + ((lane & 15) >> 2)) * 64;
    const int ntile = 4 * qb + 4;
    u32x4 kreg = *(const u32x4*)(ksrc), vreg = *(const u32x4*)(vsrc);
    for (int it = 0; it < ntile; ++it) {
        LAS unsigned char* Ks = lds + L_K + (it & 1) * 8192; LAS unsigned char* Vs = lds + L_V + (it & 1) * 8192;
        *(LAS u32x4*)(Ks + kdst) = kreg; *(LAS u32x4*)(Vs + vdst) = vreg;
        __syncthreads();
        if (it + 1 < ntile) { kreg = *(const u32x4*)(ksrc + (size_t)(it + 1) * 64 * 512); vreg = *(const u32x4*)(vsrc + (size_t)(it + 1) * 64 * 512); }
        const int blk = it >> 2; const bool band = blk == qb; const int jb = it & 3;
        bool lane_on = band ? (64 * jb <= qrel) : (((mysel >> blk) & 1u) != 0u);
        if (__any(lane_on)) {
            f32x16 p0 = {}, p1 = {};
#pragma unroll
            for (int d0 = 0; d0 < 4; ++d0) { const bf16x8 k0 = *(const LAS bf16x8*)(Ks + kfo + d0 * 2048), k1 = *(const LAS bf16x8*)(Ks + kfo + d0 * 2048 + 512);
                p0 = __builtin_amdgcn_mfma_f32_32x32x16_bf16(k0, qr[d0], p0, 0, 0, 0); p1 = __builtin_amdgcn_mfma_f32_32x32x16_bf16(k1, qr[d0], p1, 0, 0, 0); }
#pragma unroll
            for (int r = 0; r < 16; ++r) { const int kv = 64 * jb + crow(r, hi);
                const bool ok0 = band ? (kv <= qrel) : lane_on, ok1 = band ? (kv + 32 <= qrel) : lane_on;
                p0[r] = ok0 ? p0[r] * C2 : -INFINITY; p1[r] = ok1 ? p1[r] * C2 : -INFINITY; }
            float rm = fmaxf(p0[0], p1[0]);
#pragma unroll
            for (int r = 1; r < 16; ++r) rm = fmaxf(rm, fmaxf(p0[r], p1[r]));
            rm = fmaxf(rm, __shfl_xor(rm, 32));
            const float m_new = fmaxf(m_run, rm); const float m_use = (m_new == -INFINITY) ? 0.f : m_new;
            const float alpha = __builtin_amdgcn_exp2f(m_run - m_use);
            float ps = 0.f;
#pragma unroll
            for (int r = 0; r < 16; ++r) { p0[r] = __builtin_amdgcn_exp2f(p0[r] - m_use); p1[r] = __builtin_amdgcn_exp2f(p1[r] - m_use); ps += p0[r] + p1[r]; }
            l_run = l_run * alpha + ps; m_run = m_new;
            if (__any(alpha != 1.0f)) {
                if (hi == 0) wsf[r32] = alpha;
                asm volatile("s_waitcnt lgkmcnt(0)" ::: "memory");
#pragma unroll
                for (int r = 0; r < 16; ++r) { const float f = wsf[crow(r, hi)]; o0[r] *= f; o1[r] *= f; }
                asm volatile("s_waitcnt lgkmcnt(0)" ::: "memory");
            }
            u32x4 pw[4];
            pw[0] = (u32x4){cvtpk(p0[0], p0[1]), cvtpk(p0[2], p0[3]), cvtpk(p0[4], p0[5]), cvtpk(p0[6], p0[7])};
            pw[1] = (u32x4){cvtpk(p0[8], p0[9]), cvtpk(p0[10], p0[11]), cvtpk(p0[12], p0[13]), cvtpk(p0[14], p0[15])};
            pw[2] = (u32x4){cvtpk(p1[0], p1[1]), cvtpk(p1[2], p1[3]), cvtpk(p1[4], p1[5]), cvtpk(p1[6], p1[7])};
            pw[3] = (u32x4){cvtpk(p1[8], p1[9]), cvtpk(p1[10], p1[11]), cvtpk(p1[12], p1[13]), cvtpk(p1[14], p1[15])};
#pragma unroll
            for (int ks = 0; ks < 4; ++ks) {
                const s16x4 a0 = vtr(Vs + vfo + ks * 1024), a1 = vtr(Vs + vfo + ks * 1024 + 512), b0 = vtr(Vs + vfo + 4096 + ks * 1024), b1 = vtr(Vs + vfo + 4096 + ks * 1024 + 512);
                const bf16x8 va = {a0[0], a0[1], a0[2], a0[3], a1[0], a1[1], a1[2], a1[3]}, vb = {b0[0], b0[1], b0[2], b0[3], b1[0], b1[1], b1[2], b1[3]};
                const bf16x8 pa = __builtin_bit_cast(bf16x8, pw[ks]);
                o0 = __builtin_amdgcn_mfma_f32_32x32x16_bf16(pa, va, o0, 0, 0, 0); o1 = __builtin_amdgcn_mfma_f32_32x32x16_bf16(pa, vb, o1, 0, 0, 0);
            }
        }
    }
    l_run += __shfl_xor(l_run, 32);
    if (hi == 0) wsf[32 + r32] = l_run;
    asm volatile("s_waitcnt lgkmcnt(0)" ::: "memory");
    bf16* Ow = Oout + (rowbase + q0 + wid * 32) * 512 + h * 64;
#pragma unroll
    for (int r = 0; r < 16; ++r) { const int qr_ = crow(r, hi); const float rl = 1.0f / wsf[32 + qr_];
        Ow[(size_t)qr_ * 512 + r32] = (bf16)f2bf(o0[r] * rl); Ow[(size_t)qr_ * 512 + 32 + r32] = (bf16)f2bf(o1[r] * rl); }
    __syncthreads();
}
}

__device__ __forceinline__ void phase6(const Params& p, const Ctx& c) {
    unsigned char* ws = p.ws; const float* YR = (const float*)(ws + WS_YRAW); const float* BON = (const float*)(ws + WS_BONUS); const bf16* LO = (const bf16*)(ws + WS_LORA); bf16* YO = (bf16*)(ws + WS_YRWKV);
    const float* gg = p.in[15]; const float* gb = p.in[16];
    for (int idx = c.gw; idx < MTOK * NHEAD; idx += c.ngw) {
        const int m = idx >> 3, h = idx & 7, ch = h * 64 + c.lane;
        const float y = YR[(size_t)m * 512 + ch]; const float mu = wave_sum(y) * (1.0f / 64.0f); const float d = y - mu; const float var = wave_sum(d * d) * (1.0f / 64.0f);
        const float yn = d * rsqrtf(var + GN_EPS) * gg[ch] + gb[ch];
        const float g = bf2f(LO[(size_t)m * 1536 + 1024 + ch]);
        YO[(size_t)m * 512 + ch] = (bf16)f2bf((yn + BON[(size_t)m * 512 + ch]) * g);
    }
}

constexpr int RW_PITCH = 36;
constexpr int L_HIST = 1024 * RW_PITCH * 4;
__device__ __forceinline__ void phase9(const Params& p, const Ctx& c) {
    unsigned char* ws = p.ws; const float* XP = (const float*)(ws + WS_XPRE); float* X1 = (float*)(ws + WS_X1); bf16* X1B = (bf16*)(ws + WS_X1B);
    int* ctl = (int*)(ws + WS_CTL); int* TOKE = (int*)(ws + WS_TOKE); float* TOKW = (float*)(ws + WS_TOKW);
    const float* g1 = p.in[1]; const float* b1 = p.in[2]; const float* RW = p.in[20]; const float* RB = p.in[21];
    LAS float* rw = (LAS float*)c.lds; LAS int* hist = (LAS int*)(c.lds + L_HIST);
    for (int i = c.tid; i < 1024 * 8; i += NTHREADS) { const int row = i >> 3, q = i & 7; *(LAS f32x4*)(rw + row * RW_PITCH + 4 * q) = *(const f32x4*)(RW + row * 32 + 4 * q); }
    if (c.tid < 32) hist[c.tid] = 0;
    __syncthreads();
    for (int m = c.gw; m < MTOK; m += c.ngw) {
        const f32x4* xr = (const f32x4*)(XP + (size_t)m * 1024) + c.lane; f32x4 v[4]; float s = 0.f;
#pragma unroll
        for (int j = 0; j < 4; ++j) { v[j] = xr[64 * j]; s += (v[j][0] + v[j][1]) + (v[j][2] + v[j][3]); }
        const float mean = wave_sum(s) * (1.0f / 1024.0f); float s2 = 0.f;
#pragma unroll
        for (int j = 0; j < 4; ++j) { v[j] = v[j] - mean; s2 += (v[j][0] * v[j][0] + v[j][1] * v[j][1]) + (v[j][2] * v[j][2] + v[j][3] * v[j][3]); }
        const float rstd = 1.0f / sqrtf(wave_sum(s2) * (1.0f / 1024.0f) + LN_EPS);
        float acc[32];
#pragma unroll
        for (int e = 0; e < 32; ++e) acc[e] = 0.f;
#pragma unroll
        for (int j = 0; j < 4; ++j) { const int col = 256 * j + 4 * c.lane; const f32x4 gv = *(const f32x4*)(g1 + col), bv = *(const f32x4*)(b1 + col);
            v[j] = v[j] * rstd * gv + bv;
            *(f32x4*)(X1 + (size_t)m * 1024 + col) = v[j]; u32x2 w; w.x = pk2(v[j][0], v[j][1]); w.y = pk2(v[j][2], v[j][3]); *(u32x2*)(X1B + (size_t)m * 1024 + col) = w;
#pragma unroll
            for (int i = 0; i < 4; ++i) { const LAS float* wr_ = rw + (col + i) * RW_PITCH; const float xv = v[j][i];
#pragma unroll
                for (int q = 0; q < 8; ++q) { const f32x4 w4 = *(const LAS f32x4*)(wr_ + 4 * q); acc[4 * q] += xv * w4[0]; acc[4 * q + 1] += xv * w4[1]; acc[4 * q + 2] += xv * w4[2]; acc[4 * q + 3] += xv * w4[3]; } } }
#pragma unroll
        for (int e = 0; e < 32; ++e) acc[e] = wave_sum(acc[e]) + RB[e];
        float tv[4]; int ti[4]; unsigned used = 0u;
#pragma unroll
        for (int k = 0; k < 4; ++k) { float bv = -INFINITY; int bi = 0;
#pragma unroll
            for (int e = 0; e < 32; ++e) { const bool ok = ((used >> e) & 1u) == 0u && acc[e] > bv; bv = ok ? acc[e] : bv; bi = ok ? e : bi; }
            tv[k] = bv; ti[k] = bi; used |= 1u << bi; }
        const float e1 = __expf(tv[1] - tv[0]), e2 = __expf(tv[2] - tv[0]), e3 = __expf(tv[3] - tv[0]); const float inv = 1.0f / (1.0f + e1 + e2 + e3);
        if (c.lane < 4) { const int e = c.lane == 0 ? ti[0] : c.lane == 1 ? ti[1] : c.lane == 2 ? ti[2] : ti[3]; const float w = (c.lane == 0 ? 1.0f : c.lane == 1 ? e1 : c.lane == 2 ? e2 : e3) * inv;
            const int pos = __hip_atomic_fetch_add(hist + e, 1, __ATOMIC_RELAXED, __HIP_MEMORY_SCOPE_WORKGROUP);
            TOKE[m * 4 + c.lane] = e | (pos << 8); TOKW[m * 4 + c.lane] = w; }
    }
    __syncthreads();
    if (c.tid < 32) { const int base = atomicAdd(ctl + CW_COUNT + c.tid, hist[c.tid]); ctl[CW_WGBASE + c.bid * 32 + c.tid] = base; }
}

__device__ __forceinline__ void phase10(const Params& p, const Ctx& c) {
    unsigned char* ws = p.ws; int* ctl = (int*)(ws + WS_CTL); const int* TOKE = (const int*)(ws + WS_TOKE); const float* TOKW = (const float*)(ws + WS_TOKW);
    int* SLOTOF = (int*)(ws + WS_SLOTOF); float* ROWW = (float*)(ws + WS_ROWW); const bf16* X1B = (const bf16*)(ws + WS_X1B); bf16* XPM = (bf16*)(ws + WS_XPERM);
    LAS int* pst = (LAS int*)(c.lds + L_HIST + 128);
    if (c.tid == 0) { int acc = 0;
        for (int e = 0; e < 32; ++e) { const int cnt = __hip_atomic_load(ctl + CW_COUNT + e, __ATOMIC_RELAXED, __HIP_MEMORY_SCOPE_AGENT); const int nt = (cnt + 255) >> 8;
            pst[e] = acc * 256 + ctl[CW_WGBASE + c.bid * 32 + e];
            if (c.bid == 0) for (int t = 0; t < nt; ++t) ctl[CW_TILE_E + acc + t] = e;
            acc += nt; }
        if (c.bid == 0) ctl[CW_NTILES] = acc; }
    __syncthreads();
    for (int m = c.gw; m < MTOK; m += c.ngw) {
        int slot = 0;
        if (c.lane < 4) { const int ew = TOKE[m * 4 + c.lane]; slot = pst[ew & 255] + (ew >> 8); SLOTOF[m * 4 + c.lane] = slot; ROWW[slot] = TOKW[m * 4 + c.lane]; }
        const u32x4* src = (const u32x4*)(X1B + (size_t)m * 1024); const u32x4 a = src[c.lane], b2 = src[64 + c.lane];
#pragma unroll
        for (int k = 0; k < 4; ++k) { const int sk = __shfl(slot, k); u32x4* dst = (u32x4*)(XPM + (size_t)sk * 1024); dst[c.lane] = a; dst[64 + c.lane] = b2; }
    }
}

__device__ __forceinline__ void phase14(const Params& p, const Ctx& c) {
    unsigned char* ws = p.ws; const float* X1 = (const float*)(ws + WS_X1); const bf16* YB = (const bf16*)(ws + WS_YBUF); const int* SLOTOF = (const int*)(ws + WS_SLOTOF);
    const float* g2 = p.in[3]; const float* b2 = p.in[4];
    for (int m = c.gw; m < MTOK; m += c.ngw) {
        const int s0 = SLOTOF[m * 4], s1 = SLOTOF[m * 4 + 1], s2_ = SLOTOF[m * 4 + 2], s3 = SLOTOF[m * 4 + 3];
        f32x4 v[4]; float s = 0.f;
#pragma unroll
        for (int j = 0; j < 4; ++j) { const int col = 256 * j + 4 * c.lane; v[j] = *(const f32x4*)(X1 + (size_t)m * 1024 + col) * DN_ALPHA;
            const u32x2 a = *(const u32x2*)(YB + (size_t)s0 * 1024 + col), b = *(const u32x2*)(YB + (size_t)s1 * 1024 + col), cc = *(const u32x2*)(YB + (size_t)s2_ * 1024 + col), d = *(const u32x2*)(YB + (size_t)s3 * 1024 + col);
            v[j][0] += ((bflo(a.x) + bflo(b.x)) + bflo(cc.x)) + bflo(d.x); v[j][1] += ((bfhi(a.x) + bfhi(b.x)) + bfhi(cc.x)) + bfhi(d.x);
            v[j][2] += ((bflo(a.y) + bflo(b.y)) + bflo(cc.y)) + bflo(d.y); v[j][3] += ((bfhi(a.y) + bfhi(b.y)) + bfhi(cc.y)) + bfhi(d.y);
            s += (v[j][0] + v[j][1]) + (v[j][2] + v[j][3]); }
        const float mean = wave_sum(s) * (1.0f / 1024.0f); float q = 0.f;
#pragma unroll
        for (int j = 0; j < 4; ++j) { v[j] = v[j] - mean; q += (v[j][0] * v[j][0] + v[j][1] * v[j][1]) + (v[j][2] * v[j][2] + v[j][3] * v[j][3]); }
        const float rstd = 1.0f / sqrtf(wave_sum(q) * (1.0f / 1024.0f) + LN_EPS);
#pragma unroll
        for (int j = 0; j < 4; ++j) { const int col = 256 * j + 4 * c.lane; *(f32x4*)(p.out + (size_t)m * 1024 + col) = v[j] * rstd * *(const f32x4*)(g2 + col) + *(const f32x4*)(b2 + col); }
    }
}

#define XB_TMO      128
#define XB_XCNT(j)  (256  + 64 * (j))
#define XB_XSUB(j)  (1280 + 64 * (j))
#define XB_XGEN(j)  (2304 + 64 * (j))
#define XB_TOP      3328
#define XB_TOPGEN   3392
#define XCD_BAR_WORDS 3456
#define XB_SPIN_CAP (1u << 18)

__device__ __forceinline__ unsigned xb_ld(unsigned* p)              { return __hip_atomic_load(p, __ATOMIC_RELAXED, __HIP_MEMORY_SCOPE_AGENT); }
__device__ __forceinline__ unsigned xb_add(unsigned* p, unsigned v) { return __hip_atomic_fetch_add(p, v, __ATOMIC_RELAXED, __HIP_MEMORY_SCOPE_AGENT); }
__device__ __forceinline__ unsigned xb_xcc_id() { return (unsigned)__builtin_amdgcn_s_getreg((3 << 11) | 20) & 0xFu; }
#define XB_SPIN(cond, bar) do { unsigned _sp = 0; while (cond) { __builtin_amdgcn_s_sleep(1); \
    if ((++_sp & 255u) == 0u) { if (xb_ld(&(bar)[XB_TMO])) break; if (_sp > XB_SPIN_CAP) { atomicAdd(&(bar)[XB_TMO], 1u); break; } } } } while (0)

struct XcdBarrier {
    unsigned* bar; unsigned x;
    volatile LAS unsigned* st;
};

__device__ __forceinline__ XcdBarrier xcd_barrier_post(unsigned* bar, volatile LAS unsigned* st) {
    XcdBarrier b; b.bar = bar; b.x = xb_xcc_id(); b.st = st;
    if (threadIdx.x == 0) (void)xb_add(&bar[XB_XCNT(b.x)], 1u);
    return b;
}
__device__ __forceinline__ void xcd_barrier_complete(unsigned* bar, unsigned x, unsigned& nloc, unsigned& nx) {
    const unsigned G = gridDim.x * gridDim.y * gridDim.z;
    unsigned sum, cnt, mine, sp = 0u;
    for (;;) {
        sum = 0u; cnt = 0u; mine = 0u;
#pragma unroll
        for (unsigned j = 0; j < 16; ++j) { const unsigned c = xb_ld(&bar[XB_XCNT(j)]); sum += c; cnt += (c > 0u) ? 1u : 0u; mine = (j == x) ? c : mine; }
        if (sum == G) break;
        __builtin_amdgcn_s_sleep(1);
        if ((++sp & 255u) == 0u) { if (xb_ld(&bar[XB_TMO])) break; if (sp > XB_SPIN_CAP) { atomicAdd(&bar[XB_TMO], 1u); break; } }
    }
    nloc = mine > 0u ? mine : 1u; nx = cnt > 0u ? cnt : 1u;
}

__device__ __forceinline__ void xcd_barrier(const XcdBarrier& b) {
    asm volatile("s_waitcnt vmcnt(0)" ::: "memory");
    __syncthreads();
    if (threadIdx.x == 0) {
        unsigned* bar = b.bar;
        __builtin_amdgcn_s_waitcnt(0);
        unsigned nloc = b.st[0], nx = b.st[1];
        if (nloc == 0u) { xcd_barrier_complete(bar, b.x, nloc, nx); b.st[0] = nloc; b.st[1] = nx; }
        const unsigned old = xb_add(&bar[XB_XSUB(b.x)], 1u);
        const unsigned gen = old / nloc;
        if (old + 1u == (gen + 1u) * nloc) {
            __builtin_amdgcn_fence(__ATOMIC_RELEASE, "agent");
            asm volatile("s_waitcnt vmcnt(0)" ::: "memory");
            const unsigned og = xb_add(&bar[XB_TOP], 1u);
            const unsigned tg = og / nx;
            if (og + 1u == (tg + 1u) * nx) xb_add(&bar[XB_TOPGEN], 1u);
            else XB_SPIN(xb_ld(&bar[XB_TOPGEN]) == tg, bar);
            __builtin_amdgcn_fence(__ATOMIC_ACQUIRE, "agent");
            xb_add(&bar[XB_XGEN(b.x)], 1u);
            asm volatile("s_waitcnt vmcnt(0)" ::: "memory");
        } else {
            XB_SPIN(xb_ld(&bar[XB_XGEN(b.x)]) == gen, bar);
            __builtin_amdgcn_fence(__ATOMIC_ACQUIRE, "agent");
            asm volatile("s_waitcnt vmcnt(0)" ::: "memory");
        }
    }
    __syncthreads();
}


constexpr int NPHASE = 15;
#ifndef MK_SPLIT
#define MK_SPLIT 0
#endif
__global__ void __launch_bounds__(NTHREADS, 2) fwd_megakernel(Params p) {
    extern __shared__ __attribute__((aligned(16))) unsigned char lds_raw[];
    Ctx c; c.lds = (LAS unsigned char*)lds_raw; c.tid = threadIdx.x; c.lane = c.tid & 63; c.wave = __builtin_amdgcn_readfirstlane(c.tid >> 6);
    c.G = gridDim.x; c.bid = blockIdx.x; c.gw = c.bid * NWAVES + c.wave; c.ngw = c.G * NWAVES;
    unsigned char* ws = p.ws;
    const int lo = p.ph_lo, hi = p.ph_hi;
#ifdef ONLY_PHASE
#define IN(k) ((k) == ONLY_PHASE && lo <= (k) && (k) < hi)
#else
#define IN(k) (lo <= (k) && (k) < hi)
#endif
#if MK_SPLIT
#define SEAM(k) do { } while (0)
#else
    cg::grid_group grid = cg::this_grid();
    { volatile LAS unsigned* st = (volatile LAS unsigned*)(c.lds + LDS_BYTES - 16); if (c.tid < 4) st[c.tid] = 0u; }
    __syncthreads();
    const XcdBarrier xbar = xcd_barrier_post((unsigned*)(ws + WS_CTL) + CW_XBAR, (volatile LAS unsigned*)(c.lds + LDS_BYTES - 16));
#define SEAM(k) do { if (IN(k) && IN((k) + 1)) { if ((k) == 0) grid.sync(); else xcd_barrier(xbar); } } while (0)
#endif
#ifndef DBL_PHASE
#define DBL_PHASE -1
#endif
#define PH(k, ...) if (IN(k)) { __VA_ARGS__; if (DBL_PHASE == (k)) { xcd_barrier(xbar); __VA_ARGS__; } }
    PH(0, phase0(p, c))
    SEAM(0);
    PH(1, { pg8::DenseOrder S; S.init(MTOK, 5376, 1024, c.G, c.bid, ws + WS_XB, ws + WS_WIN_T);
        pg8::EpiInProj E{(bf16*)(ws + WS_PRKV), (bf16*)(ws + WS_PLR), (bf16*)(ws + WS_PQ), (bf16*)(ws + WS_PK), (bf16*)(ws + WS_PAV), (bf16*)(ws + WS_PG)};
        pg8::gemm_phase<pg8::EpiInProj, pg8::DenseOrder, true, true>(c.lds, 1024, S, E); })
    SEAM(1);
    if (IN(2)) phase2(p, c);
    SEAM(2);
    PH(3, { pg8::DenseOrder S; S.init(MTOK, 1536, 256, c.G, c.bid, ws + WS_ALORA, ws + WS_WLORA_T);
        pg8::EpiPlainBf16 E{(bf16*)(ws + WS_LORA), 1536};
        pg8::gemm_phase<pg8::EpiPlainBf16, pg8::DenseOrder, true, true>(c.lds, 256, S, E); })
    SEAM(3);
    if (IN(5)) {
        for (int rep = 0; rep < (DBL_PHASE == 50 ? 2 : 1); ++rep) { for (int item = c.bid; item < 256; item += c.G) scan_item(p, c, item); }
        for (int rep = (DBL_PHASE == 51 ? 0 : 1); rep < 2; ++rep) {
            bf16* Oout = rep == 0 ? (bf16*)(ws + WS_MERGED) : (bf16*)(ws + WS_PQ);
            for (int v = c.bid; v < 256; v += c.G) { const int bh = v >> 2, s = v & 3;
#pragma unroll 1
                for (int i = 0; i < 4; ++i) { const int qb = (i == 0) ? s : (i == 1) ? 7 - s : (i == 2) ? 8 + s : 15 - s; att::unit(p, c, bh >> 3, bh & 7, qb, Oout); } } }
    }
    SEAM(5);
    PH(6, phase6(p, c))
    SEAM(6);
    PH(7, { pg8::DenseOrder S; S.init(MTOK, 1024, 512, c.G, c.bid, ws + WS_YRWKV, ws + WS_WR_T);
        pg8::EpiGateF32 E{(float*)(ws + WS_TMP), (const bf16*)(ws + WS_PG), 0};
        pg8::gemm_phase<pg8::EpiGateF32, pg8::DenseOrder, true, true>(c.lds, 512, S, E); })
    SEAM(7);
    PH(8, { pg8::DenseOrder S; S.init(MTOK, 1024, 512, c.G, c.bid, ws + WS_PQ, ws + WS_WA_T);
        pg8::EpiGateAddBf16 E{(const float*)(ws + WS_TMP), (const bf16*)(ws + WS_PG), 1024, (bf16*)(ws + WS_MERGED)};
        pg8::gemm_phase<pg8::EpiGateAddBf16, pg8::DenseOrder, true, true>(c.lds, 512, S, E); })
    SEAM(8);
    PH(9, { pg8::DenseOrder S; S.init(MTOK, 1024, 1024, c.G, c.bid, ws + WS_MERGED, ws + WS_WO_T);
        pg8::EpiResF32 E{(float*)(ws + WS_XPRE), p.in[0], DN_ALPHA};
        pg8::gemm_phase<pg8::EpiResF32, pg8::DenseOrder, true, true>(c.lds, 1024, S, E); })
    SEAM(9);
    if (IN(10)) phase9(p, c);
    SEAM(10);
    if (IN(11)) phase10(p, c);
    SEAM(11);
    PH(12, { const int* ctl = (const int*)(ws + WS_CTL);
        pg8::MoeOrder S{ctl + CW_TILE_E, ctl[CW_NTILES], 8, c.G, c.bid, (const char*)(ws + WS_XPERM), (const char*)(ws + WS_W1T), (size_t)256 * 1024 * 2, (size_t)2048 * 1024 * 2};
        pg8::EpiSwiglu E{(bf16*)(ws + WS_ACT), p.in[23]};
        pg8::gemm_phase<pg8::EpiSwiglu, pg8::MoeOrder, true, true>(c.lds, 1024, S, E); })
    SEAM(12);
    PH(13, { const int* ctl = (const int*)(ws + WS_CTL);
        pg8::MoeOrder S{ctl + CW_TILE_E, ctl[CW_NTILES], 4, c.G, c.bid, (const char*)(ws + WS_ACT), (const char*)(ws + WS_W2T), (size_t)256 * 1024 * 2, (size_t)1024 * 1024 * 2};
        pg8::EpiMoe2 E{(bf16*)(ws + WS_YBUF), p.in[25], (const float*)(ws + WS_ROWW)};
        pg8::gemm_phase<pg8::EpiMoe2, pg8::MoeOrder, true, true>(c.lds, 1024, S, E); })
    SEAM(13);
    PH(14, phase14(p, c))
#undef PH
#undef IN
#undef SEAM
}

extern "C" void kernel_launch(void* const* d_in, const int* in_sizes, int n_in, void* d_out, int out_size, void* d_ws, size_t ws_size, hipStream_t stream) {
    static int grid = 0;
    if (grid == 0) {
        if (n_in != 26 || in_sizes[0] != MTOK * DMODEL || out_size != MTOK * DMODEL || ws_size < WS_END) {
            fprintf(stderr, "kernel_launch: unexpected shapes / workspace (n_in %d, in0 %d, out %d, ws %zu, need %zu); nothing launched\n", n_in, n_in > 0 ? in_sizes[0] : -1, out_size, ws_size, (size_t)WS_END); grid = -1; return; }
        int dev = 0, cus = 0, per_cu = 0;
        hipGetDevice(&dev); hipDeviceGetAttribute(&cus, hipDeviceAttributeMultiprocessorCount, dev);
        hipFuncSetAttribute((const void*)fwd_megakernel, hipFuncAttributeMaxDynamicSharedMemorySize, LDS_BYTES);
        hipOccupancyMaxActiveBlocksPerMultiprocessor(&per_cu, (const void*)fwd_megakernel, NTHREADS, LDS_BYTES);
        (void)hipGetLastError();
        if (per_cu < 1) { fprintf(stderr, "kernel_launch: occupancy query says %d blocks per CU\n", per_cu); per_cu = 1; }
        grid = cus;
    }
    if (grid < 0) return;
    hipMemsetAsync((char*)d_ws + WS_CTL, 0, CTL_BYTES, stream);
    Params p{};
    for (int i = 0; i < 26; ++i) p.in[i] = (const float*)d_in[i];
    p.out = (float*)d_out; p.ws = (unsigned char*)d_ws;
#if MK_SPLIT
    for (int ph = 0; ph < NPHASE; ++ph) { p.ph_lo = ph; p.ph_hi = ph + 1; hipLaunchKernelGGL(fwd_megakernel, dim3(grid), dim3(NTHREADS), LDS_BYTES, stream, p); }
#else
    p.ph_lo = 0; p.ph_hi = NPHASE;
    void* args[] = {&p};
    hipError_t e = hipLaunchCooperativeKernel((const void*)fwd_megakernel, dim3(grid), dim3(NTHREADS), args, LDS_BYTES, stream);
    if (e != hipSuccess) fprintf(stderr, "cooperative launch failed: %s (grid %d)\n", hipGetErrorString(e), grid);
#endif
}
```

```cpp
#include <hip/hip_runtime.h>
#include <hip/hip_cooperative_groups.h>
#include <cstdio>
#include <cstdint>
namespace cg = cooperative_groups;

namespace pg8 {
#define PG8_LAS __attribute__((address_space(3)))
typedef unsigned short bf16_t;
typedef short bf16x8 __attribute__((ext_vector_type(8)));
typedef float f32x4 __attribute__((ext_vector_type(4)));
typedef float f32x2 __attribute__((ext_vector_type(2)));
typedef unsigned u32x4 __attribute__((ext_vector_type(4)));
typedef unsigned u32x2 __attribute__((ext_vector_type(2)));
constexpr int BM = 256, BK = 64, HALF = 128, HTB = HALF * BK * 2  , STAGE_BYTES = 8 * HTB, NXCD = 8, WGM = 8;

__host__ __device__ __forceinline__ int lds_byte(int r, int c) { const int st = (r >> 4) * 2 + (c >> 5), rr = r & 15, cc = c & 31, ob = rr * 64 + cc * 2; return st * 1024 + (ob ^ (((ob >> 9) & 1) << 5)); }
__host__ __device__ __forceinline__ void stage_rc(int b, int& R, int& C) { const int st = b / 1024, sb = b % 1024, swz = sb ^ (((sb >> 9) & 1) << 5); R = (st >> 1) * 16 + swz / 64; C = (st & 1) * 32 + (swz % 64) / 2; }
__host__ __device__ __forceinline__ int perm32(int rho) { const int n = rho >> 4, i = rho & 15; return 8 * (i >> 2) + 4 * n + (i & 3); }

struct Unit { int pm, pn, aux; const char* A; const char* B; };

struct DenseOrder {
    static constexpr bool GATHER = false; const int* rowmap;
    int nM, nN, nwg, G, c; const char* A; const char* B; size_t tstep;
    __device__ __forceinline__ void init(int M, int N, int K, int G_, int c_, const void* A_, const void* B_) { nM = M / BM; nN = N / BM; nwg = nM * nN; G = G_; c = c_; A = (const char*)A_; B = (const char*)B_; tstep = (size_t)BM * K * 2; }
    __device__ __forceinline__ bool next(int i, Unit& u) const {
        const long L = (long)i * G + c; if (L >= nwg) return false;
        int wgid = (int)L; { const int q = nwg / NXCD, r = nwg % NXCD, xcd = wgid % NXCD, off = wgid / NXCD; wgid = (xcd < r ? xcd * (q + 1) : r * (q + 1) + (xcd - r) * q) + off; }
        const int nig = WGM * nN, gid = wgid / nig, fm = gid * WGM, gsz = (nM - fm) < WGM ? (nM - fm) : WGM;
        u.pm = fm + ((wgid % nig) % gsz); u.pn = (wgid % nig) / gsz; u.aux = 0;
        u.A = A + (size_t)u.pm * tstep; u.B = B + (size_t)u.pn * tstep; return true;
    }
    __device__ __forceinline__ void a_ready(const Unit&) const {}
    __device__ __forceinline__ void done(const Unit&) const {}
};
template <bool GATHER_> struct MoeOrder {
    static constexpr bool GATHER = GATHER_; const int* rowmap;
    const int* tile_e; int ntiles, npn, G, c; const char* A; const char* B; size_t tstep, estride;
    __device__ __forceinline__ bool next(int i, Unit& u) const {
        const long L = (long)i * G + c; if (L >= (long)ntiles * npn) return false;
        const int tile = (int)(L / npn), pn = (int)(L % npn); const int e = tile_e[tile];
        u.pm = tile; u.pn = pn; u.aux = e; u.A = GATHER_ ? A : A + (size_t)tile * tstep; u.B = B + (size_t)e * estride + (size_t)pn * tstep; return true;
    }
    __device__ __forceinline__ void a_ready(const Unit&) const {}
    __device__ __forceinline__ void done(const Unit&) const {}
};

__device__ __forceinline__ unsigned cvt_pk_bf16(float lo, float hi) { unsigned r; asm volatile("v_cvt_pk_bf16_f32 %0, %1, %2" : "=v"(r) : "v"(lo), "v"(hi)); return r; }
__device__ __forceinline__ float bf_lo(unsigned w) { return __builtin_bit_cast(float, w << 16); }
__device__ __forceinline__ float bf_hi(unsigned w) { return __builtin_bit_cast(float, w & 0xffff0000u); }
__device__ __forceinline__ float sigm(float x) { return 1.0f / (1.0f + __expf(-x)); }

__device__ __forceinline__ void st8(bf16_t* p, f32x4 v0, f32x4 v1) { u32x4 w; w.x = cvt_pk_bf16(v0[0], v0[1]); w.y = cvt_pk_bf16(v0[2], v0[3]); w.z = cvt_pk_bf16(v1[0], v1[1]); w.w = cvt_pk_bf16(v1[2], v1[3]); *(u32x4*)p = w; }

struct EpiPlainBf16 {
    static constexpr bool PERM = true, AFTER_DRAIN = false;
    bf16_t* O; int ldc;
    __device__ __forceinline__ void operator()(const f32x4 (&acc)[2][2][4][2], const Unit& u, int wr, int wc, int fr, int fq) const {
        const int row0 = u.pm * BM + wr * 64 + fr, col0 = u.pn * BM + wc * 32 + 8 * fq;
#pragma unroll
        for (int ai = 0; ai < 2; ++ai)
#pragma unroll
            for (int m = 0; m < 4; ++m) { bf16_t* rowp = O + (size_t)(row0 + ai * HALF + m * 16) * ldc + col0;
#pragma unroll
                for (int bj = 0; bj < 2; ++bj) st8(rowp + bj * HALF, acc[ai][bj][m][0], acc[ai][bj][m][1]); }
    }
};
struct EpiInProj {
    static constexpr bool PERM = true, AFTER_DRAIN = false;
    bf16_t *rkv, *lr, *q, *k, *v, *g;
    __device__ __forceinline__ void operator()(const f32x4 (&acc)[2][2][4][2], const Unit& u, int wr, int wc, int fr, int fq) const {
        const int pn = u.pn; bf16_t* base; int ldc, colt;
        if (pn < 6) { base = rkv; ldc = 1536; colt = pn * 256; } else if (pn == 6) { base = lr; ldc = 256; colt = 0; }
        else if (pn < 9) { base = q; ldc = 512; colt = (pn - 7) * 256; } else if (pn < 11) { base = k; ldc = 512; colt = (pn - 9) * 256; }
        else if (pn < 13) { base = v; ldc = 512; colt = (pn - 11) * 256; } else { base = g; ldc = 2048; colt = (pn - 13) * 256; }
        const int row0 = u.pm * BM + wr * 64 + fr, col0 = colt + wc * 32 + 8 * fq;
#pragma unroll
        for (int ai = 0; ai < 2; ++ai)
#pragma unroll
            for (int m = 0; m < 4; ++m) { bf16_t* rowp = base + (size_t)(row0 + ai * HALF + m * 16) * ldc + col0;
#pragma unroll
                for (int bj = 0; bj < 2; ++bj) st8(rowp + bj * HALF, acc[ai][bj][m][0], acc[ai][bj][m][1]); }
    }
};
struct EpiGateF32 {
    static constexpr bool PERM = true, AFTER_DRAIN = false;
    float* T; const bf16_t* G; int goff;
    __device__ __forceinline__ void operator()(const f32x4 (&acc)[2][2][4][2], const Unit& u, int wr, int wc, int fr, int fq) const {
        const int row0 = u.pm * BM + wr * 64 + fr, col0 = u.pn * BM + wc * 32 + 8 * fq;
#pragma unroll
        for (int ai = 0; ai < 2; ++ai)
#pragma unroll
            for (int m = 0; m < 4; ++m) { const size_t row = (size_t)(row0 + ai * HALF + m * 16);
#pragma unroll
                for (int bj = 0; bj < 2; ++bj) { const int col = col0 + bj * HALF; const u32x4 gw = *(const u32x4*)(G + row * 2048 + goff + col);
                    f32x4 a = acc[ai][bj][m][0], b = acc[ai][bj][m][1];
                    a[0] *= sigm(bf_lo(gw.x)); a[1] *= sigm(bf_hi(gw.x)); a[2] *= sigm(bf_lo(gw.y)); a[3] *= sigm(bf_hi(gw.y));
                    b[0] *= sigm(bf_lo(gw.z)); b[1] *= sigm(bf_hi(gw.z)); b[2] *= sigm(bf_lo(gw.w)); b[3] *= sigm(bf_hi(gw.w));
                    *(f32x4*)(T + row * 1024 + col) = a; *(f32x4*)(T + row * 1024 + col + 4) = b; } }
    }
};
struct EpiGateAddBf16 {
    static constexpr bool PERM = true, AFTER_DRAIN = false;
    const float* T; const bf16_t* G; int goff; bf16_t* O;
    __device__ __forceinline__ void operator()(const f32x4 (&acc)[2][2][4][2], const Unit& u, int wr, int wc, int fr, int fq) const {
        const int row0 = u.pm * BM + wr * 64 + fr, col0 = u.pn * BM + wc * 32 + 8 * fq;
#pragma unroll
        for (int ai = 0; ai < 2; ++ai)
#pragma unroll
            for (int m = 0; m < 4; ++m) { const size_t row = (size_t)(row0 + ai * HALF + m * 16);
#pragma unroll
                for (int bj = 0; bj < 2; ++bj) { const int col = col0 + bj * HALF; const u32x4 gw = *(const u32x4*)(G + row * 2048 + goff + col);
                    f32x4 a = acc[ai][bj][m][0], b = acc[ai][bj][m][1]; const f32x4 ta = *(const f32x4*)(T + row * 1024 + col), tb = *(const f32x4*)(T + row * 1024 + col + 4);
                    a[0] = ta[0] + a[0] * sigm(bf_lo(gw.x)); a[1] = ta[1] + a[1] * sigm(bf_hi(gw.x)); a[2] = ta[2] + a[2] * sigm(bf_lo(gw.y)); a[3] = ta[3] + a[3] * sigm(bf_hi(gw.y));
                    b[0] = tb[0] + b[0] * sigm(bf_lo(gw.z)); b[1] = tb[1] + b[1] * sigm(bf_hi(gw.z)); b[2] = tb[2] + b[2] * sigm(bf_lo(gw.w)); b[3] = tb[3] + b[3] * sigm(bf_hi(gw.w));
                    st8(O + row * 1024 + col, a, b); } }
    }
};
struct EpiResF32 {
    static constexpr bool PERM = false, AFTER_DRAIN = false;
    float* C; const float* X; float alpha;
    __device__ __forceinline__ void operator()(const f32x4 (&acc)[2][2][4][2], const Unit& u, int wr, int wc, int fr, int fq) const {
        const int row0 = u.pm * BM + wr * 64 + fr, col0 = u.pn * BM + wc * 32 + 4 * fq;
#pragma unroll
        for (int ai = 0; ai < 2; ++ai)
#pragma unroll
            for (int m = 0; m < 4; ++m) { const size_t off = (size_t)(row0 + ai * HALF + m * 16) * 1024 + col0;
#pragma unroll
                for (int bj = 0; bj < 2; ++bj)
#pragma unroll
                    for (int n = 0; n < 2; ++n) { const f32x4 xv = *(const f32x4*)(X + off + bj * HALF + n * 16); *(f32x4*)(C + off + bj * HALF + n * 16) = acc[ai][bj][m][n] + xv * alpha; } }
    }
};
struct EpiSwiglu {
    static constexpr bool PERM = true, AFTER_DRAIN = false;
    bf16_t* O; const float* bin;
    __device__ __forceinline__ void operator()(const f32x4 (&acc)[2][2][4][2], const Unit& u, int wr, int wc, int fr, int fq) const {
        const int row0 = u.pm * BM + wr * 64 + fr, c0 = u.pn * HALF + wc * 32 + 8 * fq; const float* bb = bin + (size_t)u.aux * 2048 + c0;
        const f32x4 bg0 = *(const f32x4*)(bb), bg1 = *(const f32x4*)(bb + 4), bl0 = *(const f32x4*)(bb + 1024), bl1 = *(const f32x4*)(bb + 1028);
#pragma unroll
        for (int ai = 0; ai < 2; ++ai)
#pragma unroll
            for (int m = 0; m < 4; ++m) { const size_t row = (size_t)(row0 + ai * HALF + m * 16);
                f32x4 o0, o1; const f32x4 g0 = acc[ai][0][m][0] + bg0, g1 = acc[ai][0][m][1] + bg1, l0 = acc[ai][1][m][0] + bl0, l1 = acc[ai][1][m][1] + bl1;
#pragma unroll
                for (int j = 0; j < 4; ++j) { const float ga = fminf(g0[j], 7.0f), la = fminf(fmaxf(l0[j], -7.0f), 7.0f); o0[j] = ga * sigm(1.702f * ga) * (la + 1.0f);
                                              const float gb = fminf(g1[j], 7.0f), lb = fminf(fmaxf(l1[j], -7.0f), 7.0f); o1[j] = gb * sigm(1.702f * gb) * (lb + 1.0f); }
                st8(O + row * 1024 + c0, o0, o1); }
    }
};
struct EpiMoe2 {
    static constexpr bool PERM = true, AFTER_DRAIN = false;
    bf16_t* O; const float* bout; const float* roww;
    __device__ __forceinline__ void operator()(const f32x4 (&acc)[2][2][4][2], const Unit& u, int wr, int wc, int fr, int fq) const {
        const int row0 = u.pm * BM + wr * 64 + fr, col0 = u.pn * BM + wc * 32 + 8 * fq; const float* bb = bout + (size_t)u.aux * 1024 + col0;
        f32x4 bv[2][2];
#pragma unroll
        for (int bj = 0; bj < 2; ++bj) { bv[bj][0] = *(const f32x4*)(bb + bj * HALF); bv[bj][1] = *(const f32x4*)(bb + bj * HALF + 4); }
#pragma unroll
        for (int ai = 0; ai < 2; ++ai)
#pragma unroll
            for (int m = 0; m < 4; ++m) { const size_t row = (size_t)(row0 + ai * HALF + m * 16); const float w = roww[row];
#pragma unroll
                for (int bj = 0; bj < 2; ++bj) st8(O + row * 1024 + col0 + bj * HALF, (acc[ai][bj][m][0] + bv[bj][0]) * w, (acc[ai][bj][m][1] + bv[bj][1]) * w); }
    }
};

template <class Epi, class Sched, bool ALIGN_EPI = false, bool SP2 = false>
__device__ __forceinline__ void gemm_phase(PG8_LAS unsigned char* lds, const int K, const Sched& S, const Epi& E) {
    const int tid = threadIdx.x, wid = __builtin_amdgcn_readfirstlane(tid >> 6), lane = tid & 63, wr = wid >> 2, wc = wid & 3, fr = lane & 15, fq = lane >> 4;
    const int nt = K / BK;
    unsigned vA0[2], vA1[2], nvA0[2], nvA1[2], voffB[2]; int sR[2], sC[2];
#pragma unroll
    for (int i = 0; i < 2; ++i) { int R, C; stage_rc(tid * 16 + i * 8192, R, C); const int Rb = Epi::PERM ? ((R & ~31) + perm32(R & 31)) : R;
        sR[i] = R; sC[i] = C; vA0[i] = (unsigned)(R * K + C) * 2u; vA1[i] = vA0[i] + (unsigned)(HALF * K * 2); nvA0[i] = vA0[i]; nvA1[i] = vA1[i]; voffB[i] = (unsigned)(Rb * K + C) * 2u; }
    const size_t kstep = (size_t)(BK * 2);
    const size_t hstep = (size_t)HALF * K * 2;
    const unsigned ldsw = (unsigned)wid * 1024u;
    const int aoff = lds_byte(wr * 64 + fr, fq * 8), boff = lds_byte(wc * 32 + fr, fq * 8);
#define PG8_SA(b, h) (((b) * 2 + (h)) * HTB)
#define PG8_SB(b, h) ((4 + (b) * 2 + (h)) * HTB)
#define PG8_STAGE(bufoff, gbase, voff) do { _Pragma("unroll") for (int _i = 0; _i < 2; ++_i) \
        __builtin_amdgcn_global_load_lds((const unsigned*)((const char*)(gbase) + (voff)[_i]), (PG8_LAS unsigned*)(lds + (bufoff) + ldsw + _i * 8192), 16, 0, 0); } while (0)
#define PG8_LDA(dst, b, h) do { _Pragma("unroll") for (int m = 0; m < 4; ++m) _Pragma("unroll") for (int k = 0; k < 2; ++k) dst[m][k] = *(const PG8_LAS bf16x8*)(lds + PG8_SA(b, h) + aoff + m * 2048 + k * 1024); } while (0)
#define PG8_LDB(dst, b, h) do { _Pragma("unroll") for (int n = 0; n < 2; ++n) _Pragma("unroll") for (int k = 0; k < 2; ++k) dst[n][k] = *(const PG8_LAS bf16x8*)(lds + PG8_SB(b, h) + boff + n * 2048 + k * 1024); } while (0)
#define PG8_MMA(ai, bj, At, Bt) do { __builtin_amdgcn_s_setprio(1); _Pragma("unroll") for (int m = 0; m < 4; ++m) _Pragma("unroll") for (int n = 0; n < 2; ++n) _Pragma("unroll") for (int k = 0; k < 2; ++k) \
        acc[ai][bj][m][n] = __builtin_amdgcn_mfma_f32_16x16x32_bf16(Bt[n][k], At[m][k], acc[ai][bj][m][n], 0, 0, 0); __builtin_amdgcn_s_setprio(0); } while (0)
#define PG8_WAIT_V(n) asm volatile("s_waitcnt vmcnt(" #n ")" ::: "memory")
#define PG8_WAIT_L(n) asm volatile("s_waitcnt lgkmcnt(" #n ")" ::: "memory")
#define PG8_BAR __builtin_amdgcn_s_barrier()
#define PG8_SCHED __builtin_amdgcn_sched_barrier(0)
    Unit cur, nxt; int ui = 0;
    if (!S.next(0, cur)) return;
    if constexpr (Sched::GATHER) {
#pragma unroll
        for (int i = 0; i < 2; ++i) { vA0[i] = (unsigned)S.rowmap[cur.pm * BM + sR[i]] * (unsigned)(K * 2) + (unsigned)sC[i] * 2u; vA1[i] = (unsigned)S.rowmap[cur.pm * BM + HALF + sR[i]] * (unsigned)(K * 2) + (unsigned)sC[i] * 2u; nvA0[i] = vA0[i]; nvA1[i] = vA1[i]; }
    }
    f32x4 acc[2][2][4][2];
#pragma unroll
    for (int a = 0; a < 2; ++a)
#pragma unroll
        for (int b = 0; b < 2; ++b)
#pragma unroll
            for (int m = 0; m < 4; ++m)
#pragma unroll
                for (int n = 0; n < 2; ++n) acc[a][b][m][n] = (f32x4){0.f, 0.f, 0.f, 0.f};
    bf16x8 At[4][2], B0[2][2], B1[2][2];
    const char* cA = cur.A; const char* cB = cur.B;
    S.a_ready(cur);
    if constexpr (SP2) {
        PG8_STAGE(PG8_SB(0, 0), cB, voffB); PG8_STAGE(PG8_SB(0, 1), cB + hstep, voffB); PG8_STAGE(PG8_SA(0, 0), cA, vA0); PG8_STAGE(PG8_SA(0, 1), cA, vA1);
        if (wr == 1) PG8_BAR;
        PG8_WAIT_V(2); PG8_BAR;
        PG8_STAGE(PG8_SB(1, 0), cB + kstep, voffB); PG8_STAGE(PG8_SA(1, 0), cA + kstep, vA0); PG8_STAGE(PG8_SB(1, 1), cB + hstep + kstep, voffB);
        PG8_WAIT_V(6); PG8_BAR;
    } else {
        PG8_STAGE(PG8_SB(0, 0), cB, voffB); PG8_STAGE(PG8_SA(0, 0), cA, vA0); PG8_STAGE(PG8_SB(0, 1), cB + hstep, voffB); PG8_STAGE(PG8_SA(0, 1), cA, vA1);
        if (wr == 1) PG8_BAR;
        PG8_WAIT_V(4); PG8_BAR;
        PG8_STAGE(PG8_SB(1, 0), cB + kstep, voffB); PG8_STAGE(PG8_SA(1, 0), cA + kstep, vA0); PG8_STAGE(PG8_SB(1, 1), cB + hstep + kstep, voffB);
        PG8_WAIT_V(6); PG8_BAR;
    }
    for (;;) {
        const bool has_next = S.next(ui + 1, nxt);
        const char* nA = has_next ? nxt.A : cA; const char* nB = has_next ? nxt.B : cB;
        if constexpr (Sched::GATHER) { if (has_next) {
#pragma unroll
            for (int i = 0; i < 2; ++i) { nvA0[i] = (unsigned)S.rowmap[nxt.pm * BM + sR[i]] * (unsigned)(K * 2) + (unsigned)sC[i] * 2u; nvA1[i] = (unsigned)S.rowmap[nxt.pm * BM + HALF + sR[i]] * (unsigned)(K * 2) + (unsigned)sC[i] * 2u; } } }
#pragma unroll 1
        for (int t = 0; t < nt; t += 2) {
            const bool last = (t == nt - 2);
            const char* a1 = cA + (size_t)(t + 1) * kstep;
            const char* a2 = last ? nA : cA + (size_t)(t + 2) * kstep; const char* b2 = last ? nB : cB + (size_t)(t + 2) * kstep;
            const char* a3 = a2 + kstep; const char* b3 = b2 + kstep;
            if (last && has_next) S.a_ready(nxt);
            unsigned wA0[2] = {vA0[0], vA0[1]}, wA1[2] = {vA1[0], vA1[1]};
            if constexpr (Sched::GATHER) { if (last) { asm volatile("" : "+v"(nvA0[0]), "+v"(nvA0[1]), "+v"(nvA1[0]), "+v"(nvA1[1])); wA0[0] = nvA0[0]; wA0[1] = nvA0[1]; wA1[0] = nvA1[0]; wA1[1] = nvA1[1]; } }
            if constexpr (SP2) {
            PG8_LDB(B0, 0, 0); PG8_LDB(B1, 0, 1); PG8_SCHED; PG8_LDA(At, 0, 0); PG8_STAGE(PG8_SA(1, 1), a1, vA1);
            PG8_WAIT_V(8); PG8_WAIT_L(0); PG8_BAR; PG8_MMA(0, 0, At, B0); PG8_MMA(0, 1, At, B1); PG8_BAR; PG8_SCHED;
            PG8_LDA(At, 0, 1); PG8_STAGE(PG8_SB(0, 0), b2, voffB); PG8_STAGE(PG8_SB(0, 1), b2 + hstep, voffB); PG8_STAGE(PG8_SA(0, 0), a2, wA0);
            PG8_WAIT_V(8); PG8_WAIT_L(0); PG8_BAR; PG8_MMA(1, 0, At, B0); PG8_MMA(1, 1, At, B1); PG8_BAR; PG8_SCHED;
            PG8_LDB(B0, 1, 0); PG8_LDB(B1, 1, 1); PG8_SCHED; PG8_LDA(At, 1, 0); PG8_STAGE(PG8_SA(0, 1), a2, wA1);
            PG8_WAIT_V(8); PG8_WAIT_L(0); PG8_BAR; PG8_MMA(0, 0, At, B0); PG8_MMA(0, 1, At, B1); PG8_BAR; PG8_SCHED;
            PG8_LDA(At, 1, 1); PG8_STAGE(PG8_SB(1, 0), b3, voffB); PG8_STAGE(PG8_SB(1, 1), b3 + hstep, voffB); PG8_STAGE(PG8_SA(1, 0), a3, wA0);
            PG8_WAIT_V(8); PG8_WAIT_L(0); PG8_BAR; PG8_MMA(1, 0, At, B0); PG8_MMA(1, 1, At, B1); PG8_BAR; PG8_SCHED;
            } else {
            PG8_LDB(B0, 0, 0); PG8_SCHED; PG8_LDA(At, 0, 0); PG8_STAGE(PG8_SA(1, 1), a1, vA1);
            PG8_WAIT_L(8); PG8_BAR; PG8_WAIT_L(0); PG8_MMA(0, 0, At, B0); PG8_BAR; PG8_SCHED;
            PG8_LDB(B1, 0, 1); PG8_STAGE(PG8_SB(0, 0), b2, voffB);
            PG8_BAR; PG8_WAIT_L(0); PG8_MMA(0, 1, At, B1); PG8_BAR;
            PG8_LDA(At, 0, 1); PG8_STAGE(PG8_SA(0, 0), a2, wA0);
            PG8_BAR; PG8_WAIT_L(0); PG8_MMA(1, 0, At, B0); PG8_BAR; PG8_SCHED;
            PG8_STAGE(PG8_SB(0, 1), b2 + hstep, voffB);
            PG8_WAIT_V(6); PG8_BAR; PG8_MMA(1, 1, At, B1); PG8_BAR;
            PG8_LDB(B0, 1, 0); PG8_SCHED; PG8_LDA(At, 1, 0); PG8_STAGE(PG8_SA(0, 1), a2, wA1);
            PG8_WAIT_L(8); PG8_BAR; PG8_WAIT_L(0); PG8_MMA(0, 0, At, B0); PG8_BAR; PG8_SCHED;
            PG8_LDB(B1, 1, 1); PG8_STAGE(PG8_SB(1, 0), b3, voffB);
            PG8_BAR; PG8_WAIT_L(0); PG8_MMA(0, 1, At, B1); PG8_BAR;
            PG8_LDA(At, 1, 1); PG8_STAGE(PG8_SA(1, 0), a3, wA0);
            PG8_BAR; PG8_WAIT_L(0); PG8_MMA(1, 0, At, B0); PG8_BAR; PG8_SCHED;
            PG8_STAGE(PG8_SB(1, 1), b3 + hstep, voffB);
            PG8_WAIT_V(6); PG8_BAR; PG8_MMA(1, 1, At, B1); PG8_BAR;
            }
        }
        if constexpr (ALIGN_EPI) { if (wr == 0) PG8_BAR; }
        if constexpr (!Epi::AFTER_DRAIN) { E(acc, cur, wr, wc, fr, fq); S.done(cur); }
        if (!has_next) break;
#pragma unroll
        for (int a = 0; a < 2; ++a)
#pragma unroll
            for (int b = 0; b < 2; ++b)
#pragma unroll
                for (int m = 0; m < 4; ++m)
#pragma unroll
                    for (int n = 0; n < 2; ++n) acc[a][b][m][n] = (f32x4){0.f, 0.f, 0.f, 0.f};
        cur = nxt; cA = nA; cB = nB; ++ui;
        if constexpr (Sched::GATHER) { vA0[0] = nvA0[0]; vA0[1] = nvA0[1]; vA1[0] = nvA1[0]; vA1[1] = nvA1[1]; }
        if constexpr (ALIGN_EPI) { if (wr == 1) PG8_BAR; }
    }
    PG8_WAIT_V(0);
    if constexpr (!ALIGN_EPI) { if (wr == 0) PG8_BAR; }
    PG8_BAR;
    if constexpr (Epi::AFTER_DRAIN) { E.fused(acc, cur, wr, wc, fr, fq, lds, wid, lane); S.done(cur); }
#undef PG8_SA
#undef PG8_SB
#undef PG8_STAGE
#undef PG8_LDA
#undef PG8_LDB
#undef PG8_MMA
#undef PG8_WAIT_V
#undef PG8_WAIT_L
#undef PG8_BAR
#undef PG8_SCHED
}
}


#define LAS __attribute__((address_space(3)))
typedef unsigned short bf16;
typedef float f32x4 __attribute__((ext_vector_type(4)));
typedef float f32x2 __attribute__((ext_vector_type(2)));
typedef float f32x16 __attribute__((ext_vector_type(16)));
typedef unsigned u32x4 __attribute__((ext_vector_type(4)));
typedef unsigned u32x2 __attribute__((ext_vector_type(2)));
typedef short bf16x8 __attribute__((ext_vector_type(8)));
typedef short s16x4 __attribute__((ext_vector_type(4)));

constexpr int NB = 8, SEQ = 4096, DMODEL = 1024, MTOK = NB * SEQ, NHEAD = 8, HDIM = 64, BRD = 512;
constexpr int NEXP = 32, TOPK = 4, MAXTILES = 544, MAXSLOTS = MAXTILES * 256;
constexpr float DN_ALPHA = 1.189207115002721f, LN_EPS = 1e-5f, GN_EPS = 64e-5f;
constexpr int NWAVES = 8, NTHREADS = 512;
constexpr int LDS_BYTES = 155648;

constexpr size_t MiB = 1u << 20;
constexpr size_t WS_CTL = 0, CTL_BYTES = 128 * 1024;
constexpr size_t WS_WIN_T = 1 * MiB, WS_WLORA_T = 12 * MiB, WS_WR_T = 13 * MiB, WS_WA_T = 14 * MiB, WS_WO_T = 15 * MiB, WS_W1T = 17 * MiB, WS_W2T = 145 * MiB;
constexpr size_t WS_KMEAN = 209 * MiB, WS_ROPE = 209 * MiB + 512 * 1024, WS_TOKE = 210 * MiB, WS_TOKW = 210 * MiB + 512 * 1024, WS_SLOTOF = 211 * MiB, WS_ROWTOK = 212 * MiB, WS_ROWW = 213 * MiB;
constexpr size_t WS_D = 216 * MiB;
constexpr size_t WS_PG = WS_D, WS_PQ = WS_D + 128 * MiB, WS_PK = WS_D + 160 * MiB, WS_PAV = WS_D + 192 * MiB, WS_PRKV = WS_D + 224 * MiB, WS_PLR = WS_D + 320 * MiB;
constexpr size_t WS_LORA = WS_D + 320 * MiB, WS_ALORA = WS_D + 416 * MiB, WS_XB = WS_D + 432 * MiB, WS_BONUS = WS_D + 416 * MiB;
constexpr size_t WS_YRAW = WS_D + 480 * MiB, WS_YRWKV = WS_D + 288 * MiB, WS_TMP = WS_D + 416 * MiB, WS_MERGED = WS_D + 544 * MiB, WS_XPRE = WS_D + 608 * MiB;
constexpr size_t WS_X1 = WS_D, WS_X1B = WS_D + 128 * MiB, WS_XPERM = WS_D + 192 * MiB, WS_ACT = WS_D + 464 * MiB, WS_YBUF = WS_D + 192 * MiB;
constexpr size_t WS_END = WS_D + 800 * MiB;
constexpr int CW_COUNT = 0, CW_NTILES = 64, CW_TILE_E = 128, CW_WGBASE = 1024, CW_XBAR = 16384;

struct Params { const float* in[26]; float* out; unsigned char* ws; int ph_lo, ph_hi; };
struct Ctx { LAS unsigned char* lds; int tid, lane, wave, gw, ngw, G, bid; };

__device__ __forceinline__ unsigned f2bf(float f) { unsigned u = __builtin_bit_cast(unsigned, f); return (u + 0x7fffu + ((u >> 16) & 1u)) >> 16; }
__device__ __forceinline__ unsigned pk2(float lo, float hi) { return f2bf(lo) | (f2bf(hi) << 16); }
__device__ __forceinline__ float bf2f(bf16 v) { return __builtin_bit_cast(float, (unsigned)v << 16); }
__device__ __forceinline__ float bflo(unsigned w) { return __builtin_bit_cast(float, w << 16); }
__device__ __forceinline__ float bfhi(unsigned w) { return __builtin_bit_cast(float, w & 0xffff0000u); }
__device__ __forceinline__ float wave_sum(float v) {
#pragma unroll
    for (int o = 1; o < 64; o <<= 1) v += __shfl_xor(v, o);
    return v;
}
__device__ __forceinline__ float sigmf(float x) { return 1.0f / (1.0f + __expf(-x)); }

__device__ __forceinline__ void transpose_item(const float* W, int K, int N, bf16* WT, int k0, int n0, int dst_row0, LAS float* scr, int lane) {
#pragma unroll 8
    for (int i = 0; i < 32; ++i) { const int kk = 2 * i + (lane >> 5); scr[kk * 33 + (lane & 31)] = W[(size_t)(k0 + kk) * N + n0 + (lane & 31)]; }
    asm volatile("s_waitcnt lgkmcnt(0)" ::: "memory");
    const int c = lane & 7;
#pragma unroll
    for (int j = 0; j < 4; ++j) { const int n = (lane >> 3) + 8 * j; const LAS float* s = scr + (8 * c) * 33 + n;
        u32x4 o; o.x = pk2(s[0 * 33], s[1 * 33]); o.y = pk2(s[2 * 33], s[3 * 33]); o.z = pk2(s[4 * 33], s[5 * 33]); o.w = pk2(s[6 * 33], s[7 * 33]);
        *(u32x4*)(WT + (size_t)(dst_row0 + n) * K + k0 + 8 * c) = o; }
    asm volatile("s_waitcnt lgkmcnt(0)" ::: "memory");
}
__device__ __forceinline__ void phase0(const Params& p, const Ctx& c) {
    unsigned char* ws = p.ws;
    LAS float* scr = (LAS float*)(c.lds + c.wave * 16384);
    constexpr int I0 = 16 * 168, I1 = 8 * 32, I2 = 8 * 32, I3 = 16 * 32, I4 = 32 * 1024, I5 = 32 * 512, NIT = I0 + I1 + I2 + I3 + I4 + I5;
    for (int it = c.gw; it < NIT; it += c.ngw) {
        int r = it;
        if (r < I0) { transpose_item(p.in[5], 1024, 5376, (bf16*)(ws + WS_WIN_T), 64 * (r / 168), 32 * (r % 168), 32 * (r % 168), scr, c.lane); continue; } r -= I0;
        if (r < I1) { transpose_item(p.in[17], 512, 1024, (bf16*)(ws + WS_WR_T), 64 * (r / 32), 32 * (r % 32), 32 * (r % 32), scr, c.lane); continue; } r -= I1;
        if (r < I2) { transpose_item(p.in[18], 512, 1024, (bf16*)(ws + WS_WA_T), 64 * (r / 32), 32 * (r % 32), 32 * (r % 32), scr, c.lane); continue; } r -= I2;
        if (r < I3) { transpose_item(p.in[19], 1024, 1024, (bf16*)(ws + WS_WO_T), 64 * (r / 32), 32 * (r % 32), 32 * (r % 32), scr, c.lane); continue; } r -= I3;
        if (r < I4) { const int e = r >> 10, rr = r & 1023, n0 = 32 * (rr & 63);
            const int dst = n0 < 1024 ? (n0 >> 7) * 256 + (n0 & 127) : ((n0 - 1024) >> 7) * 256 + 128 + ((n0 - 1024) & 127);
            transpose_item(p.in[22] + (size_t)e * 1024 * 2048, 1024, 2048, (bf16*)(ws + WS_W1T) + (size_t)e * 2048 * 1024, 64 * (rr >> 6), n0, dst, scr, c.lane); continue; } r -= I4;
        { const int e = r >> 9, rr = r & 511; transpose_item(p.in[24] + (size_t)e * 1024 * 1024, 1024, 1024, (bf16*)(ws + WS_W2T) + (size_t)e * 1024 * 1024, 64 * (rr >> 5), 32 * (rr & 31), 32 * (rr & 31), scr, c.lane); }
    }
    const int gt = c.bid * NTHREADS + c.tid, ngt = c.G * NTHREADS;
    { bf16* WL = (bf16*)(ws + WS_WLORA_T); const float* du = p.in[8]; const float* iu = p.in[10]; const float* gu = p.in[11];
      for (int i = gt; i < 1536 * 256; i += ngt) { const int n = i >> 8, k = i & 255; float v = 0.f;
          if (n < 512) { if (k < 64) v = du[k * 512 + n]; } else if (n < 1024) { if (k >= 64 && k < 128) v = iu[(k - 64) * 512 + (n - 512)]; } else { if (k >= 128) v = gu[(k - 128) * 512 + (n - 1024)]; }
          WL[i] = (bf16)f2bf(v); } }
    { float* RT = (float*)(ws + WS_ROPE); for (int i = gt; i < SEQ * 8; i += ngt) { const int pos = i >> 3, j = i & 7; float sn, cs; sincosf((float)pos * powf(500000.0f, -(float)j * 0.125f), &sn, &cs); RT[pos * 16 + j] = cs; RT[pos * 16 + 8 + j] = sn; }
      int* RTK = (int*)(ws + WS_ROWTOK); for (int i = gt; i < MAXSLOTS; i += ngt) RTK[i] = 0;
      float* KMz = (float*)(ws + WS_KMEAN); for (int i = gt; i < NB * NHEAD * 16 * 64; i += ngt) KMz[i] = 0.f; }
    { const f32x4* x4 = (const f32x4*)p.in[0]; u32x2* o = (u32x2*)(ws + WS_XB);
      for (int i = gt; i < MTOK * DMODEL / 4; i += ngt) { const f32x4 v = x4[i]; u32x2 w; w.x = pk2(v[0], v[1]); w.y = pk2(v[2], v[3]); o[i] = w; } }
}

__device__ __forceinline__ void phase2(const Params& p, const Ctx& c) {
    unsigned char* ws = p.ws;
    { const bf16* __restrict__ PLR = (const bf16*)(ws + WS_PLR); bf16* __restrict__ AL = (bf16*)(ws + WS_ALORA); const float* mix = p.in[6] + 1536;
      const int j0 = c.lane * 4; const f32x4 mx = *(const f32x4*)(mix + j0);
      for (int m0 = 4 * c.gw; m0 < MTOK; m0 += 4 * c.ngw) {
          u32x2 r[5]; u32x2 z; z.x = 0u; z.y = 0u; r[0] = z;
          if ((m0 & (SEQ - 1)) != 0) r[0] = *(const u32x2*)(PLR + (size_t)(m0 - 1) * 256 + j0);
#pragma unroll
          for (int u = 0; u < 4; ++u) r[u + 1] = *(const u32x2*)(PLR + (size_t)(m0 + u) * 256 + j0);
#pragma unroll
          for (int u = 0; u < 4; ++u) { const f32x4 cu = {bflo(r[u + 1].x), bfhi(r[u + 1].x), bflo(r[u + 1].y), bfhi(r[u + 1].y)}, pv = {bflo(r[u].x), bfhi(r[u].x), bflo(r[u].y), bfhi(r[u].y)};
              f32x4 s = cu + (pv - cu) * mx;
#pragma unroll
              for (int i = 0; i < 4; ++i) { if (c.lane < 16) s[i] = tanhf(s[i]); else if (c.lane >= 32) s[i] = sigmf(s[i]); }
              u32x2 o; o.x = pk2(s[0], s[1]); o.y = pk2(s[2], s[3]); *(u32x2*)(AL + (size_t)(m0 + u) * 256 + j0) = o; } } }
    { bf16* Q = (bf16*)(ws + WS_PQ); bf16* K = (bf16*)(ws + WS_PK); const float* RT = (const float*)(ws + WS_ROPE);
      for (int g = c.gw; g < MTOK / 4; g += c.ngw) { const int tok = 4 * g + (c.lane >> 4), which = (c.lane >> 3) & 1, h = c.lane & 7;
          bf16* P = (which ? K : Q) + (size_t)tok * 512 + h * 64; const float* rt = RT + (size_t)(tok & (SEQ - 1)) * 16;
          const u32x4 a = *(const u32x4*)P, bq = *(const u32x4*)(P + 8); const f32x4 c0 = *(const f32x4*)rt, c1 = *(const f32x4*)(rt + 4), s0 = *(const f32x4*)(rt + 8), s1 = *(const f32x4*)(rt + 12);
          const float x1[8] = {bflo(a.x), bfhi(a.x), bflo(a.y), bfhi(a.y), bflo(a.z), bfhi(a.z), bflo(a.w), bfhi(a.w)}, x2[8] = {bflo(bq.x), bfhi(bq.x), bflo(bq.y), bfhi(bq.y), bflo(bq.z), bfhi(bq.z), bflo(bq.w), bfhi(bq.w)};
          const float cs[8] = {c0[0], c0[1], c0[2], c0[3], c1[0], c1[1], c1[2], c1[3]}, sn[8] = {s0[0], s0[1], s0[2], s0[3], s1[0], s1[1], s1[2], s1[3]};
          float o1[8], o2[8];
#pragma unroll
          for (int i = 0; i < 8; ++i) { o1[i] = x1[i] * cs[i] - x2[i] * sn[i]; o2[i] = x2[i] * cs[i] + x1[i] * sn[i]; }
          u32x4 w1, w2; w1.x = pk2(o1[0], o1[1]); w1.y = pk2(o1[2], o1[3]); w1.z = pk2(o1[4], o1[5]); w1.w = pk2(o1[6], o1[7]); w2.x = pk2(o2[0], o2[1]); w2.y = pk2(o2[2], o2[3]); w2.z = pk2(o2[4], o2[5]); w2.w = pk2(o2[6], o2[7]);
          *(u32x4*)P = w1; *(u32x4*)(P + 8) = w2; } }
}
__device__ __forceinline__ void kmean_items(const Params& p, const Ctx& c) {
    const bf16* __restrict__ K = (const bf16*)(p.ws + WS_PK); float* KM = (float*)(p.ws + WS_KMEAN);
    for (int item = c.bid; item < NB * 32; item += c.G) { const int b = item >> 5, blk = (item >> 1) & 15, hf = item & 1, h = c.tid >> 6, d = c.tid & 63; const bf16* kp = K + ((size_t)b * SEQ + blk * 256 + hf * 128) * 512 + c.tid; float s = 0.f;
#pragma unroll 32
        for (int tok = 0; tok < 128; ++tok) s += bf2f(kp[(size_t)tok * 512]);
        atomicAdd(KM + ((size_t)((b * 8 + h) * 16 + blk)) * 64 + d, s * (1.0f / 256.0f)); }
}

template <int CTRL> __device__ __forceinline__ float dppf(float x) { return __builtin_bit_cast(float, __builtin_amdgcn_update_dpp(0, __builtin_bit_cast(int, x), CTRL, 0xF, 0xF, true)); }
__device__ __forceinline__ float row16_sum(float x) {
    x += dppf<0xB1>(x);
    x += dppf<0x4E>(x);
    x += dppf<0x141>(x);
    x += dppf<0x140>(x);
    return x;
}
__device__ __forceinline__ float wave_sum_dpp(float x) {
    x = row16_sum(x);
    x += __builtin_bit_cast(float, __builtin_amdgcn_update_dpp(0, __builtin_bit_cast(int, x), 0x142, 0xA, 0xF, false));
    x += __builtin_bit_cast(float, __builtin_amdgcn_update_dpp(0, __builtin_bit_cast(int, x), 0x143, 0xC, 0xF, false));
    return __builtin_bit_cast(float, __builtin_amdgcn_readlane(__builtin_bit_cast(int, x), 63));
}
constexpr int SCAN_TC = 32, SCAN_CHUNK_F = SCAN_TC * 384;
__device__ __forceinline__ f32x4 unpk4(u32x2 w) { return (f32x4){bflo(w.x), bfhi(w.x), bflo(w.y), bfhi(w.y)}; }
struct PrepConst { f32x4 mr, mk, mv, w0, a0, kk, ka, rk; };
__device__ __forceinline__ void prep_load(u32x2 (&raw)[8], const bf16* RKVh, const bf16* LOh, size_t m, bool has_prev) {
    const bf16* row = RKVh + m * 1536;
    raw[0] = *(const u32x2*)(row); raw[1] = *(const u32x2*)(row + 512); raw[2] = *(const u32x2*)(row + 1024);
    u32x2 z; z.x = 0u; z.y = 0u; raw[3] = z; raw[4] = z; raw[5] = z;
    if (has_prev) { raw[3] = *(const u32x2*)(row - 1536); raw[4] = *(const u32x2*)(row - 1536 + 512); raw[5] = *(const u32x2*)(row - 1536 + 1024); }
    raw[6] = *(const u32x2*)(LOh + m * 1536); raw[7] = *(const u32x2*)(LOh + m * 1536 + 512);
}
__device__ __forceinline__ void prep_pass(const u32x2 (&raw)[8], const PrepConst& k, LAS float* dst  , float* bonus  ) {
    f32x4 r = unpk4(raw[0]), kx = unpk4(raw[1]), v = unpk4(raw[2]); const f32x4 rp = unpk4(raw[3]), kp = unpk4(raw[4]), vp = unpk4(raw[5]), lw = unpk4(raw[6]), la = unpk4(raw[7]);
    r = r + (rp - r) * k.mr; kx = kx + (kp - kx) * k.mk; v = v + (vp - v) * k.mv;
    f32x4 dec, a;
#pragma unroll
    for (int i = 0; i < 4; ++i) { const float sg = 1.0f / (1.0f + __expf(-(k.w0[i] + lw[i]))); dec[i] = __expf(-0.6065306597126334f * sg); a[i] = 1.0f / (1.0f + __expf(-(k.a0[i] + la[i]))); }
    const f32x4 kkv = kx * k.kk; float ss = (kkv[0] * kkv[0] + kkv[1] * kkv[1]) + (kkv[2] * kkv[2] + kkv[3] * kkv[3]); ss = row16_sum(ss);
    const float inv = 1.0f / fmaxf(sqrtf(ss), 1e-12f); const f32x4 kk = kkv * inv; const f32x4 kmod = kx * ((a - 1.0f) * k.ka + 1.0f);
    const f32x4 rb = r * kmod * k.rk; float bs = (rb[0] + rb[1]) + (rb[2] + rb[3]); bs = row16_sum(bs);
    *(LAS f32x4*)(dst) = -kk; *(LAS f32x4*)(dst + 64) = kk * a; *(LAS f32x4*)(dst + 128) = dec; *(LAS f32x4*)(dst + 192) = kmod; *(LAS f32x4*)(dst + 256) = r; *(LAS f32x4*)(dst + 320) = v;
    if (bonus) *(f32x4*)bonus = v * bs;
}
__device__ __forceinline__ void scan_item(const Params& p, const Ctx& c, int item) {
    const int bh = item >> 2, rg = item & 3, b = bh >> 3, h = bh & 7;
    LAS float* buf = (LAS float*)c.lds;
    constexpr int NC = SEQ / SCAN_TC;
    const int pt = c.tid & 255, tl = pt >> 4, cq = pt & 15, ch0 = h * 64 + 4 * cq;
    const bf16* RKVh = (const bf16*)(p.ws + WS_PRKV) + ch0; const bf16* LOh = (const bf16*)(p.ws + WS_LORA) + ch0; float* BON = (float*)(p.ws + WS_BONUS) + ch0;
    const size_t mb = (size_t)b * SEQ;
    PrepConst pc; u32x2 raw0[8], raw1[8];
    const int rowl = (c.wave & 3) * 4 + (c.lane >> 4), kq = c.lane & 15, rowg = rg * 16 + rowl;
    f32x4 S = {0.f, 0.f, 0.f, 0.f};
    if (c.wave >= 4) {
        pc.mr = *(const f32x4*)(p.in[6] + ch0); pc.mk = *(const f32x4*)(p.in[6] + 512 + ch0); pc.mv = *(const f32x4*)(p.in[6] + 1024 + ch0);
        pc.w0 = *(const f32x4*)(p.in[7] + ch0); pc.a0 = *(const f32x4*)(p.in[9] + ch0); pc.kk = *(const f32x4*)(p.in[12] + ch0); pc.ka = *(const f32x4*)(p.in[13] + ch0); pc.rk = *(const f32x4*)(p.in[14] + ch0);
        prep_load(raw0, RKVh, LOh, mb + tl, tl != 0); prep_load(raw1, RKVh, LOh, mb + 16 + tl, true);
        prep_pass(raw0, pc, buf + tl * 384 + 4 * cq, rg == 0 ? BON + (mb + tl) * 512 : nullptr);
        prep_pass(raw1, pc, buf + (16 + tl) * 384 + 4 * cq, rg == 0 ? BON + (mb + 16 + tl) * 512 : nullptr);
        prep_load(raw0, RKVh, LOh, mb + SCAN_TC + tl, true); prep_load(raw1, RKVh, LOh, mb + SCAN_TC + 16 + tl, true);
    }
    __syncthreads();
    for (int ch = 0; ch < NC; ++ch) {
        if (c.wave < 4) {
            const LAS float* cb = buf + (ch & 1) * SCAN_CHUNK_F;
            float* yo = (float*)(p.ws + WS_YRAW) + (mb + (size_t)ch * SCAN_TC + kq) * 512 + h * 64 + rowg;
            f32x4 nk = *(const LAS f32x4*)(cb + 4 * kq), ka = *(const LAS f32x4*)(cb + 64 + 4 * kq), w = *(const LAS f32x4*)(cb + 128 + 4 * kq);
            f32x4 km = *(const LAS f32x4*)(cb + 192 + 4 * kq), rr = *(const LAS f32x4*)(cb + 256 + 4 * kq); float v = cb[320 + rowg];
            float ykeep = 0.f;
#pragma unroll
            for (int s = 0; s < SCAN_TC; ++s) {
                f32x4 nk2 = nk, ka2 = ka, w2 = w, km2 = km, rr2 = rr; float v2 = v;
                if (s + 1 < SCAN_TC) { const LAS float* op = cb + (s + 1) * 384;
                    nk2 = *(const LAS f32x4*)(op + 4 * kq); ka2 = *(const LAS f32x4*)(op + 64 + 4 * kq); w2 = *(const LAS f32x4*)(op + 128 + 4 * kq);
                    km2 = *(const LAS f32x4*)(op + 192 + 4 * kq); rr2 = *(const LAS f32x4*)(op + 256 + 4 * kq); v2 = op[320 + rowg]; }
                __builtin_amdgcn_sched_barrier(0);
                float sa = (S[0] * nk[0] + S[1] * nk[1]) + (S[2] * nk[2] + S[3] * nk[3]);
                const f32x4 T = S * w + km * v;
                sa = row16_sum(sa);
                S = T + ka * sa;
                float y = (S[0] * rr[0] + S[1] * rr[1]) + (S[2] * rr[2] + S[3] * rr[3]);
                y = row16_sum(y);
                ykeep = (kq == (s & 15)) ? y : ykeep;
                if ((s & 15) == 15) yo[(size_t)(s - 15) * 512] = ykeep;
                nk = nk2; ka = ka2; w = w2; km = km2; rr = rr2; v = v2;
            }
        } else if (ch + 1 < NC) {
            LAS float* nb = buf + ((ch + 1) & 1) * SCAN_CHUNK_F; const size_t m1 = mb + (size_t)(ch + 1) * SCAN_TC;
            prep_pass(raw0, pc, nb + tl * 384 + 4 * cq, rg == 0 ? BON + (m1 + tl) * 512 : nullptr);
            prep_pass(raw1, pc, nb + (16 + tl) * 384 + 4 * cq, rg == 0 ? BON + (m1 + 16 + tl) * 512 : nullptr);
            if (ch + 2 < NC) { prep_load(raw0, RKVh, LOh, m1 + SCAN_TC + tl, true); prep_load(raw1, RKVh, LOh, m1 + SCAN_TC + 16 + tl, true); }
        }
        __syncthreads();
    }
}

namespace att {
constexpr int L_K = 0, L_V = 16384, L_KM = 32768, L_SEL = 36864, L_WS = 37888;
constexpr float C2 = 0.125f * 1.4426950408889634f;
__device__ __forceinline__ int crow(int r, int hi) { return (r & 3) + 8 * (r >> 2) + 4 * hi; }
typedef __bf16 bf16x2_t __attribute__((ext_vector_type(2)));
__device__ __forceinline__ unsigned cvtpk(float lo, float hi) { f32x2 v = {lo, hi}; bf16x2_t b = __builtin_convertvector(v, bf16x2_t); return __builtin_bit_cast(unsigned, b); }
typedef short v4i16_t __attribute__((ext_vector_type(4)));
__device__ __forceinline__ s16x4 vtr(const LAS unsigned char* p) { return __builtin_bit_cast(s16x4, __builtin_amdgcn_ds_read_tr16_b64_v4i16((LAS v4i16_t*)p)); }

__device__ __forceinline__ void unit(const Params& p, const Ctx& c, int b, int h, int qb, bf16* Oout) {
    const int tid = c.tid, lane = c.lane, wid = c.wave, r32 = lane & 31, hi = lane >> 5;
    bf16* Q = (bf16*)(p.ws + WS_PQ); const bf16* K = (const bf16*)(p.ws + WS_PK); const bf16* V = (const bf16*)(p.ws + WS_PAV); const float* KMg = (const float*)(p.ws + WS_KMEAN);
    const size_t rowbase = (size_t)b * SEQ; const int q0 = qb * 256;
    LAS unsigned char* lds = c.lds; LAS float* kml = (LAS float*)(lds + L_KM); LAS unsigned* sell = (LAS unsigned*)(lds + L_SEL); LAS float* wsf = (LAS float*)(lds + L_WS) + wid * 64;
    for (int i = tid; i < qb * 64; i += NTHREADS) kml[i] = KMg[(size_t)((b * 8 + h) * 16) * 64 + i];
    __syncthreads();
    if (tid < 256) {
        const bf16* qrow = Q + (rowbase + q0 + tid) * 512 + h * 64; float qv[64];
#pragma unroll
        for (int i = 0; i < 8; ++i) { const u32x4 w = *(const u32x4*)(qrow + 8 * i); qv[8 * i] = bflo(w.x); qv[8 * i + 1] = bfhi(w.x); qv[8 * i + 2] = bflo(w.y); qv[8 * i + 3] = bfhi(w.y); qv[8 * i + 4] = bflo(w.z); qv[8 * i + 5] = bfhi(w.z); qv[8 * i + 6] = bflo(w.w); qv[8 * i + 7] = bfhi(w.w); }
        float v0 = -INFINITY, v1 = -INFINITY, v2 = -INFINITY; int i0 = -1, i1 = -1, i2 = -1;
        for (int j = 0; j < qb; ++j) { float g = 0.f;
#pragma unroll
            for (int d = 0; d < 64; d += 4) { const f32x4 km = *(const LAS f32x4*)(kml + j * 64 + d); g += qv[d] * km[0] + qv[d + 1] * km[1] + qv[d + 2] * km[2] + qv[d + 3] * km[3]; }
            if (g > v0) { v2 = v1; i2 = i1; v1 = v0; i1 = i0; v0 = g; i0 = j; } else if (g > v1) { v2 = v1; i2 = i1; v1 = g; i1 = j; } else if (g > v2) { v2 = g; i2 = j; } }
        unsigned msk = 0u; if (i0 >= 0) msk |= 1u << i0; if (i1 >= 0) msk |= 1u << i1; if (i2 >= 0) msk |= 1u << i2;
        sell[tid] = msk;
    }
    __syncthreads();
    const bf16* Qw = Q + (rowbase + q0 + wid * 32) * 512 + h * 64; bf16x8 qr[4];
#pragma unroll
    for (int d0 = 0; d0 < 4; ++d0) qr[d0] = *(const bf16x8*)(Qw + (size_t)r32 * 512 + d0 * 16 + hi * 8);
    const unsigned mysel = sell[wid * 32 + r32]; const int qrel = wid * 32 + r32;
    float m_run = -INFINITY, l_run = 0.f; f32x16 o0 = {}, o1 = {};
    const int krow = tid & 63, kch = tid >> 6; const bf16* ksrc = K + (rowbase + krow) * 512 + h * 64 + kch * 8; const int kdst = kch * 1024 + krow * 16;
    const int vrow = 16 * (wid & 3) + (lane >> 2), vcol = (wid >> 2) * 32 + (lane & 3) * 8; const bf16* vsrc = V + (rowbase + vrow) * 512 + h * 64 + vcol; const int vdst = wid * 1024 + lane * 16;
    const int kfo = hi * 1024 + r32 * 16; const int vfo = ((lane >> 4) & 1) * 32 + (lane & 3) * 8 + (4 * hi + ((lane & 15) >> 2)) * 64;
    const int ntile = 4 * qb + 4;
    u32x4 kreg = *(const u32x4*)(ksrc), vreg = *(const u32x4*)(vsrc);
    for (int it = 0; it < ntile; ++it) {
        LAS unsigned char* Ks = lds + L_K + (it & 1) * 8192; LAS unsigned char* Vs = lds + L_V + (it & 1) * 8192;
        *(LAS u32x4*)(Ks + kdst) = kreg; *(LAS u32x4*)(Vs + vdst) = vreg;
        __syncthreads();
        if (it + 1 < ntile) { kreg = *(const u32x4*)(ksrc + (size_t)(it + 1) * 64 * 512); vreg = *(const u32x4*)(vsrc + (size_t)(it + 1) * 64 * 512); }
        const int blk = it >> 2; const bool band = blk == qb; const int jb = it & 3;
        bool lane_on = band ? (64 * jb <= qrel) : (((mysel >> blk) & 1u) != 0u);
        if (__any(lane_on)) {
            f32x16 p0 = {}, p1 = {};
#pragma unroll
            for (int d0 = 0; d0 < 4; ++d0) { const bf16x8 k0 = *(const LAS bf16x8*)(Ks + kfo + d0 * 2048), k1 = *(const LAS bf16x8*)(Ks + kfo + d0 * 2048 + 512);
                p0 = __builtin_amdgcn_mfma_f32_32x32x16_bf16(k0, qr[d0], p0, 0, 0, 0); p1 = __builtin_amdgcn_mfma_f32_32x32x16_bf16(k1, qr[d0], p1, 0, 0, 0); }
#pragma unroll
            for (int r = 0; r < 16; ++r) { const int kv = 64 * jb + crow(r, hi);
                const bool ok0 = band ? (kv <= qrel) : lane_on, ok1 = band ? (kv + 32 <= qrel) : lane_on;
                p0[r] = ok0 ? p0[r] * C2 : -INFINITY; p1[r] = ok1 ? p1[r] * C2 : -INFINITY; }
            float rm = fmaxf(p0[0], p1[0]);
#pragma unroll
            for (int r = 1; r < 16; ++r) rm = fmaxf(rm, fmaxf(p0[r], p1[r]));
            rm = fmaxf(rm, __shfl_xor(rm, 32));
            const float m_new = fmaxf(m_run, rm); const float m_use = (m_new == -INFINITY) ? 0.f : m_new;
            const float alpha = __builtin_amdgcn_exp2f(m_run - m_use);
            float ps = 0.f;
#pragma unroll
            for (int r = 0; r < 16; ++r) { p0[r] = __builtin_amdgcn_exp2f(p0[r] - m_use); p1[r] = __builtin_amdgcn_exp2f(p1[r] - m_use); ps += p0[r] + p1[r]; }
            l_run = l_run * alpha + ps; m_run = m_new;
            if (__any(alpha != 1.0f)) {
                if (hi == 0) wsf[r32] = alpha;
                asm volatile("s_waitcnt lgkmcnt(0)" ::: "memory");
#pragma unroll
                for (int r = 0; r < 16; ++r) { const float f = wsf[crow(r, hi)]; o0[r] *= f; o1[r] *= f; }
                asm volatile("s_waitcnt lgkmcnt(0)" ::: "memory");
            }
            u32x4 pw[4];
            pw[0] = (u32x4){cvtpk(p0[0], p0[1]), cvtpk(p0[2], p0[3]), cvtpk(p0[4], p0[5]), cvtpk(p0[6], p0[7])};
            pw[1] = (u32x4){cvtpk(p0[8], p0[9]), cvtpk(p0[10], p0[11]), cvtpk(p0[12], p0[13]), cvtpk(p0[14], p0[15])};
            pw[2] = (u32x4){cvtpk(p1[0], p1[1]), cvtpk(p1[2], p1[3]), cvtpk(p1[4], p1[5]), cvtpk(p1[6], p1[7])};
            pw[3] = (u32x4){cvtpk(p1[8], p1[9]), cvtpk(p1[10], p1[11]), cvtpk(p1[12], p1[13]), cvtpk(p1[14], p1[15])};
#pragma unroll
            for (int ks = 0; ks < 4; ++ks) {
                const s16x4 a0 = vtr(Vs + vfo + ks * 1024), a1 = vtr(Vs + vfo + ks * 1024 + 512), b0 = vtr(Vs + vfo + 4096 + ks * 1024), b1 = vtr(Vs + vfo + 4096 + ks * 1024 + 512);
                const bf16x8 va = {a0[0], a0[1], a0[2], a0[3], a1[0], a1[1], a1[2], a1[3]}, vb = {b0[0], b0[1], b0[2], b0[3], b1[0], b1[1], b1[2], b1[3]};
                const bf16x8 pa = __builtin_bit_cast(bf16x8, pw[ks]);
                o0 = __builtin_amdgcn_mfma_f32_32x32x16_bf16(pa, va, o0, 0, 0, 0); o1 = __builtin_amdgcn_mfma_f32_32x32x16_bf16(pa, vb, o1, 0, 0, 0);
            }
        }
    }
    l_run += __shfl_xor(l_run, 32);
    if (hi == 0) wsf[32 + r32] = l_run;
    asm volatile("s_waitcnt lgkmcnt(0)" ::: "memory");
    bf16* Ow = Oout + (rowbase + q0 + wid * 32) * 512 + h * 64;
#pragma unroll
    for (int r = 0; r < 16; ++r) { const int qr_ = crow(r, hi); const float rl = 1.0f / wsf[32 + qr_];
        Ow[(size_t)qr_ * 512 + r32] = (bf16)f2bf(o0[r] * rl); Ow[(size_t)qr_ * 512 + 32 + r32] = (bf16)f2bf(o1[r] * rl); }
    __syncthreads();
}
}

__device__ __forceinline__ float sum8(float x) { x += dppf<0xB1>(x); x += dppf<0x4E>(x); x += dppf<0x141>(x); return x; }
__device__ __forceinline__ void phase6(const Params& p, const Ctx& c) {
    unsigned char* ws = p.ws; const float* __restrict__ YR = (const float*)(ws + WS_YRAW); const float* __restrict__ BON = (const float*)(ws + WS_BONUS); const bf16* __restrict__ LO = (const bf16*)(ws + WS_LORA); bf16* __restrict__ YO = (bf16*)(ws + WS_YRWKV);
    const int ch = 8 * c.lane; const f32x4 gg0 = *(const f32x4*)(p.in[15] + ch), gg1 = *(const f32x4*)(p.in[15] + ch + 4), gb0 = *(const f32x4*)(p.in[16] + ch), gb1 = *(const f32x4*)(p.in[16] + ch + 4);
    for (int m0 = 2 * c.gw; m0 < MTOK; m0 += 2 * c.ngw) {
        f32x4 y[2][2], bo[2][2]; u32x4 gw_[2];
#pragma unroll
        for (int u = 0; u < 2; ++u) { const size_t m = (size_t)(m0 + u); y[u][0] = *(const f32x4*)(YR + m * 512 + ch); y[u][1] = *(const f32x4*)(YR + m * 512 + ch + 4);
            bo[u][0] = *(const f32x4*)(BON + m * 512 + ch); bo[u][1] = *(const f32x4*)(BON + m * 512 + ch + 4); gw_[u] = *(const u32x4*)(LO + m * 1536 + 1024 + ch); }
#pragma unroll
        for (int u = 0; u < 2; ++u) { const size_t m = (size_t)(m0 + u);
            float s = ((y[u][0][0] + y[u][0][1]) + (y[u][0][2] + y[u][0][3])) + ((y[u][1][0] + y[u][1][1]) + (y[u][1][2] + y[u][1][3]));
            const float mu = sum8(s) * (1.0f / 64.0f); const f32x4 d0 = y[u][0] - mu, d1 = y[u][1] - mu;
            float q = ((d0[0] * d0[0] + d0[1] * d0[1]) + (d0[2] * d0[2] + d0[3] * d0[3])) + ((d1[0] * d1[0] + d1[1] * d1[1]) + (d1[2] * d1[2] + d1[3] * d1[3]));
            const float rs = rsqrtf(sum8(q) * (1.0f / 64.0f) + GN_EPS);
            const f32x4 g0 = {bflo(gw_[u].x), bfhi(gw_[u].x), bflo(gw_[u].y), bfhi(gw_[u].y)}, g1v = {bflo(gw_[u].z), bfhi(gw_[u].z), bflo(gw_[u].w), bfhi(gw_[u].w)};
            const f32x4 o0 = (d0 * rs * gg0 + gb0 + bo[u][0]) * g0, o1 = (d1 * rs * gg1 + gb1 + bo[u][1]) * g1v;
            u32x4 w; w.x = pk2(o0[0], o0[1]); w.y = pk2(o0[2], o0[3]); w.z = pk2(o1[0], o1[1]); w.w = pk2(o1[2], o1[3]);
            *(u32x4*)(YO + m * 512 + ch) = w; }
    }
}

constexpr int RW_PITCH = 36;
constexpr int L_HIST = 1024 * RW_PITCH * 4;
__device__ __forceinline__ void phase9(const Params& p, const Ctx& c, const bool dry = false) {
    unsigned char* ws = p.ws; const float* XP = (const float*)(ws + WS_XPRE); float* X1 = (float*)(ws + WS_X1); bf16* X1B = (bf16*)(ws + WS_X1B);
    int* ctl = (int*)(ws + WS_CTL); int* TOKE = (int*)(ws + WS_TOKE); float* TOKW = (float*)(ws + WS_TOKW);
    const float* g1 = p.in[1]; const float* b1 = p.in[2]; const float* RW = p.in[20]; const float* RB = p.in[21];
    LAS float* rw = (LAS float*)c.lds; LAS int* hist = (LAS int*)(c.lds + L_HIST);
    for (int i = c.tid; i < 1024 * 8; i += NTHREADS) { const int row = i >> 3, q = i & 7; *(LAS f32x4*)(rw + row * RW_PITCH + 4 * q) = *(const f32x4*)(RW + row * 32 + 4 * q); }
    if (c.tid < 32) { hist[c.tid] = 0; ((LAS float*)(c.lds + L_HIST + 256))[c.tid] = RB[c.tid]; }
    __syncthreads();
    float gv[16], bvv[16]; LAS float* rbl = (LAS float*)(c.lds + L_HIST + 256);
#pragma unroll
    for (int i = 0; i < 16; ++i) { gv[i] = g1[c.lane + 64 * i]; bvv[i] = b1[c.lane + 64 * i]; }
    for (int m = c.gw; m < MTOK; m += c.ngw) {
        const float* xr = XP + (size_t)m * 1024 + c.lane; float v[16]; float s = 0.f;
#pragma unroll
        for (int i = 0; i < 16; ++i) { v[i] = xr[64 * i]; s += v[i]; }
        const float mean = wave_sum_dpp(s) * (1.0f / 1024.0f); float s2 = 0.f;
#pragma unroll
        for (int i = 0; i < 16; ++i) { v[i] -= mean; s2 += v[i] * v[i]; }
        const float rstd = 1.0f / sqrtf(wave_sum_dpp(s2) * (1.0f / 1024.0f) + LN_EPS);
        float acc[32];
#pragma unroll
        for (int e = 0; e < 32; ++e) acc[e] = 0.f;
#pragma unroll
        for (int i = 0; i < 16; ++i) { const int col = c.lane + 64 * i; const float xv = v[i] * rstd * gv[i] + bvv[i];
            X1[(size_t)m * 1024 + col] = xv; X1B[(size_t)m * 1024 + col] = (bf16)f2bf(xv);
            const LAS float* wr_ = rw + col * RW_PITCH;
#pragma unroll
            for (int q = 0; q < 8; ++q) { const f32x4 w4 = *(const LAS f32x4*)(wr_ + 4 * q); acc[4 * q] += xv * w4[0]; acc[4 * q + 1] += xv * w4[1]; acc[4 * q + 2] += xv * w4[2]; acc[4 * q + 3] += xv * w4[3]; }
            __builtin_amdgcn_sched_barrier(0); }
#pragma unroll
        for (int e = 0; e < 32; ++e) acc[e] = wave_sum_dpp(acc[e]) + rbl[e];
        float tv[4]; int ti[4]; unsigned used = 0u;
#pragma unroll
        for (int k = 0; k < 4; ++k) { float bv = -INFINITY; int bi = 0;
#pragma unroll
            for (int e = 0; e < 32; ++e) { const bool ok = ((used >> e) & 1u) == 0u && acc[e] > bv; bv = ok ? acc[e] : bv; bi = ok ? e : bi; }
            tv[k] = bv; ti[k] = bi; used |= 1u << bi; }
        const float e1 = __expf(tv[1] - tv[0]), e2 = __expf(tv[2] - tv[0]), e3 = __expf(tv[3] - tv[0]); const float inv = 1.0f / (1.0f + e1 + e2 + e3);
        if (c.lane < 4 && (!dry || tv[0] == 12345.678f)) { const int e = c.lane == 0 ? ti[0] : c.lane == 1 ? ti[1] : c.lane == 2 ? ti[2] : ti[3]; const float w = (c.lane == 0 ? 1.0f : c.lane == 1 ? e1 : c.lane == 2 ? e2 : e3) * inv;
            const int pos = __hip_atomic_fetch_add(hist + e, 1, __ATOMIC_RELAXED, __HIP_MEMORY_SCOPE_WORKGROUP);
            TOKE[m * 4 + c.lane] = e | (pos << 8); TOKW[m * 4 + c.lane] = w; }
    }
    __syncthreads();
    if (c.tid < 32 && !dry) { const int base = atomicAdd(ctl + CW_COUNT + c.tid, hist[c.tid]); ctl[CW_WGBASE + c.bid * 32 + c.tid] = base; }
    __syncthreads();
}

__device__ __forceinline__ void phase10(const Params& p, const Ctx& c) {
    unsigned char* ws = p.ws; int* ctl = (int*)(ws + WS_CTL); const int* TOKE = (const int*)(ws + WS_TOKE); const float* TOKW = (const float*)(ws + WS_TOKW);
    int* SLOTOF = (int*)(ws + WS_SLOTOF); float* ROWW = (float*)(ws + WS_ROWW);
    LAS int* pst = (LAS int*)(c.lds + L_HIST + 128);
    if (c.tid == 0) { int acc = 0;
        for (int e = 0; e < 32; ++e) { const int cnt = __hip_atomic_load(ctl + CW_COUNT + e, __ATOMIC_RELAXED, __HIP_MEMORY_SCOPE_AGENT); const int nt = (cnt + 255) >> 8;
            pst[e] = acc * 256;
            if (c.bid == 0) for (int t = 0; t < nt; ++t) ctl[CW_TILE_E + acc + t] = e;
            acc += nt; }
        if (c.bid == 0) ctl[CW_NTILES] = acc; }
    __syncthreads();
    int* ROWTOK = (int*)(ws + WS_ROWTOK);
    for (int i = c.bid * NTHREADS + c.tid; i < MTOK * 4; i += c.G * NTHREADS) { const int m = i >> 2, wg = (m % c.ngw) >> 3;
        const int ew = TOKE[i], e = ew & 255; const int slot = pst[e] + ctl[CW_WGBASE + wg * 32 + e] + (ew >> 8); SLOTOF[i] = slot; ROWW[slot] = TOKW[i]; ROWTOK[slot] = m; }
}

__device__ __forceinline__ void phase14(const Params& p, const Ctx& c) {
    unsigned char* ws = p.ws; const float* __restrict__ X1 = (const float*)(ws + WS_X1); const bf16* __restrict__ YB = (const bf16*)(ws + WS_YBUF); const int* __restrict__ SLOTOF = (const int*)(ws + WS_SLOTOF);
    float* __restrict__ OUT = p.out; f32x4 g2v[4], b2v[4];
#pragma unroll
    for (int j = 0; j < 4; ++j) { g2v[j] = *(const f32x4*)(p.in[3] + 256 * j + 4 * c.lane); b2v[j] = *(const f32x4*)(p.in[4] + 256 * j + 4 * c.lane); }
    for (int m0 = 2 * c.gw; m0 < MTOK; m0 += 2 * c.ngw) {
        f32x4 v[2][4]; u32x2 yv[2][4][4];
#pragma unroll
        for (int u = 0; u < 2; ++u) { const int m = m0 + u; int sl[4];
#pragma unroll
            for (int k = 0; k < 4; ++k) sl[k] = SLOTOF[m * 4 + k];
#pragma unroll
            for (int j = 0; j < 4; ++j) { const int col = 256 * j + 4 * c.lane; v[u][j] = *(const f32x4*)(X1 + (size_t)m * 1024 + col);
#pragma unroll
                for (int k = 0; k < 4; ++k) yv[u][j][k] = *(const u32x2*)(YB + (size_t)sl[k] * 1024 + col); } }
#pragma unroll
        for (int u = 0; u < 2; ++u) { const int m = m0 + u; float s = 0.f;
#pragma unroll
            for (int j = 0; j < 4; ++j) { f32x4 a = v[u][j] * DN_ALPHA; const u32x2 y0 = yv[u][j][0], y1 = yv[u][j][1], y2 = yv[u][j][2], y3 = yv[u][j][3];
                a[0] += ((bflo(y0.x) + bflo(y1.x)) + bflo(y2.x)) + bflo(y3.x); a[1] += ((bfhi(y0.x) + bfhi(y1.x)) + bfhi(y2.x)) + bfhi(y3.x);
                a[2] += ((bflo(y0.y) + bflo(y1.y)) + bflo(y2.y)) + bflo(y3.y); a[3] += ((bfhi(y0.y) + bfhi(y1.y)) + bfhi(y2.y)) + bfhi(y3.y);
                v[u][j] = a; s += (a[0] + a[1]) + (a[2] + a[3]); }
            const float mean = wave_sum_dpp(s) * (1.0f / 1024.0f); float q = 0.f;
#pragma unroll
            for (int j = 0; j < 4; ++j) { v[u][j] = v[u][j] - mean; q += (v[u][j][0] * v[u][j][0] + v[u][j][1] * v[u][j][1]) + (v[u][j][2] * v[u][j][2] + v[u][j][3] * v[u][j][3]); }
            const float rstd = 1.0f / sqrtf(wave_sum_dpp(q) * (1.0f / 1024.0f) + LN_EPS);
#pragma unroll
            for (int j = 0; j < 4; ++j) *(f32x4*)(OUT + (size_t)m * 1024 + 256 * j + 4 * c.lane) = v[u][j] * rstd * g2v[j] + b2v[j]; }
    }
}

#define XB_TMO      128
#define XB_XCNT(j)  (256  + 64 * (j))
#define XB_XSUB(j)  (1280 + 64 * (j))
#define XB_XGEN(j)  (2304 + 64 * (j))
#define XB_TOP      3328
#define XB_TOPGEN   3392
#define XCD_BAR_WORDS 3456
#define XB_SPIN_CAP (1u << 18)

__device__ __forceinline__ unsigned xb_ld(unsigned* p)              { return __hip_atomic_load(p, __ATOMIC_RELAXED, __HIP_MEMORY_SCOPE_AGENT); }
__device__ __forceinline__ unsigned xb_add(unsigned* p, unsigned v) { return __hip_atomic_fetch_add(p, v, __ATOMIC_RELAXED, __HIP_MEMORY_SCOPE_AGENT); }
__device__ __forceinline__ unsigned xb_xcc_id() { return (unsigned)__builtin_amdgcn_s_getreg((3 << 11) | 20) & 0xFu; }
#define XB_SPIN(cond, bar) do { unsigned _sp = 0; while (cond) { __builtin_amdgcn_s_sleep(1); \
    if ((++_sp & 255u) == 0u) { if (xb_ld(&(bar)[XB_TMO])) break; if (_sp > XB_SPIN_CAP) { atomicAdd(&(bar)[XB_TMO], 1u); break; } } } } while (0)

struct XcdBarrier {
    unsigned* bar; unsigned x;
    volatile LAS unsigned* st;
};

__device__ __forceinline__ XcdBarrier xcd_barrier_post(unsigned* bar, volatile LAS unsigned* st) {
    XcdBarrier b; b.bar = bar; b.x = xb_xcc_id(); b.st = st;
    if (threadIdx.x == 0) (void)xb_add(&bar[XB_XCNT(b.x)], 1u);
    return b;
}
__device__ __forceinline__ void xcd_barrier_complete(unsigned* bar, unsigned x, unsigned& nloc, unsigned& nx) {
    const unsigned G = gridDim.x * gridDim.y * gridDim.z;
    unsigned sum, cnt, mine, sp = 0u;
    for (;;) {
        sum = 0u; cnt = 0u; mine = 0u;
#pragma unroll
        for (unsigned j = 0; j < 16; ++j) { const unsigned c = xb_ld(&bar[XB_XCNT(j)]); sum += c; cnt += (c > 0u) ? 1u : 0u; mine = (j == x) ? c : mine; }
        if (sum == G) break;
        __builtin_amdgcn_s_sleep(1);
        if ((++sp & 255u) == 0u) { if (xb_ld(&bar[XB_TMO])) break; if (sp > XB_SPIN_CAP) { atomicAdd(&bar[XB_TMO], 1u); break; } }
    }
    nloc = mine > 0u ? mine : 1u; nx = cnt > 0u ? cnt : 1u;
}

__device__ __forceinline__ void xcd_barrier(const XcdBarrier& b) {
    asm volatile("s_waitcnt vmcnt(0)" ::: "memory");
    __syncthreads();
    if (threadIdx.x == 0) {
        unsigned* bar = b.bar;
        __builtin_amdgcn_s_waitcnt(0);
        unsigned nloc = b.st[0], nx = b.st[1];
        if (nloc == 0u) { xcd_barrier_complete(bar, b.x, nloc, nx); b.st[0] = nloc; b.st[1] = nx; }
        const unsigned old = xb_add(&bar[XB_XSUB(b.x)], 1u);
        const unsigned gen = old / nloc;
        if (old + 1u == (gen + 1u) * nloc) {
            __builtin_amdgcn_fence(__ATOMIC_RELEASE, "agent");
            asm volatile("s_waitcnt vmcnt(0)" ::: "memory");
            const unsigned og = xb_add(&bar[XB_TOP], 1u);
            const unsigned tg = og / nx;
            if (og + 1u == (tg + 1u) * nx) xb_add(&bar[XB_TOPGEN], 1u);
            else XB_SPIN(xb_ld(&bar[XB_TOPGEN]) == tg, bar);
            __builtin_amdgcn_fence(__ATOMIC_ACQUIRE, "agent");
            xb_add(&bar[XB_XGEN(b.x)], 1u);
            asm volatile("s_waitcnt vmcnt(0)" ::: "memory");
        } else {
            XB_SPIN(xb_ld(&bar[XB_XGEN(b.x)]) == gen, bar);
            __builtin_amdgcn_fence(__ATOMIC_ACQUIRE, "agent");
            asm volatile("s_waitcnt vmcnt(0)" ::: "memory");
        }
    }
    __syncthreads();
}


constexpr int NPHASE = 15;
#ifndef MK_SPLIT
#define MK_SPLIT 0
#endif
__global__ void __launch_bounds__(NTHREADS, 2) fwd_megakernel(Params p) {
    extern __shared__ __attribute__((aligned(16))) unsigned char lds_raw[];
    Ctx c; c.lds = (LAS unsigned char*)lds_raw; c.tid = threadIdx.x; c.lane = c.tid & 63; c.wave = __builtin_amdgcn_readfirstlane(c.tid >> 6);
    c.G = gridDim.x; c.bid = blockIdx.x; c.gw = c.bid * NWAVES + c.wave; c.ngw = c.G * NWAVES;
    unsigned char* ws = p.ws;
    const int lo = p.ph_lo, hi = p.ph_hi;
#ifdef ONLY_PHASE
#define IN(k) ((k) == ONLY_PHASE && lo <= (k) && (k) < hi)
#else
#define IN(k) (lo <= (k) && (k) < hi)
#endif
#if MK_SPLIT
#define SEAM(k) do { } while (0)
#else
    cg::grid_group grid = cg::this_grid();
    { volatile LAS unsigned* st = (volatile LAS unsigned*)(c.lds + LDS_BYTES - 16); if (c.tid < 4) st[c.tid] = 0u; }
    __syncthreads();
    const XcdBarrier xbar = xcd_barrier_post((unsigned*)(ws + WS_CTL) + CW_XBAR, (volatile LAS unsigned*)(c.lds + LDS_BYTES - 16));
#define SEAM(k) do { if (IN(k) && IN((k) + 1)) { if ((k) == 0) grid.sync(); else xcd_barrier(xbar); } } while (0)
#endif
#ifndef DBL_PHASE
#define DBL_PHASE -1
#endif
#define PH(k, ...) if (IN(k)) { __VA_ARGS__; if (DBL_PHASE == (k)) { xcd_barrier(xbar); __VA_ARGS__; } }
    PH(0, phase0(p, c))
    SEAM(0);
    PH(1, { pg8::DenseOrder S; S.init(MTOK, 5376, 1024, c.G, c.bid, ws + WS_XB, ws + WS_WIN_T);
        pg8::EpiInProj E{(bf16*)(ws + WS_PRKV), (bf16*)(ws + WS_PLR), (bf16*)(ws + WS_PQ), (bf16*)(ws + WS_PK), (bf16*)(ws + WS_PAV), (bf16*)(ws + WS_PG)};
        pg8::gemm_phase<pg8::EpiInProj, pg8::DenseOrder, true, true>(c.lds, 1024, S, E); })
    SEAM(1);
    if (IN(2)) phase2(p, c);
    SEAM(2);
    PH(3, { kmean_items(p, c); pg8::DenseOrder S; S.init(MTOK, 1536, 256, c.G, c.bid, ws + WS_ALORA, ws + WS_WLORA_T);
        pg8::EpiPlainBf16 E{(bf16*)(ws + WS_LORA), 1536};
        pg8::gemm_phase<pg8::EpiPlainBf16, pg8::DenseOrder, true, true>(c.lds, 256, S, E); })
    SEAM(3);
    if (IN(5)) {
        for (int rep = 0; rep < (DBL_PHASE == 50 ? 2 : 1); ++rep) { for (int item = c.bid; item < 256; item += c.G) scan_item(p, c, item); }
        for (int rep = (DBL_PHASE == 51 ? 0 : 1); rep < 2; ++rep) {
            bf16* Oout = rep == 0 ? (bf16*)(ws + WS_MERGED) : (bf16*)(ws + WS_PQ);
            for (int v = c.bid; v < 256; v += c.G) { const int bh = v >> 2, s = v & 3;
#pragma unroll 1
                for (int i = 0; i < 4; ++i) { const int qb = (i == 0) ? s : (i == 1) ? 7 - s : (i == 2) ? 8 + s : 15 - s; att::unit(p, c, bh >> 3, bh & 7, qb, Oout); } } }
    }
    SEAM(5);
    PH(6, phase6(p, c))
    SEAM(6);
    PH(7, { pg8::DenseOrder S; S.init(MTOK, 1024, 512, c.G, c.bid, ws + WS_YRWKV, ws + WS_WR_T);
        pg8::EpiGateF32 E{(float*)(ws + WS_TMP), (const bf16*)(ws + WS_PG), 0};
        pg8::gemm_phase<pg8::EpiGateF32, pg8::DenseOrder, true, true>(c.lds, 512, S, E); })
    SEAM(7);
    PH(8, { pg8::DenseOrder S; S.init(MTOK, 1024, 512, c.G, c.bid, ws + WS_PQ, ws + WS_WA_T);
        pg8::EpiGateAddBf16 E{(const float*)(ws + WS_TMP), (const bf16*)(ws + WS_PG), 1024, (bf16*)(ws + WS_MERGED)};
        pg8::gemm_phase<pg8::EpiGateAddBf16, pg8::DenseOrder, true, true>(c.lds, 512, S, E); })
    SEAM(8);
    PH(9, { pg8::DenseOrder S; S.init(MTOK, 1024, 1024, c.G, c.bid, ws + WS_MERGED, ws + WS_WO_T);
        pg8::EpiResF32 E{(float*)(ws + WS_XPRE), p.in[0], DN_ALPHA};
        pg8::gemm_phase<pg8::EpiResF32, pg8::DenseOrder, true, true>(c.lds, 1024, S, E); })
    SEAM(9);
    if (IN(10)) { if (DBL_PHASE == 10) { phase9(p, c, true); } phase9(p, c); }
    SEAM(10);
    if (IN(11)) phase10(p, c);
    SEAM(11);
    PH(12, { const int* ctl = (const int*)(ws + WS_CTL);
        pg8::MoeOrder<true> S{(const int*)(ws + WS_ROWTOK), ctl + CW_TILE_E, ctl[CW_NTILES], 8, c.G, c.bid, (const char*)(ws + WS_X1B), (const char*)(ws + WS_W1T), (size_t)256 * 1024 * 2, (size_t)2048 * 1024 * 2};
        pg8::EpiSwiglu E{(bf16*)(ws + WS_ACT), p.in[23]};
        pg8::gemm_phase<pg8::EpiSwiglu, pg8::MoeOrder<true>, true, true>(c.lds, 1024, S, E); })
    SEAM(12);
    PH(13, { const int* ctl = (const int*)(ws + WS_CTL);
        pg8::MoeOrder<false> S{nullptr, ctl + CW_TILE_E, ctl[CW_NTILES], 4, c.G, c.bid, (const char*)(ws + WS_ACT), (const char*)(ws + WS_W2T), (size_t)256 * 1024 * 2, (size_t)1024 * 1024 * 2};
        pg8::EpiMoe2 E{(bf16*)(ws + WS_YBUF), p.in[25], (const float*)(ws + WS_ROWW)};
        pg8::gemm_phase<pg8::EpiMoe2, pg8::MoeOrder<false>, true, true>(c.lds, 1024, S, E); })
    SEAM(13);
    PH(14, phase14(p, c))
#undef PH
#undef IN
#undef SEAM
}

extern "C" void kernel_launch(void* const* d_in, const int* in_sizes, int n_in, void* d_out, int out_size, void* d_ws, size_t ws_size, hipStream_t stream) {
    static int grid = 0;
    if (grid == 0) {
        if (n_in != 26 || in_sizes[0] != MTOK * DMODEL || out_size != MTOK * DMODEL || ws_size < WS_END) {
            fprintf(stderr, "kernel_launch: unexpected shapes / workspace (n_in %d, in0 %d, out %d, ws %zu, need %zu); nothing launched\n", n_in, n_in > 0 ? in_sizes[0] : -1, out_size, ws_size, (size_t)WS_END); grid = -1; return; }
        int dev = 0, cus = 0, per_cu = 0;
        hipGetDevice(&dev); hipDeviceGetAttribute(&cus, hipDeviceAttributeMultiprocessorCount, dev);
        hipFuncSetAttribute((const void*)fwd_megakernel, hipFuncAttributeMaxDynamicSharedMemorySize, LDS_BYTES);
        hipOccupancyMaxActiveBlocksPerMultiprocessor(&per_cu, (const void*)fwd_megakernel, NTHREADS, LDS_BYTES);
        (void)hipGetLastError();
        if (per_cu < 1) { fprintf(stderr, "kernel_launch: occupancy query says %d blocks per CU\n", per_cu); per_cu = 1; }
        grid = cus;
    }
    if (grid < 0) return;
    hipMemsetAsync((char*)d_ws + WS_CTL, 0, CTL_BYTES, stream);
    Params p{};
    for (int i = 0; i < 26; ++i) p.in[i] = (const float*)d_in[i];
    p.out = (float*)d_out; p.ws = (unsigned char*)d_ws;
#if MK_SPLIT
    for (int ph = 0; ph < NPHASE; ++ph) { p.ph_lo = ph; p.ph_hi = ph + 1; hipLaunchKernelGGL(fwd_megakernel, dim3(grid), dim3(NTHREADS), LDS_BYTES, stream, p); }
#else
    p.ph_lo = 0; p.ph_hi = NPHASE;
    void* args[] = {&p};
    hipError_t e = hipLaunchCooperativeKernel((const void*)fwd_megakernel, dim3(grid), dim3(NTHREADS), args, LDS_BYTES, stream);
    if (e != hipSuccess) fprintf(stderr, "cooperative launch failed: %s (grid %d)\n", hipGetErrorString(e), grid);
#endif
}
```

```cpp
#include <hip/hip_runtime.h>
#include <hip/hip_cooperative_groups.h>
#include <cstdio>
#include <cstdint>
namespace cg = cooperative_groups;

namespace pg8 {
#define PG8_LAS __attribute__((address_space(3)))
typedef unsigned short bf16_t;
typedef short bf16x8 __attribute__((ext_vector_type(8)));
typedef float f32x4 __attribute__((ext_vector_type(4)));
typedef float f32x2 __attribute__((ext_vector_type(2)));
typedef unsigned u32x4 __attribute__((ext_vector_type(4)));
typedef unsigned u32x2 __attribute__((ext_vector_type(2)));
typedef int i32x4 __attribute__((ext_vector_type(4)));
typedef int i32x8 __attribute__((ext_vector_type(8)));
constexpr int BM = 256, BK = 64, HALF = 128, HTB = HALF * BK * 2  , STAGE_BYTES = 8 * HTB, NXCD = 8, WGM = 8;

__host__ __device__ __forceinline__ int lds_byte(int r, int c) { const int st = (r >> 4) * 2 + (c >> 5), rr = r & 15, cc = c & 31, ob = rr * 64 + cc * 2; return st * 1024 + (ob ^ (((ob >> 9) & 1) << 5)); }
__host__ __device__ __forceinline__ void stage_rc(int b, int& R, int& C) { const int st = b / 1024, sb = b % 1024, swz = sb ^ (((sb >> 9) & 1) << 5); R = (st >> 1) * 16 + swz / 64; C = (st & 1) * 32 + (swz % 64) / 2; }
__host__ __device__ __forceinline__ int perm32(int rho) { const int n = rho >> 4, i = rho & 15; return 8 * (i >> 2) + 4 * n + (i & 3); }

struct Unit { int pm, pn, aux; const char* A; const char* B; };

struct DenseOrder {
    static constexpr bool GATHER = false; const int* rowmap;
    int nM, nN, nwg, G, c; const char* A; const char* B; size_t tstep;
    __device__ __forceinline__ void init(int M, int N, int K, int G_, int c_, const void* A_, const void* B_) { nM = M / BM; nN = N / BM; nwg = nM * nN; G = G_; c = c_; A = (const char*)A_; B = (const char*)B_; tstep = (size_t)BM * K * 2; }
    __device__ __forceinline__ bool next(int i, Unit& u) const {
        const long L = (long)i * G + c; if (L >= nwg) return false;
        int wgid = (int)L; { const int q = nwg / NXCD, r = nwg % NXCD, xcd = wgid % NXCD, off = wgid / NXCD; wgid = (xcd < r ? xcd * (q + 1) : r * (q + 1) + (xcd - r) * q) + off; }
        const int nig = WGM * nN, gid = wgid / nig, fm = gid * WGM, gsz = (nM - fm) < WGM ? (nM - fm) : WGM;
        u.pm = fm + ((wgid % nig) % gsz); u.pn = (wgid % nig) / gsz; u.aux = 0;
        u.A = A + (size_t)u.pm * tstep; u.B = B + (size_t)u.pn * tstep; return true;
    }
    __device__ __forceinline__ void a_ready(const Unit&) const {}
    __device__ __forceinline__ void done(const Unit&) const {}
};
template <bool GATHER_> struct MoeOrder {
    static constexpr bool GATHER = GATHER_; const int* rowmap;
    const int* tile_e; int ntiles, npn, G, c; const char* A; const char* B; size_t tstep, estride;
    __device__ __forceinline__ bool next(int i, Unit& u) const {
        const long L = (long)i * G + c; if (L >= (long)ntiles * npn) return false;
        const int tile = (int)(L / npn), pn = (int)(L % npn); const int e = tile_e[tile];
        u.pm = tile; u.pn = pn; u.aux = e; u.A = GATHER_ ? A : A + (size_t)tile * tstep; u.B = B + (size_t)e * estride + (size_t)pn * tstep; return true;
    }
    __device__ __forceinline__ void a_ready(const Unit&) const {}
    __device__ __forceinline__ void done(const Unit&) const {}
};

__device__ __forceinline__ unsigned cvt_pk_bf16(float lo, float hi) { unsigned r; asm volatile("v_cvt_pk_bf16_f32 %0, %1, %2" : "=v"(r) : "v"(lo), "v"(hi)); return r; }
__device__ __forceinline__ float bf_lo(unsigned w) { return __builtin_bit_cast(float, w << 16); }
__device__ __forceinline__ float bf_hi(unsigned w) { return __builtin_bit_cast(float, w & 0xffff0000u); }
__device__ __forceinline__ float sigm(float x) { return 1.0f / (1.0f + __expf(-x)); }

__device__ __forceinline__ void st8(bf16_t* p, f32x4 v0, f32x4 v1) { u32x4 w; w.x = cvt_pk_bf16(v0[0], v0[1]); w.y = cvt_pk_bf16(v0[2], v0[3]); w.z = cvt_pk_bf16(v1[0], v1[1]); w.w = cvt_pk_bf16(v1[2], v1[3]); *(u32x4*)p = w; }

struct EpiPlainBf16 {
    static constexpr bool PERM = true, AFTER_DRAIN = false;
    bf16_t* O; int ldc;
    __device__ __forceinline__ void operator()(const f32x4 (&acc)[2][2][4][2], const Unit& u, int wr, int wc, int fr, int fq) const {
        const int row0 = u.pm * BM + wr * 64 + fr, col0 = u.pn * BM + wc * 32 + 8 * fq;
#pragma unroll
        for (int ai = 0; ai < 2; ++ai)
#pragma unroll
            for (int m = 0; m < 4; ++m) { bf16_t* rowp = O + (size_t)(row0 + ai * HALF + m * 16) * ldc + col0;
#pragma unroll
                for (int bj = 0; bj < 2; ++bj) st8(rowp + bj * HALF, acc[ai][bj][m][0], acc[ai][bj][m][1]); }
    }
};
struct EpiInProj {
    static constexpr bool PERM = true, AFTER_DRAIN = false;
    bf16_t *rkv, *lr, *q, *k, *v, *g;
    __device__ __forceinline__ void operator()(const f32x4 (&acc)[2][2][4][2], const Unit& u, int wr, int wc, int fr, int fq) const {
        const int pn = u.pn; bf16_t* base; int ldc, colt;
        if (pn < 6) { base = rkv; ldc = 1536; colt = pn * 256; } else if (pn == 6) { base = lr; ldc = 256; colt = 0; }
        else if (pn < 9) { base = q; ldc = 512; colt = (pn - 7) * 256; } else if (pn < 11) { base = k; ldc = 512; colt = (pn - 9) * 256; }
        else if (pn < 13) { base = v; ldc = 512; colt = (pn - 11) * 256; } else { base = g; ldc = 2048; colt = (pn - 13) * 256; }
        const int row0 = u.pm * BM + wr * 64 + fr, col0 = colt + wc * 32 + 8 * fq;
#pragma unroll
        for (int ai = 0; ai < 2; ++ai)
#pragma unroll
            for (int m = 0; m < 4; ++m) { bf16_t* rowp = base + (size_t)(row0 + ai * HALF + m * 16) * ldc + col0;
#pragma unroll
                for (int bj = 0; bj < 2; ++bj) st8(rowp + bj * HALF, acc[ai][bj][m][0], acc[ai][bj][m][1]); }
    }
};
struct EpiGateF32 {
    static constexpr bool PERM = true, AFTER_DRAIN = false;
    float* T; const bf16_t* G; int goff;
    __device__ __forceinline__ void operator()(const f32x4 (&acc)[2][2][4][2], const Unit& u, int wr, int wc, int fr, int fq) const {
        const int row0 = u.pm * BM + wr * 64 + fr, col0 = u.pn * BM + wc * 32 + 8 * fq;
#pragma unroll
        for (int ai = 0; ai < 2; ++ai)
#pragma unroll
            for (int m = 0; m < 4; ++m) { const size_t row = (size_t)(row0 + ai * HALF + m * 16);
#pragma unroll
                for (int bj = 0; bj < 2; ++bj) { const int col = col0 + bj * HALF; const u32x4 gw = *(const u32x4*)(G + row * 2048 + goff + col);
                    f32x4 a = acc[ai][bj][m][0], b = acc[ai][bj][m][1];
                    a[0] *= sigm(bf_lo(gw.x)); a[1] *= sigm(bf_hi(gw.x)); a[2] *= sigm(bf_lo(gw.y)); a[3] *= sigm(bf_hi(gw.y));
                    b[0] *= sigm(bf_lo(gw.z)); b[1] *= sigm(bf_hi(gw.z)); b[2] *= sigm(bf_lo(gw.w)); b[3] *= sigm(bf_hi(gw.w));
                    *(f32x4*)(T + row * 1024 + col) = a; *(f32x4*)(T + row * 1024 + col + 4) = b; } }
    }
};
struct EpiGateAddBf16 {
    static constexpr bool PERM = true, AFTER_DRAIN = false;
    const float* T; const bf16_t* G; int goff; bf16_t* O;
    __device__ __forceinline__ void operator()(const f32x4 (&acc)[2][2][4][2], const Unit& u, int wr, int wc, int fr, int fq) const {
        const int row0 = u.pm * BM + wr * 64 + fr, col0 = u.pn * BM + wc * 32 + 8 * fq;
#pragma unroll
        for (int ai = 0; ai < 2; ++ai)
#pragma unroll
            for (int m = 0; m < 4; ++m) { const size_t row = (size_t)(row0 + ai * HALF + m * 16);
#pragma unroll
                for (int bj = 0; bj < 2; ++bj) { const int col = col0 + bj * HALF; const u32x4 gw = *(const u32x4*)(G + row * 2048 + goff + col);
                    f32x4 a = acc[ai][bj][m][0], b = acc[ai][bj][m][1]; const f32x4 ta = *(const f32x4*)(T + row * 1024 + col), tb = *(const f32x4*)(T + row * 1024 + col + 4);
                    a[0] = ta[0] + a[0] * sigm(bf_lo(gw.x)); a[1] = ta[1] + a[1] * sigm(bf_hi(gw.x)); a[2] = ta[2] + a[2] * sigm(bf_lo(gw.y)); a[3] = ta[3] + a[3] * sigm(bf_hi(gw.y));
                    b[0] = tb[0] + b[0] * sigm(bf_lo(gw.z)); b[1] = tb[1] + b[1] * sigm(bf_hi(gw.z)); b[2] = tb[2] + b[2] * sigm(bf_lo(gw.w)); b[3] = tb[3] + b[3] * sigm(bf_hi(gw.w));
                    st8(O + row * 1024 + col, a, b); } }
    }
};
struct EpiResF32 {
    static constexpr bool PERM = false, AFTER_DRAIN = false;
    float* C; const float* X; float alpha;
    __device__ __forceinline__ void operator()(const f32x4 (&acc)[2][2][4][2], const Unit& u, int wr, int wc, int fr, int fq) const {
        const int row0 = u.pm * BM + wr * 64 + fr, col0 = u.pn * BM + wc * 32 + 4 * fq;
#pragma unroll
        for (int ai = 0; ai < 2; ++ai)
#pragma unroll
            for (int m = 0; m < 4; ++m) { const size_t off = (size_t)(row0 + ai * HALF + m * 16) * 1024 + col0;
#pragma unroll
                for (int bj = 0; bj < 2; ++bj)
#pragma unroll
                    for (int n = 0; n < 2; ++n) { const f32x4 xv = *(const f32x4*)(X + off + bj * HALF + n * 16); *(f32x4*)(C + off + bj * HALF + n * 16) = acc[ai][bj][m][n] + xv * alpha; } }
    }
};
__device__ __forceinline__ unsigned pk4_fp8(float a, float b, float c, float d) { int w = 0; w = __builtin_amdgcn_cvt_pk_fp8_f32(a, b, w, false); w = __builtin_amdgcn_cvt_pk_fp8_f32(c, d, w, true); return (unsigned)w; }
struct EpiSwiglu {
    static constexpr bool PERM = true, AFTER_DRAIN = false;
    unsigned char* O; const float* bin; float sc;
    __device__ __forceinline__ void operator()(const f32x4 (&acc)[2][2][4][2], const Unit& u, int wr, int wc, int fr, int fq) const {
        const int row0 = u.pm * BM + wr * 64 + fr, c0 = u.pn * HALF + wc * 32 + 8 * fq; const float* bb = bin + (size_t)u.aux * 2048 + c0;
        const f32x4 bg0 = *(const f32x4*)(bb), bg1 = *(const f32x4*)(bb + 4), bl0 = *(const f32x4*)(bb + 1024), bl1 = *(const f32x4*)(bb + 1028);
#pragma unroll
        for (int ai = 0; ai < 2; ++ai)
#pragma unroll
            for (int m = 0; m < 4; ++m) { const size_t row = (size_t)(row0 + ai * HALF + m * 16);
                f32x4 o0, o1; const f32x4 g0 = acc[ai][0][m][0] * sc + bg0, g1 = acc[ai][0][m][1] * sc + bg1, l0 = acc[ai][1][m][0] * sc + bl0, l1 = acc[ai][1][m][1] * sc + bl1;
#pragma unroll
                for (int j = 0; j < 4; ++j) { const float ga = fminf(g0[j], 7.0f), la = fminf(fmaxf(l0[j], -7.0f), 7.0f); o0[j] = ga * sigm(1.702f * ga) * (la + 1.0f);
                                              const float gb = fminf(g1[j], 7.0f), lb = fminf(fmaxf(l1[j], -7.0f), 7.0f); o1[j] = gb * sigm(1.702f * gb) * (lb + 1.0f); }
                u32x2 w; w.x = pk4_fp8(o0[0], o0[1], o0[2], o0[3]); w.y = pk4_fp8(o1[0], o1[1], o1[2], o1[3]); *(u32x2*)(O + row * 1024 + c0) = w; }
    }
};
struct EpiMoe2 {
    static constexpr bool PERM = true, AFTER_DRAIN = false;
    bf16_t* O; const float* bout; const float* roww; float sc;
    __device__ __forceinline__ void operator()(const f32x4 (&acc)[2][2][4][2], const Unit& u, int wr, int wc, int fr, int fq) const {
        const int row0 = u.pm * BM + wr * 64 + fr, col0 = u.pn * BM + wc * 32 + 8 * fq; const float* bb = bout + (size_t)u.aux * 1024 + col0;
        f32x4 bv[2][2];
#pragma unroll
        for (int bj = 0; bj < 2; ++bj) { bv[bj][0] = *(const f32x4*)(bb + bj * HALF); bv[bj][1] = *(const f32x4*)(bb + bj * HALF + 4); }
#pragma unroll
        for (int ai = 0; ai < 2; ++ai)
#pragma unroll
            for (int m = 0; m < 4; ++m) { const size_t row = (size_t)(row0 + ai * HALF + m * 16); const float w = roww[row];
#pragma unroll
                for (int bj = 0; bj < 2; ++bj) st8(O + row * 1024 + col0 + bj * HALF, (acc[ai][bj][m][0] * sc + bv[bj][0]) * w, (acc[ai][bj][m][1] * sc + bv[bj][1]) * w); }
    }
};

template <class Epi, class Sched, bool ALIGN_EPI = false, bool SP2 = false, int ESZ = 2  >
__device__ __forceinline__ void gemm_phase(PG8_LAS unsigned char* lds, const int K, const Sched& S, const Epi& E) {
    const int tid = threadIdx.x, wid = __builtin_amdgcn_readfirstlane(tid >> 6), lane = tid & 63, wr = wid >> 2, wc = wid & 3, fr = lane & 15, fq = lane >> 4;
    const int nt = K * ESZ / (BK * 2);
    unsigned vA0[2], vA1[2], nvA0[2], nvA1[2], voffB[2];
#pragma unroll
    for (int i = 0; i < 2; ++i) { int R, C; stage_rc(tid * 16 + i * 8192, R, C); const int Rb = Epi::PERM ? ((R & ~31) + perm32(R & 31)) : R;
        vA0[i] = (unsigned)(R * K * ESZ + C * 2); vA1[i] = 0u; nvA0[i] = 0u; nvA1[i] = 0u; voffB[i] = (unsigned)(Rb * K * ESZ + C * 2); }
    const size_t kstep = (size_t)(BK * 2);
    const size_t hstep = (size_t)HALF * K * ESZ;
    const unsigned ldsw = (unsigned)wid * 1024u;
    const int ac0 = ESZ == 2 ? fq * 8 : (fq >> 1) * 32 + (fq & 1) * 16, ac1 = ESZ == 2 ? 32 + fq * 8 : ac0 + 8;
    const int aoffk[2] = {lds_byte(wr * 64 + fr, ac0), lds_byte(wr * 64 + fr, ac1)}, boffk[2] = {lds_byte(wc * 32 + fr, ac0), lds_byte(wc * 32 + fr, ac1)};
#define PG8_SA(b, h) (((b) * 2 + (h)) * HTB)
#define PG8_SB(b, h) ((4 + (b) * 2 + (h)) * HTB)
#define PG8_STAGE(bufoff, gbase, voff) do { _Pragma("unroll") for (int _i = 0; _i < 2; ++_i) \
        __builtin_amdgcn_global_load_lds((const unsigned*)((const char*)(gbase) + (voff)[_i]), (PG8_LAS unsigned*)(lds + (bufoff) + ldsw + _i * 8192), 16, 0, 0); } while (0)
#define PG8_STAGE_A(bufoff, gbase, hf, nx) do { if constexpr (!Sched::GATHER) { PG8_STAGE(bufoff, (gbase) + (hf) * hstep, vA0); } \
        else { if (hf) { PG8_STAGE(bufoff, gbase, vA1); } else { PG8_STAGE(bufoff, gbase, vA0); } } } while (0)
#define PG8_STAGE_AN(bufoff, gbase, hf) do { if constexpr (!Sched::GATHER) { PG8_STAGE(bufoff, (gbase) + (hf) * hstep, vA0); } \
        else { if (hf) { PG8_STAGE(bufoff, gbase, wA1); } else { PG8_STAGE(bufoff, gbase, wA0); } } } while (0)
#define PG8_LDA(dst, b, h) do { _Pragma("unroll") for (int m = 0; m < 4; ++m) { if constexpr (ESZ == 2) { _Pragma("unroll") for (int k = 0; k < 2; ++k) dst[m][k] = *(const PG8_LAS bf16x8*)(lds + PG8_SA(b, h) + aoffk[k] + m * 2048); } \
        else { const i32x4 lo_ = *(const PG8_LAS i32x4*)(lds + PG8_SA(b, h) + aoffk[0] + m * 2048), hi_ = *(const PG8_LAS i32x4*)(lds + PG8_SA(b, h) + aoffk[1] + m * 2048); \
               dst##8[m] = (i32x8){lo_[0], lo_[1], lo_[2], lo_[3], hi_[0], hi_[1], hi_[2], hi_[3]}; } } } while (0)
#define PG8_LDB(dst, b, h) do { _Pragma("unroll") for (int n = 0; n < 2; ++n) { if constexpr (ESZ == 2) { _Pragma("unroll") for (int k = 0; k < 2; ++k) dst[n][k] = *(const PG8_LAS bf16x8*)(lds + PG8_SB(b, h) + boffk[k] + n * 2048); } \
        else { const i32x4 lo_ = *(const PG8_LAS i32x4*)(lds + PG8_SB(b, h) + boffk[0] + n * 2048), hi_ = *(const PG8_LAS i32x4*)(lds + PG8_SB(b, h) + boffk[1] + n * 2048); \
               dst##8[n] = (i32x8){lo_[0], lo_[1], lo_[2], lo_[3], hi_[0], hi_[1], hi_[2], hi_[3]}; } } } while (0)
#define PG8_MMA(ai, bj, At, Bt) do { __builtin_amdgcn_s_setprio(1); _Pragma("unroll") for (int m = 0; m < 4; ++m) _Pragma("unroll") for (int n = 0; n < 2; ++n) { \
        if constexpr (ESZ == 2) { _Pragma("unroll") for (int k = 0; k < 2; ++k) acc[ai][bj][m][n] = __builtin_amdgcn_mfma_f32_16x16x32_bf16(Bt[n][k], At[m][k], acc[ai][bj][m][n], 0, 0, 0); } \
        else { asm volatile("v_mfma_scale_f32_16x16x128_f8f6f4 %0, %1, %2, %0, %3, %3 op_sel_hi:[0,0,0]" : "+v"(acc[ai][bj][m][n]) : "v"(Bt##8[n]), "v"(At##8[m]), "v"(scale1)); } } \
        __builtin_amdgcn_s_setprio(0); } while (0)
#define PG8_WAIT_V(n) asm volatile("s_waitcnt vmcnt(" #n ")" ::: "memory")
#define PG8_WAIT_L(n) asm volatile("s_waitcnt lgkmcnt(" #n ")" ::: "memory")
#define PG8_BAR __builtin_amdgcn_s_barrier()
#define PG8_SCHED __builtin_amdgcn_sched_barrier(0)
    Unit cur, nxt; int ui = 0;
    if (!S.next(0, cur)) return;
    if constexpr (Sched::GATHER) {
#pragma unroll
        for (int i = 0; i < 2; ++i) { int R, C; stage_rc(tid * 16 + i * 8192, R, C); vA0[i] = (unsigned)S.rowmap[cur.pm * BM + R] * (unsigned)(K * ESZ) + (unsigned)C * 2u; vA1[i] = (unsigned)S.rowmap[cur.pm * BM + HALF + R] * (unsigned)(K * ESZ) + (unsigned)C * 2u; nvA0[i] = vA0[i]; nvA1[i] = vA1[i]; }
    }
    f32x4 acc[2][2][4][2];
#pragma unroll
    for (int a = 0; a < 2; ++a)
#pragma unroll
        for (int b = 0; b < 2; ++b)
#pragma unroll
            for (int m = 0; m < 4; ++m)
#pragma unroll
                for (int n = 0; n < 2; ++n) acc[a][b][m][n] = (f32x4){0.f, 0.f, 0.f, 0.f};
    const int scale1 = 0x7F7F7F7F;
    bf16x8 At[4][2], B0[2][2], B1[2][2]; i32x8 At8[4], B08[2], B18[2];
    const char* cA = cur.A; const char* cB = cur.B;
    S.a_ready(cur);
    if constexpr (SP2) {
        PG8_STAGE(PG8_SB(0, 0), cB, voffB); PG8_STAGE(PG8_SB(0, 1), cB + hstep, voffB); PG8_STAGE_A(PG8_SA(0, 0), cA, 0, 0); PG8_STAGE_A(PG8_SA(0, 1), cA, 1, 0);
        if (wr == 1) PG8_BAR;
        PG8_WAIT_V(2); PG8_BAR;
        PG8_STAGE(PG8_SB(1, 0), cB + kstep, voffB); PG8_STAGE_A(PG8_SA(1, 0), cA + kstep, 0, 0); PG8_STAGE(PG8_SB(1, 1), cB + hstep + kstep, voffB);
        PG8_WAIT_V(6); PG8_BAR;
    } else {
        PG8_STAGE(PG8_SB(0, 0), cB, voffB); PG8_STAGE_A(PG8_SA(0, 0), cA, 0, 0); PG8_STAGE(PG8_SB(0, 1), cB + hstep, voffB); PG8_STAGE_A(PG8_SA(0, 1), cA, 1, 0);
        if (wr == 1) PG8_BAR;
        PG8_WAIT_V(4); PG8_BAR;
        PG8_STAGE(PG8_SB(1, 0), cB + kstep, voffB); PG8_STAGE_A(PG8_SA(1, 0), cA + kstep, 0, 0); PG8_STAGE(PG8_SB(1, 1), cB + hstep + kstep, voffB);
        PG8_WAIT_V(6); PG8_BAR;
    }
    for (;;) {
        const bool has_next = S.next(ui + 1, nxt);
        const char* nA = has_next ? nxt.A : cA; const char* nB = has_next ? nxt.B : cB;
        if constexpr (Sched::GATHER) { if (has_next) {
#pragma unroll
            for (int i = 0; i < 2; ++i) { int R, C; stage_rc(tid * 16 + i * 8192, R, C); nvA0[i] = (unsigned)S.rowmap[nxt.pm * BM + R] * (unsigned)(K * ESZ) + (unsigned)C * 2u; nvA1[i] = (unsigned)S.rowmap[nxt.pm * BM + HALF + R] * (unsigned)(K * ESZ) + (unsigned)C * 2u; } } }
#pragma unroll 1
        for (int t = 0; t < nt; t += 2) {
            const bool last = (t == nt - 2);
            const char* a1 = cA + (size_t)(t + 1) * kstep;
            const char* a2 = last ? nA : cA + (size_t)(t + 2) * kstep; const char* b2 = last ? nB : cB + (size_t)(t + 2) * kstep;
            const char* a3 = a2 + kstep; const char* b3 = b2 + kstep;
            if (last && has_next) S.a_ready(nxt);
            unsigned wA0[2] = {vA0[0], vA0[1]}, wA1[2] = {vA1[0], vA1[1]}; (void)wA0; (void)wA1;
            if constexpr (Sched::GATHER) { if (last) { asm volatile("" : "+v"(nvA0[0]), "+v"(nvA0[1]), "+v"(nvA1[0]), "+v"(nvA1[1])); wA0[0] = nvA0[0]; wA0[1] = nvA0[1]; wA1[0] = nvA1[0]; wA1[1] = nvA1[1]; } }
            if constexpr (SP2) {
            PG8_LDB(B0, 0, 0); PG8_LDB(B1, 0, 1); PG8_SCHED; PG8_LDA(At, 0, 0); PG8_STAGE_A(PG8_SA(1, 1), a1, 1, 0);
            PG8_WAIT_V(8); PG8_WAIT_L(0); PG8_BAR; PG8_MMA(0, 0, At, B0); PG8_MMA(0, 1, At, B1); PG8_BAR; PG8_SCHED;
            PG8_LDA(At, 0, 1); PG8_STAGE(PG8_SB(0, 0), b2, voffB); PG8_STAGE(PG8_SB(0, 1), b2 + hstep, voffB); PG8_STAGE_AN(PG8_SA(0, 0), a2, 0);
            PG8_WAIT_V(8); PG8_WAIT_L(0); PG8_BAR; PG8_MMA(1, 0, At, B0); PG8_MMA(1, 1, At, B1); PG8_BAR; PG8_SCHED;
            PG8_LDB(B0, 1, 0); PG8_LDB(B1, 1, 1); PG8_SCHED; PG8_LDA(At, 1, 0); PG8_STAGE_AN(PG8_SA(0, 1), a2, 1);
            PG8_WAIT_V(8); PG8_WAIT_L(0); PG8_BAR; PG8_MMA(0, 0, At, B0); PG8_MMA(0, 1, At, B1); PG8_BAR; PG8_SCHED;
            PG8_LDA(At, 1, 1); PG8_STAGE(PG8_SB(1, 0), b3, voffB); PG8_STAGE(PG8_SB(1, 1), b3 + hstep, voffB); PG8_STAGE_AN(PG8_SA(1, 0), a3, 0);
            PG8_WAIT_V(8); PG8_WAIT_L(0); PG8_BAR; PG8_MMA(1, 0, At, B0); PG8_MMA(1, 1, At, B1); PG8_BAR; PG8_SCHED;
            } else {
            PG8_LDB(B0, 0, 0); PG8_SCHED; PG8_LDA(At, 0, 0); PG8_STAGE_A(PG8_SA(1, 1), a1, 1, 0);
            PG8_WAIT_L(8); PG8_BAR; PG8_WAIT_L(0); PG8_MMA(0, 0, At, B0); PG8_BAR; PG8_SCHED;
            PG8_LDB(B1, 0, 1); PG8_STAGE(PG8_SB(0, 0), b2, voffB);
            PG8_BAR; PG8_WAIT_L(0); PG8_MMA(0, 1, At, B1); PG8_BAR;
            PG8_LDA(At, 0, 1); PG8_STAGE_AN(PG8_SA(0, 0), a2, 0);
            PG8_BAR; PG8_WAIT_L(0); PG8_MMA(1, 0, At, B0); PG8_BAR; PG8_SCHED;
            PG8_STAGE(PG8_SB(0, 1), b2 + hstep, voffB);
            PG8_WAIT_V(6); PG8_BAR; PG8_MMA(1, 1, At, B1); PG8_BAR;
            PG8_LDB(B0, 1, 0); PG8_SCHED; PG8_LDA(At, 1, 0); PG8_STAGE_AN(PG8_SA(0, 1), a2, 1);
            PG8_WAIT_L(8); PG8_BAR; PG8_WAIT_L(0); PG8_MMA(0, 0, At, B0); PG8_BAR; PG8_SCHED;
            PG8_LDB(B1, 1, 1); PG8_STAGE(PG8_SB(1, 0), b3, voffB);
            PG8_BAR; PG8_WAIT_L(0); PG8_MMA(0, 1, At, B1); PG8_BAR;
            PG8_LDA(At, 1, 1); PG8_STAGE_AN(PG8_SA(1, 0), a3, 0);
            PG8_BAR; PG8_WAIT_L(0); PG8_MMA(1, 0, At, B0); PG8_BAR; PG8_SCHED;
            PG8_STAGE(PG8_SB(1, 1), b3 + hstep, voffB);
            PG8_WAIT_V(6); PG8_BAR; PG8_MMA(1, 1, At, B1); PG8_BAR;
            }
        }
        if constexpr (ALIGN_EPI) { if (wr == 0) PG8_BAR; }
        if constexpr (ESZ == 1) asm volatile("s_nop 15\n\ts_nop 15" ::: "memory");
        if constexpr (!Epi::AFTER_DRAIN) { E(acc, cur, wr, wc, fr, fq); S.done(cur); }
        if (!has_next) break;
#pragma unroll
        for (int a = 0; a < 2; ++a)
#pragma unroll
            for (int b = 0; b < 2; ++b)
#pragma unroll
                for (int m = 0; m < 4; ++m)
#pragma unroll
                    for (int n = 0; n < 2; ++n) acc[a][b][m][n] = (f32x4){0.f, 0.f, 0.f, 0.f};
        cur = nxt; cA = nA; cB = nB; ++ui;
        if constexpr (Sched::GATHER) { vA0[0] = nvA0[0]; vA0[1] = nvA0[1]; vA1[0] = nvA1[0]; vA1[1] = nvA1[1]; }
        if constexpr (ALIGN_EPI) { if (wr == 1) PG8_BAR; }
    }
    PG8_WAIT_V(0);
    if constexpr (!ALIGN_EPI) { if (wr == 0) PG8_BAR; }
    PG8_BAR;
    if constexpr (Epi::AFTER_DRAIN) { E.fused(acc, cur, wr, wc, fr, fq, lds, wid, lane); S.done(cur); }
#undef PG8_SA
#undef PG8_SB
#undef PG8_STAGE
#undef PG8_STAGE_A
#undef PG8_STAGE_AN
#undef PG8_LDA
#undef PG8_LDB
#undef PG8_MMA
#undef PG8_WAIT_V
#undef PG8_WAIT_L
#undef PG8_BAR
#undef PG8_SCHED
}
}


#define LAS __attribute__((address_space(3)))
typedef unsigned short bf16;
typedef float f32x4 __attribute__((ext_vector_type(4)));
typedef float f32x2 __attribute__((ext_vector_type(2)));
typedef float f32x16 __attribute__((ext_vector_type(16)));
typedef unsigned u32x4 __attribute__((ext_vector_type(4)));
typedef unsigned u32x2 __attribute__((ext_vector_type(2)));
typedef short bf16x8 __attribute__((ext_vector_type(8)));
typedef short s16x4 __attribute__((ext_vector_type(4)));

constexpr int NB = 8, SEQ = 4096, DMODEL = 1024, MTOK = NB * SEQ, NHEAD = 8, HDIM = 64, BRD = 512;
constexpr int NEXP = 32, TOPK = 4, MAXTILES = 544, MAXSLOTS = MAXTILES * 256;
constexpr float DN_ALPHA = 1.189207115002721f, LN_EPS = 1e-5f, GN_EPS = 64e-5f;
constexpr int NWAVES = 8, NTHREADS = 512;
constexpr float W1_SCALE = 32.0f, W2_SCALE = 64.0f;
constexpr int LDS_BYTES = 155648;

constexpr size_t MiB = 1u << 20;
constexpr size_t WS_CTL = 0, CTL_BYTES = 128 * 1024;
constexpr size_t WS_WIN_T = 1 * MiB, WS_WLORA_T = 12 * MiB, WS_WR_T = 13 * MiB, WS_WA_T = 14 * MiB, WS_WO_T = 15 * MiB, WS_W1T = 17 * MiB, WS_W2T = 145 * MiB;
constexpr size_t WS_KMEAN = 209 * MiB, WS_ROPE = 209 * MiB + 512 * 1024, WS_TOKE = 210 * MiB, WS_TOKW = 210 * MiB + 512 * 1024, WS_SLOTOF = 211 * MiB, WS_ROWTOK = 212 * MiB, WS_ROWW = 213 * MiB;
constexpr size_t WS_D = 216 * MiB;
constexpr size_t WS_PG = WS_D, WS_PQ = WS_D + 128 * MiB, WS_PK = WS_D + 160 * MiB, WS_PAV = WS_D + 192 * MiB, WS_PRKV = WS_D + 224 * MiB, WS_PLR = WS_D + 320 * MiB;
constexpr size_t WS_LORA = WS_D + 320 * MiB, WS_ALORA = WS_D + 416 * MiB, WS_XB = WS_D + 432 * MiB, WS_BONUS = WS_D + 416 * MiB;
constexpr size_t WS_YRAW = WS_D + 480 * MiB, WS_YRWKV = WS_D + 288 * MiB, WS_TMP = WS_D + 416 * MiB, WS_MERGED = WS_D + 544 * MiB, WS_XPRE = WS_D + 608 * MiB;
constexpr size_t WS_X1 = WS_D, WS_X1B = WS_D + 128 * MiB, WS_XPERM = WS_D + 192 * MiB, WS_ACT = WS_D + 464 * MiB, WS_YBUF = WS_D + 192 * MiB;
constexpr size_t WS_END = WS_D + 800 * MiB;
constexpr int CW_COUNT = 0, CW_NTILES = 64, CW_TILE_E = 128, CW_WGBASE = 1024, CW_XBAR = 16384;

struct Params { const float* in[26]; float* out; unsigned char* ws; int ph_lo, ph_hi; };
struct Ctx { LAS unsigned char* lds; int tid, lane, wave, gw, ngw, G, bid; };

__device__ __forceinline__ unsigned f2bf(float f) { unsigned u = __builtin_bit_cast(unsigned, f); return (u + 0x7fffu + ((u >> 16) & 1u)) >> 16; }
__device__ __forceinline__ unsigned pk2(float lo, float hi) { return f2bf(lo) | (f2bf(hi) << 16); }
__device__ __forceinline__ float bf2f(bf16 v) { return __builtin_bit_cast(float, (unsigned)v << 16); }
__device__ __forceinline__ float bflo(unsigned w) { return __builtin_bit_cast(float, w << 16); }
__device__ __forceinline__ float bfhi(unsigned w) { return __builtin_bit_cast(float, w & 0xffff0000u); }
__device__ __forceinline__ float wave_sum(float v) {
#pragma unroll
    for (int o = 1; o < 64; o <<= 1) v += __shfl_xor(v, o);
    return v;
}
__device__ __forceinline__ float sigmf(float x) { return 1.0f / (1.0f + __expf(-x)); }

__device__ __forceinline__ void transpose_item(const float* W, int K, int N, bf16* WT, int k0, int n0, int dst_row0, LAS float* scr, int lane) {
#pragma unroll 8
    for (int i = 0; i < 32; ++i) { const int kk = 2 * i + (lane >> 5); scr[kk * 33 + (lane & 31)] = W[(size_t)(k0 + kk) * N + n0 + (lane & 31)]; }
    asm volatile("s_waitcnt lgkmcnt(0)" ::: "memory");
    const int c = lane & 7;
#pragma unroll
    for (int j = 0; j < 4; ++j) { const int n = (lane >> 3) + 8 * j; const LAS float* s = scr + (8 * c) * 33 + n;
        u32x4 o; o.x = pk2(s[0 * 33], s[1 * 33]); o.y = pk2(s[2 * 33], s[3 * 33]); o.z = pk2(s[4 * 33], s[5 * 33]); o.w = pk2(s[6 * 33], s[7 * 33]);
        *(u32x4*)(WT + (size_t)(dst_row0 + n) * K + k0 + 8 * c) = o; }
    asm volatile("s_waitcnt lgkmcnt(0)" ::: "memory");
}
__device__ __forceinline__ unsigned pk4f8(float a, float b, float c, float d) { int w = 0; w = __builtin_amdgcn_cvt_pk_fp8_f32(a, b, w, false); w = __builtin_amdgcn_cvt_pk_fp8_f32(c, d, w, true); return (unsigned)w; }
__device__ __forceinline__ void transpose_item_f8(const float* W, int K, int N, unsigned char* WT, int k0, int n0, int dst_row0, float scale, LAS float* scr, int lane) {
#pragma unroll 8
    for (int i = 0; i < 32; ++i) { const int kk = 2 * i + (lane >> 5); scr[kk * 33 + (lane & 31)] = W[(size_t)(k0 + kk) * N + n0 + (lane & 31)] * scale; }
    asm volatile("s_waitcnt lgkmcnt(0)" ::: "memory");
    const int c = lane & 3;
#pragma unroll
    for (int j = 0; j < 2; ++j) { const int n = (lane >> 2) + 16 * j; const LAS float* s = scr + (16 * c) * 33 + n;
        u32x4 o; o.x = pk4f8(s[0 * 33], s[1 * 33], s[2 * 33], s[3 * 33]); o.y = pk4f8(s[4 * 33], s[5 * 33], s[6 * 33], s[7 * 33]); o.z = pk4f8(s[8 * 33], s[9 * 33], s[10 * 33], s[11 * 33]); o.w = pk4f8(s[12 * 33], s[13 * 33], s[14 * 33], s[15 * 33]);
        *(u32x4*)(WT + (size_t)(dst_row0 + n) * K + k0 + 16 * c) = o; }
    asm volatile("s_waitcnt lgkmcnt(0)" ::: "memory");
}
__device__ __forceinline__ void phase0(const Params& p, const Ctx& c) {
    unsigned char* ws = p.ws;
    LAS float* scr = (LAS float*)(c.lds + c.wave * 16384);
    constexpr int I0 = 16 * 168, I1 = 8 * 32, I2 = 8 * 32, I3 = 16 * 32, I4 = 32 * 1024, I5 = 32 * 512, NIT = I0 + I1 + I2 + I3 + I4 + I5;
    for (int it = c.gw; it < NIT; it += c.ngw) {
        int r = it;
        if (r < I0) { transpose_item(p.in[5], 1024, 5376, (bf16*)(ws + WS_WIN_T), 64 * (r / 168), 32 * (r % 168), 32 * (r % 168), scr, c.lane); continue; } r -= I0;
        if (r < I1) { transpose_item(p.in[17], 512, 1024, (bf16*)(ws + WS_WR_T), 64 * (r / 32), 32 * (r % 32), 32 * (r % 32), scr, c.lane); continue; } r -= I1;
        if (r < I2) { transpose_item(p.in[18], 512, 1024, (bf16*)(ws + WS_WA_T), 64 * (r / 32), 32 * (r % 32), 32 * (r % 32), scr, c.lane); continue; } r -= I2;
        if (r < I3) { transpose_item(p.in[19], 1024, 1024, (bf16*)(ws + WS_WO_T), 64 * (r / 32), 32 * (r % 32), 32 * (r % 32), scr, c.lane); continue; } r -= I3;
        if (r < I4) { const int e = r >> 10, rr = r & 1023, n0 = 32 * (rr & 63);
            const int dst = n0 < 1024 ? (n0 >> 7) * 256 + (n0 & 127) : ((n0 - 1024) >> 7) * 256 + 128 + ((n0 - 1024) & 127);
            transpose_item_f8(p.in[22] + (size_t)e * 1024 * 2048, 1024, 2048, ws + WS_W1T + (size_t)e * 2048 * 1024, 64 * (rr >> 6), n0, dst, W1_SCALE, scr, c.lane); continue; } r -= I4;
        { const int e = r >> 9, rr = r & 511; transpose_item_f8(p.in[24] + (size_t)e * 1024 * 1024, 1024, 1024, ws + WS_W2T + (size_t)e * 1024 * 1024, 64 * (rr >> 5), 32 * (rr & 31), 32 * (rr & 31), W2_SCALE, scr, c.lane); }
    }
    const int gt = c.bid * NTHREADS + c.tid, ngt = c.G * NTHREADS;
    { bf16* WL = (bf16*)(ws + WS_WLORA_T); const float* du = p.in[8]; const float* iu = p.in[10]; const float* gu = p.in[11];
      for (int i = gt; i < 1536 * 256; i += ngt) { const int n = i >> 8, k = i & 255; float v = 0.f;
          if (n < 512) { if (k < 64) v = du[k * 512 + n]; } else if (n < 1024) { if (k >= 64 && k < 128) v = iu[(k - 64) * 512 + (n - 512)]; } else { if (k >= 128) v = gu[(k - 128) * 512 + (n - 1024)]; }
          WL[i] = (bf16)f2bf(v); } }
    { float* RT = (float*)(ws + WS_ROPE); for (int i = gt; i < SEQ * 8; i += ngt) { const int pos = i >> 3, j = i & 7; float sn, cs; sincosf((float)pos * powf(500000.0f, -(float)j * 0.125f), &sn, &cs); RT[pos * 16 + j] = cs; RT[pos * 16 + 8 + j] = sn; }
      int* RTK = (int*)(ws + WS_ROWTOK); for (int i = gt; i < MAXSLOTS; i += ngt) RTK[i] = 0;
      float* KMz = (float*)(ws + WS_KMEAN); for (int i = gt; i < NB * NHEAD * 16 * 64; i += ngt) KMz[i] = 0.f; }
    { const f32x4* x4 = (const f32x4*)p.in[0]; u32x2* o = (u32x2*)(ws + WS_XB);
      for (int i = gt; i < MTOK * DMODEL / 4; i += ngt) { const f32x4 v = x4[i]; u32x2 w; w.x = pk2(v[0], v[1]); w.y = pk2(v[2], v[3]); o[i] = w; } }
}

__device__ __forceinline__ void phase2(const Params& p, const Ctx& c) {
    unsigned char* ws = p.ws;
    { const bf16* __restrict__ PLR = (const bf16*)(ws + WS_PLR); bf16* __restrict__ AL = (bf16*)(ws + WS_ALORA); const float* mix = p.in[6] + 1536;
      const int j0 = c.lane * 4; const f32x4 mx = *(const f32x4*)(mix + j0);
      for (int m0 = 4 * c.gw; m0 < MTOK; m0 += 4 * c.ngw) {
          u32x2 r[5]; u32x2 z; z.x = 0u; z.y = 0u; r[0] = z;
          if ((m0 & (SEQ - 1)) != 0) r[0] = *(const u32x2*)(PLR + (size_t)(m0 - 1) * 256 + j0);
#pragma unroll
          for (int u = 0; u < 4; ++u) r[u + 1] = *(const u32x2*)(PLR + (size_t)(m0 + u) * 256 + j0);
#pragma unroll
          for (int u = 0; u < 4; ++u) { const f32x4 cu = {bflo(r[u + 1].x), bfhi(r[u + 1].x), bflo(r[u + 1].y), bfhi(r[u + 1].y)}, pv = {bflo(r[u].x), bfhi(r[u].x), bflo(r[u].y), bfhi(r[u].y)};
              f32x4 s = cu + (pv - cu) * mx;
#pragma unroll
              for (int i = 0; i < 4; ++i) { if (c.lane < 16) s[i] = tanhf(s[i]); else if (c.lane >= 32) s[i] = sigmf(s[i]); }
              u32x2 o; o.x = pk2(s[0], s[1]); o.y = pk2(s[2], s[3]); *(u32x2*)(AL + (size_t)(m0 + u) * 256 + j0) = o; } } }
    { bf16* Q = (bf16*)(ws + WS_PQ); bf16* K = (bf16*)(ws + WS_PK); const float* RT = (const float*)(ws + WS_ROPE);
      for (int g = c.gw; g < MTOK / 4; g += c.ngw) { const int tok = 4 * g + (c.lane >> 4), which = (c.lane >> 3) & 1, h = c.lane & 7;
          bf16* P = (which ? K : Q) + (size_t)tok * 512 + h * 64; const float* rt = RT + (size_t)(tok & (SEQ - 1)) * 16;
          const u32x4 a = *(const u32x4*)P, bq = *(const u32x4*)(P + 8); const f32x4 c0 = *(const f32x4*)rt, c1 = *(const f32x4*)(rt + 4), s0 = *(const f32x4*)(rt + 8), s1 = *(const f32x4*)(rt + 12);
          const float x1[8] = {bflo(a.x), bfhi(a.x), bflo(a.y), bfhi(a.y), bflo(a.z), bfhi(a.z), bflo(a.w), bfhi(a.w)}, x2[8] = {bflo(bq.x), bfhi(bq.x), bflo(bq.y), bfhi(bq.y), bflo(bq.z), bfhi(bq.z), bflo(bq.w), bfhi(bq.w)};
          const float cs[8] = {c0[0], c0[1], c0[2], c0[3], c1[0], c1[1], c1[2], c1[3]}, sn[8] = {s0[0], s0[1], s0[2], s0[3], s1[0], s1[1], s1[2], s1[3]};
          float o1[8], o2[8];
#pragma unroll
          for (int i = 0; i < 8; ++i) { o1[i] = x1[i] * cs[i] - x2[i] * sn[i]; o2[i] = x2[i] * cs[i] + x1[i] * sn[i]; }
          u32x4 w1, w2; w1.x = pk2(o1[0], o1[1]); w1.y = pk2(o1[2], o1[3]); w1.z = pk2(o1[4], o1[5]); w1.w = pk2(o1[6], o1[7]); w2.x = pk2(o2[0], o2[1]); w2.y = pk2(o2[2], o2[3]); w2.z = pk2(o2[4], o2[5]); w2.w = pk2(o2[6], o2[7]);
          *(u32x4*)P = w1; *(u32x4*)(P + 8) = w2; } }
}
__device__ __forceinline__ void kmean_items(const Params& p, const Ctx& c) {
    const bf16* __restrict__ K = (const bf16*)(p.ws + WS_PK); float* KM = (float*)(p.ws + WS_KMEAN);
    for (int item = c.bid; item < NB * 32; item += c.G) { const int b = item >> 5, blk = (item >> 1) & 15, hf = item & 1, h = c.tid >> 6, d = c.tid & 63; const bf16* kp = K + ((size_t)b * SEQ + blk * 256 + hf * 128) * 512 + c.tid; float s = 0.f;
#pragma unroll 32
        for (int tok = 0; tok < 128; ++tok) s += bf2f(kp[(size_t)tok * 512]);
        atomicAdd(KM + ((size_t)((b * 8 + h) * 16 + blk)) * 64 + d, s * (1.0f / 256.0f)); }
}

template <int CTRL> __device__ __forceinline__ float dppf(float x) { return __builtin_bit_cast(float, __builtin_amdgcn_update_dpp(0, __builtin_bit_cast(int, x), CTRL, 0xF, 0xF, true)); }
__device__ __forceinline__ float row16_sum(float x) {
    x += dppf<0xB1>(x);
    x += dppf<0x4E>(x);
    x += dppf<0x141>(x);
    x += dppf<0x140>(x);
    return x;
}
__device__ __forceinline__ float wave_sum_dpp(float x) {
    x = row16_sum(x);
    x += __builtin_bit_cast(float, __builtin_amdgcn_update_dpp(0, __builtin_bit_cast(int, x), 0x142, 0xA, 0xF, false));
    x += __builtin_bit_cast(float, __builtin_amdgcn_update_dpp(0, __builtin_bit_cast(int, x), 0x143, 0xC, 0xF, false));
    return __builtin_bit_cast(float, __builtin_amdgcn_readlane(__builtin_bit_cast(int, x), 63));
}
constexpr int SCAN_TC = 32, SCAN_CHUNK_F = SCAN_TC * 384;
__device__ __forceinline__ f32x4 unpk4(u32x2 w) { return (f32x4){bflo(w.x), bfhi(w.x), bflo(w.y), bfhi(w.y)}; }
struct PrepConst { f32x4 mr, mk, mv, w0, a0, kk, ka, rk; };
__device__ __forceinline__ void prep_load(u32x2 (&raw)[8], const bf16* RKVh, const bf16* LOh, size_t m, bool has_prev) {
    const bf16* row = RKVh + m * 1536;
    raw[0] = *(const u32x2*)(row); raw[1] = *(const u32x2*)(row + 512); raw[2] = *(const u32x2*)(row + 1024);
    u32x2 z; z.x = 0u; z.y = 0u; raw[3] = z; raw[4] = z; raw[5] = z;
    if (has_prev) { raw[3] = *(const u32x2*)(row - 1536); raw[4] = *(const u32x2*)(row - 1536 + 512); raw[5] = *(const u32x2*)(row - 1536 + 1024); }
    raw[6] = *(const u32x2*)(LOh + m * 1536); raw[7] = *(const u32x2*)(LOh + m * 1536 + 512);
}
__device__ __forceinline__ void prep_pass(const u32x2 (&raw)[8], const PrepConst& k, LAS float* dst  , float* bonus  ) {
    f32x4 r = unpk4(raw[0]), kx = unpk4(raw[1]), v = unpk4(raw[2]); const f32x4 rp = unpk4(raw[3]), kp = unpk4(raw[4]), vp = unpk4(raw[5]), lw = unpk4(raw[6]), la = unpk4(raw[7]);
    r = r + (rp - r) * k.mr; kx = kx + (kp - kx) * k.mk; v = v + (vp - v) * k.mv;
    f32x4 dec, a;
#pragma unroll
    for (int i = 0; i < 4; ++i) { const float sg = 1.0f / (1.0f + __expf(-(k.w0[i] + lw[i]))); dec[i] = __expf(-0.6065306597126334f * sg); a[i] = 1.0f / (1.0f + __expf(-(k.a0[i] + la[i]))); }
    const f32x4 kkv = kx * k.kk; float ss = (kkv[0] * kkv[0] + kkv[1] * kkv[1]) + (kkv[2] * kkv[2] + kkv[3] * kkv[3]); ss = row16_sum(ss);
    const float inv = 1.0f / fmaxf(sqrtf(ss), 1e-12f); const f32x4 kk = kkv * inv; const f32x4 kmod = kx * ((a - 1.0f) * k.ka + 1.0f);
    const f32x4 rb = r * kmod * k.rk; float bs = (rb[0] + rb[1]) + (rb[2] + rb[3]); bs = row16_sum(bs);
    *(LAS f32x4*)(dst) = -kk; *(LAS f32x4*)(dst + 64) = kk * a; *(LAS f32x4*)(dst + 128) = dec; *(LAS f32x4*)(dst + 192) = kmod; *(LAS f32x4*)(dst + 256) = r; *(LAS f32x4*)(dst + 320) = v;
    if (bonus) *(f32x4*)bonus = v * bs;
}
__device__ __forceinline__ void scan_item(const Params& p, const Ctx& c, int item) {
    const int bh = item >> 2, rg = item & 3, b = bh >> 3, h = bh & 7;
    LAS float* buf = (LAS float*)c.lds;
    constexpr int NC = SEQ / SCAN_TC;
    const int pt = c.tid & 255, tl = pt >> 4, cq = pt & 15, ch0 = h * 64 + 4 * cq;
    const bf16* RKVh = (const bf16*)(p.ws + WS_PRKV) + ch0; const bf16* LOh = (const bf16*)(p.ws + WS_LORA) + ch0; float* BON = (float*)(p.ws + WS_BONUS) + ch0;
    const size_t mb = (size_t)b * SEQ;
    PrepConst pc; u32x2 raw0[8], raw1[8];
    const int rowl = (c.wave & 3) * 4 + (c.lane >> 4), kq = c.lane & 15, rowg = rg * 16 + rowl;
    f32x4 S = {0.f, 0.f, 0.f, 0.f};
    if (c.wave >= 4) {
        pc.mr = *(const f32x4*)(p.in[6] + ch0); pc.mk = *(const f32x4*)(p.in[6] + 512 + ch0); pc.mv = *(const f32x4*)(p.in[6] + 1024 + ch0);
        pc.w0 = *(const f32x4*)(p.in[7] + ch0); pc.a0 = *(const f32x4*)(p.in[9] + ch0); pc.kk = *(const f32x4*)(p.in[12] + ch0); pc.ka = *(const f32x4*)(p.in[13] + ch0); pc.rk = *(const f32x4*)(p.in[14] + ch0);
        prep_load(raw0, RKVh, LOh, mb + tl, tl != 0); prep_load(raw1, RKVh, LOh, mb + 16 + tl, true);
        prep_pass(raw0, pc, buf + tl * 384 + 4 * cq, rg == 0 ? BON + (mb + tl) * 512 : nullptr);
        prep_pass(raw1, pc, buf + (16 + tl) * 384 + 4 * cq, rg == 0 ? BON + (mb + 16 + tl) * 512 : nullptr);
        prep_load(raw0, RKVh, LOh, mb + SCAN_TC + tl, true); prep_load(raw1, RKVh, LOh, mb + SCAN_TC + 16 + tl, true);
    }
    __syncthreads();
    for (int ch = 0; ch < NC; ++ch) {
        if (c.wave < 4) {
            const LAS float* cb = buf + (ch & 1) * SCAN_CHUNK_F;
            float* yo = (float*)(p.ws + WS_YRAW) + (mb + (size_t)ch * SCAN_TC + kq) * 512 + h * 64 + rowg;
            f32x4 nk = *(const LAS f32x4*)(cb + 4 * kq), ka = *(const LAS f32x4*)(cb + 64 + 4 * kq), w = *(const LAS f32x4*)(cb + 128 + 4 * kq);
            f32x4 km = *(const LAS f32x4*)(cb + 192 + 4 * kq), rr = *(const LAS f32x4*)(cb + 256 + 4 * kq); float v = cb[320 + rowg];
            float ykeep = 0.f;
#pragma unroll
            for (int s = 0; s < SCAN_TC; ++s) {
                f32x4 nk2 = nk, ka2 = ka, w2 = w, km2 = km, rr2 = rr; float v2 = v;
                if (s + 1 < SCAN_TC) { const LAS float* op = cb + (s + 1) * 384;
                    nk2 = *(const LAS f32x4*)(op + 4 * kq); ka2 = *(const LAS f32x4*)(op + 64 + 4 * kq); w2 = *(const LAS f32x4*)(op + 128 + 4 * kq);
                    km2 = *(const LAS f32x4*)(op + 192 + 4 * kq); rr2 = *(const LAS f32x4*)(op + 256 + 4 * kq); v2 = op[320 + rowg]; }
                __builtin_amdgcn_sched_barrier(0);
                float sa = (S[0] * nk[0] + S[1] * nk[1]) + (S[2] * nk[2] + S[3] * nk[3]);
                const f32x4 T = S * w + km * v;
                sa = row16_sum(sa);
                S = T + ka * sa;
                float y = (S[0] * rr[0] + S[1] * rr[1]) + (S[2] * rr[2] + S[3] * rr[3]);
                y = row16_sum(y);
                ykeep = (kq == (s & 15)) ? y : ykeep;
                if ((s & 15) == 15) yo[(size_t)(s - 15) * 512] = ykeep;
                nk = nk2; ka = ka2; w = w2; km = km2; rr = rr2; v = v2;
            }
        } else if (ch + 1 < NC) {
            LAS float* nb = buf + ((ch + 1) & 1) * SCAN_CHUNK_F; const size_t m1 = mb + (size_t)(ch + 1) * SCAN_TC;
            prep_pass(raw0, pc, nb + tl * 384 + 4 * cq, rg == 0 ? BON + (m1 + tl) * 512 : nullptr);
            prep_pass(raw1, pc, nb + (16 + tl) * 384 + 4 * cq, rg == 0 ? BON + (m1 + 16 + tl) * 512 : nullptr);
            if (ch + 2 < NC) { prep_load(raw0, RKVh, LOh, m1 + SCAN_TC + tl, true); prep_load(raw1, RKVh, LOh, m1 + SCAN_TC + 16 + tl, true); }
        }
        __syncthreads();
    }
}

namespace att {
constexpr int L_K = 0, L_V = 16384, L_KM = 32768, L_SEL = 36864, L_WS = 37888;
constexpr float C2 = 0.125f * 1.4426950408889634f;
__device__ __forceinline__ int crow(int r, int hi) { return (r & 3) + 8 * (r >> 2) + 4 * hi; }
typedef __bf16 bf16x2_t __attribute__((ext_vector_type(2)));
__device__ __forceinline__ unsigned cvtpk(float lo, float hi) { f32x2 v = {lo, hi}; bf16x2_t b = __builtin_convertvector(v, bf16x2_t); return __builtin_bit_cast(unsigned, b); }
typedef short v4i16_t __attribute__((ext_vector_type(4)));
__device__ __forceinline__ s16x4 vtr(const LAS unsigned char* p) { return __builtin_bit_cast(s16x4, __builtin_amdgcn_ds_read_tr16_b64_v4i16((LAS v4i16_t*)p)); }

__device__ __forceinline__ void unit(const Params& p, const Ctx& c, int b, int h, int qb, bf16* Oout) {
    const int tid = c.tid, lane = c.lane, wid = c.wave, r32 = lane & 31, hi = lane >> 5;
    bf16* Q = (bf16*)(p.ws + WS_PQ); const bf16* K = (const bf16*)(p.ws + WS_PK); const bf16* V = (const bf16*)(p.ws + WS_PAV); const float* KMg = (const float*)(p.ws + WS_KMEAN);
    const size_t rowbase = (size_t)b * SEQ; const int q0 = qb * 256;
    LAS unsigned char* lds = c.lds; LAS float* kml = (LAS float*)(lds + L_KM); LAS unsigned* sell = (LAS unsigned*)(lds + L_SEL); LAS float* wsf = (LAS float*)(lds + L_WS) + wid * 64;
    for (int i = tid; i < qb * 64; i += NTHREADS) kml[i] = KMg[(size_t)((b * 8 + h) * 16) * 64 + i];
    __syncthreads();
    if (tid < 256) {
        const bf16* qrow = Q + (rowbase + q0 + tid) * 512 + h * 64; float qv[64];
#pragma unroll
        for (int i = 0; i < 8; ++i) { const u32x4 w = *(const u32x4*)(qrow + 8 * i); qv[8 * i] = bflo(w.x); qv[8 * i + 1] = bfhi(w.x); qv[8 * i + 2] = bflo(w.y); qv[8 * i + 3] = bfhi(w.y); qv[8 * i + 4] = bflo(w.z); qv[8 * i + 5] = bfhi(w.z); qv[8 * i + 6] = bflo(w.w); qv[8 * i + 7] = bfhi(w.w); }
        float v0 = -INFINITY, v1 = -INFINITY, v2 = -INFINITY; int i0 = -1, i1 = -1, i2 = -1;
        for (int j = 0; j < qb; ++j) { float g = 0.f;
#pragma unroll
            for (int d = 0; d < 64; d += 4) { const f32x4 km = *(const LAS f32x4*)(kml + j * 64 + d); g += qv[d] * km[0] + qv[d + 1] * km[1] + qv[d + 2] * km[2] + qv[d + 3] * km[3]; }
            if (g > v0) { v2 = v1; i2 = i1; v1 = v0; i1 = i0; v0 = g; i0 = j; } else if (g > v1) { v2 = v1; i2 = i1; v1 = g; i1 = j; } else if (g > v2) { v2 = g; i2 = j; } }
        unsigned msk = 0u; if (i0 >= 0) msk |= 1u << i0; if (i1 >= 0) msk |= 1u << i1; if (i2 >= 0) msk |= 1u << i2;
        sell[tid] = msk;
    }
    __syncthreads();
    const bf16* Qw = Q + (rowbase + q0 + wid * 32) * 512 + h * 64; bf16x8 qr[4];
#pragma unroll
    for (int d0 = 0; d0 < 4; ++d0) qr[d0] = *(const bf16x8*)(Qw + (size_t)r32 * 512 + d0 * 16 + hi * 8);
    const unsigned mysel = sell[wid * 32 + r32]; const int qrel = wid * 32 + r32;
    float m_run = -INFINITY, l_run = 0.f; f32x16 o0 = {}, o1 = {};
    const int krow = tid & 63, kch = tid >> 6; const bf16* ksrc = K + (rowbase + krow) * 512 + h * 64 + kch * 8; const int kdst = kch * 1024 + krow * 16;
    const int vrow = 16 * (wid & 3) + (lane >> 2), vcol = (wid >> 2) * 32 + (lane & 3) * 8; const bf16* vsrc = V + (rowbase + vrow) * 512 + h * 64 + vcol; const int vdst = wid * 1024 + lane * 16;
    const int kfo = hi * 1024 + r32 * 16; const int vfo = ((lane >> 4) & 1) * 32 + (lane & 3) * 8 + (4 * hi + ((lane & 15) >> 2)) * 64;
    const int ntile = 4 * qb + 4;
    u32x4 kreg = *(const u32x4*)(ksrc), vreg = *(const u32x4*)(vsrc);
    for (int it = 0; it < ntile; ++it) {
        LAS unsigned char* Ks = lds + L_K + (it & 1) * 8192; LAS unsigned char* Vs = lds + L_V + (it & 1) * 8192;
        *(LAS u32x4*)(Ks + kdst) = kreg; *(LAS u32x4*)(Vs + vdst) = vreg;
        __syncthreads();
        if (it + 1 < ntile) { kreg = *(const u32x4*)(ksrc + (size_t)(it + 1) * 64 * 512); vreg = *(const u32x4*)(vsrc + (size_t)(it + 1) * 64 * 512); }
        const int blk = it >> 2; const bool band = blk == qb; const int jb = it & 3;
        bool lane_on = band ? (64 * jb <= qrel) : (((mysel >> blk) & 1u) != 0u);
        if (__any(lane_on)) {
            f32x16 p0 = {}, p1 = {};
#pragma unroll
            for (int d0 = 0; d0 < 4; ++d0) { const bf16x8 k0 = *(const LAS bf16x8*)(Ks + kfo + d0 * 2048), k1 = *(const LAS bf16x8*)(Ks + kfo + d0 * 2048 + 512);
                p0 = __builtin_amdgcn_mfma_f32_32x32x16_bf16(k0, qr[d0], p0, 0, 0, 0); p1 = __builtin_amdgcn_mfma_f32_32x32x16_bf16(k1, qr[d0], p1, 0, 0, 0); }
#pragma unroll
            for (int r = 0; r < 16; ++r) { const int kv = 64 * jb + crow(r, hi);
                const bool ok0 = band ? (kv <= qrel) : lane_on, ok1 = band ? (kv + 32 <= qrel) : lane_on;
                p0[r] = ok0 ? p0[r] * C2 : -INFINITY; p1[r] = ok1 ? p1[r] * C2 : -INFINITY; }
            float rm = fmaxf(p0[0], p1[0]);
#pragma unroll
            for (int r = 1; r < 16; ++r) rm = fmaxf(rm, fmaxf(p0[r], p1[r]));
            rm = fmaxf(rm, __shfl_xor(rm, 32));
            const float m_new = fmaxf(m_run, rm); const float m_use = (m_new == -INFINITY) ? 0.f : m_new;
            const float alpha = __builtin_amdgcn_exp2f(m_run - m_use);
            float ps = 0.f;
#pragma unroll
            for (int r = 0; r < 16; ++r) { p0[r] = __builtin_amdgcn_exp2f(p0[r] - m_use); p1[r] = __builtin_amdgcn_exp2f(p1[r] - m_use); ps += p0[r] + p1[r]; }
            l_run = l_run * alpha + ps; m_run = m_new;
            if (__any(alpha != 1.0f)) {
                if (hi == 0) wsf[r32] = alpha;
                asm volatile("s_waitcnt lgkmcnt(0)" ::: "memory");
#pragma unroll
                for (int r = 0; r < 16; ++r) { const float f = wsf[crow(r, hi)]; o0[r] *= f; o1[r] *= f; }
                asm volatile("s_waitcnt lgkmcnt(0)" ::: "memory");
            }
            u32x4 pw[4];
            pw[0] = (u32x4){cvtpk(p0[0], p0[1]), cvtpk(p0[2], p0[3]), cvtpk(p0[4], p0[5]), cvtpk(p0[6], p0[7])};
            pw[1] = (u32x4){cvtpk(p0[8], p0[9]), cvtpk(p0[10], p0[11]), cvtpk(p0[12], p0[13]), cvtpk(p0[14], p0[15])};
            pw[2] = (u32x4){cvtpk(p1[0], p1[1]), cvtpk(p1[2], p1[3]), cvtpk(p1[4], p1[5]), cvtpk(p1[6], p1[7])};
            pw[3] = (u32x4){cvtpk(p1[8], p1[9]), cvtpk(p1[10], p1[11]), cvtpk(p1[12], p1[13]), cvtpk(p1[14], p1[15])};
#pragma unroll
            for (int ks = 0; ks < 4; ++ks) {
                const s16x4 a0 = vtr(Vs + vfo + ks * 1024), a1 = vtr(Vs + vfo + ks * 1024 + 512), b0 = vtr(Vs + vfo + 4096 + ks * 1024), b1 = vtr(Vs + vfo + 4096 + ks * 1024 + 512);
                const bf16x8 va = {a0[0], a0[1], a0[2], a0[3], a1[0], a1[1], a1[2], a1[3]}, vb = {b0[0], b0[1], b0[2], b0[3], b1[0], b1[1], b1[2], b1[3]};
                const bf16x8 pa = __builtin_bit_cast(bf16x8, pw[ks]);
                o0 = __builtin_amdgcn_mfma_f32_32x32x16_bf16(pa, va, o0, 0, 0, 0); o1 = __builtin_amdgcn_mfma_f32_32x32x16_bf16(pa, vb, o1, 0, 0, 0);
            }
        }
    }
    l_run += __shfl_xor(l_run, 32);
    if (hi == 0) wsf[32 + r32] = l_run;
    asm volatile("s_waitcnt lgkmcnt(0)" ::: "memory");
    bf16* Ow = Oout + (rowbase + q0 + wid * 32) * 512 + h * 64;
#pragma unroll
    for (int r = 0; r < 16; ++r) { const int qr_ = crow(r, hi); const float rl = 1.0f / wsf[32 + qr_];
        Ow[(size_t)qr_ * 512 + r32] = (bf16)f2bf(o0[r] * rl); Ow[(size_t)qr_ * 512 + 32 + r32] = (bf16)f2bf(o1[r] * rl); }
    __syncthreads();
}
}

__device__ __forceinline__ float sum8(float x) { x += dppf<0xB1>(x); x += dppf<0x4E>(x); x += dppf<0x141>(x); return x; }
__device__ __forceinline__ void phase6(const Params& p, const Ctx& c) {
    unsigned char* ws = p.ws; const float* __restrict__ YR = (const float*)(ws + WS_YRAW); const float* __restrict__ BON = (const float*)(ws + WS_BONUS); const bf16* __restrict__ LO = (const bf16*)(ws + WS_LORA); bf16* __restrict__ YO = (bf16*)(ws + WS_YRWKV);
    const int ch = 8 * c.lane; const f32x4 gg0 = *(const f32x4*)(p.in[15] + ch), gg1 = *(const f32x4*)(p.in[15] + ch + 4), gb0 = *(const f32x4*)(p.in[16] + ch), gb1 = *(const f32x4*)(p.in[16] + ch + 4);
    for (int m0 = 2 * c.gw; m0 < MTOK; m0 += 2 * c.ngw) {
        f32x4 y[2][2], bo[2][2]; u32x4 gw_[2];
#pragma unroll
        for (int u = 0; u < 2; ++u) { const size_t m = (size_t)(m0 + u); y[u][0] = *(const f32x4*)(YR + m * 512 + ch); y[u][1] = *(const f32x4*)(YR + m * 512 + ch + 4);
            bo[u][0] = *(const f32x4*)(BON + m * 512 + ch); bo[u][1] = *(const f32x4*)(BON + m * 512 + ch + 4); gw_[u] = *(const u32x4*)(LO + m * 1536 + 1024 + ch); }
#pragma unroll
        for (int u = 0; u < 2; ++u) { const size_t m = (size_t)(m0 + u);
            float s = ((y[u][0][0] + y[u][0][1]) + (y[u][0][2] + y[u][0][3])) + ((y[u][1][0] + y[u][1][1]) + (y[u][1][2] + y[u][1][3]));
            const float mu = sum8(s) * (1.0f / 64.0f); const f32x4 d0 = y[u][0] - mu, d1 = y[u][1] - mu;
            float q = ((d0[0] * d0[0] + d0[1] * d0[1]) + (d0[2] * d0[2] + d0[3] * d0[3])) + ((d1[0] * d1[0] + d1[1] * d1[1]) + (d1[2] * d1[2] + d1[3] * d1[3]));
            const float rs = rsqrtf(sum8(q) * (1.0f / 64.0f) + GN_EPS);
            const f32x4 g0 = {bflo(gw_[u].x), bfhi(gw_[u].x), bflo(gw_[u].y), bfhi(gw_[u].y)}, g1v = {bflo(gw_[u].z), bfhi(gw_[u].z), bflo(gw_[u].w), bfhi(gw_[u].w)};
            const f32x4 o0 = (d0 * rs * gg0 + gb0 + bo[u][0]) * g0, o1 = (d1 * rs * gg1 + gb1 + bo[u][1]) * g1v;
            u32x4 w; w.x = pk2(o0[0], o0[1]); w.y = pk2(o0[2], o0[3]); w.z = pk2(o1[0], o1[1]); w.w = pk2(o1[2], o1[3]);
            *(u32x4*)(YO + m * 512 + ch) = w; }
    }
}

constexpr int RW_PITCH = 36;
constexpr int L_HIST = 1024 * RW_PITCH * 4;
__device__ __forceinline__ void phase9(const Params& p, const Ctx& c, const bool dry = false) {
    unsigned char* ws = p.ws; const float* XP = (const float*)(ws + WS_XPRE); float* X1 = (float*)(ws + WS_X1); unsigned char* X1F = (unsigned char*)(ws + WS_X1B);
    int* ctl = (int*)(ws + WS_CTL); int* TOKE = (int*)(ws + WS_TOKE); float* TOKW = (float*)(ws + WS_TOKW);
    const float* g1 = p.in[1]; const float* b1 = p.in[2]; const float* RW = p.in[20]; const float* RB = p.in[21];
    LAS float* rw = (LAS float*)c.lds; LAS int* hist = (LAS int*)(c.lds + L_HIST);
    for (int i = c.tid; i < 1024 * 8; i += NTHREADS) { const int row = i >> 3, q = i & 7; *(LAS f32x4*)(rw + row * RW_PITCH + 4 * q) = *(const f32x4*)(RW + row * 32 + 4 * q); }
    if (c.tid < 32) { hist[c.tid] = 0; ((LAS float*)(c.lds + L_HIST + 256))[c.tid] = RB[c.tid]; }
    __syncthreads();
    float gv[16], bvv[16]; LAS float* rbl = (LAS float*)(c.lds + L_HIST + 256);
#pragma unroll
    for (int i = 0; i < 16; ++i) { gv[i] = g1[c.lane + 64 * i]; bvv[i] = b1[c.lane + 64 * i]; }
    for (int m = c.gw; m < MTOK; m += c.ngw) {
        const float* xr = XP + (size_t)m * 1024 + c.lane; float v[16]; float s = 0.f;
#pragma unroll
        for (int i = 0; i < 16; ++i) { v[i] = xr[64 * i]; s += v[i]; }
        const float mean = wave_sum_dpp(s) * (1.0f / 1024.0f); float s2 = 0.f;
#pragma unroll
        for (int i = 0; i < 16; ++i) { v[i] -= mean; s2 += v[i] * v[i]; }
        const float rstd = 1.0f / sqrtf(wave_sum_dpp(s2) * (1.0f / 1024.0f) + LN_EPS);
        float acc[32];
#pragma unroll
        for (int e = 0; e < 32; ++e) acc[e] = 0.f;
#pragma unroll
        for (int i = 0; i < 16; ++i) { const int col = c.lane + 64 * i; const float xv = v[i] * rstd * gv[i] + bvv[i];
            X1[(size_t)m * 1024 + col] = xv; X1F[(size_t)m * 1024 + col] = (unsigned char)(__builtin_amdgcn_cvt_pk_fp8_f32(xv, xv, 0, false) & 0xff);
            const LAS float* wr_ = rw + col * RW_PITCH;
#pragma unroll
            for (int q = 0; q < 8; ++q) { const f32x4 w4 = *(const LAS f32x4*)(wr_ + 4 * q); acc[4 * q] += xv * w4[0]; acc[4 * q + 1] += xv * w4[1]; acc[4 * q + 2] += xv * w4[2]; acc[4 * q + 3] += xv * w4[3]; }
            __builtin_amdgcn_sched_barrier(0); }
#pragma unroll
        for (int e = 0; e < 32; ++e) acc[e] = wave_sum_dpp(acc[e]) + rbl[e];
        float tv[4]; int ti[4]; unsigned used = 0u;
#pragma unroll
        for (int k = 0; k < 4; ++k) { float bv = -INFINITY; int bi = 0;
#pragma unroll
            for (int e = 0; e < 32; ++e) { const bool ok = ((used >> e) & 1u) == 0u && acc[e] > bv; bv = ok ? acc[e] : bv; bi = ok ? e : bi; }
            tv[k] = bv; ti[k] = bi; used |= 1u << bi; }
        const float e1 = __expf(tv[1] - tv[0]), e2 = __expf(tv[2] - tv[0]), e3 = __expf(tv[3] - tv[0]); const float inv = 1.0f / (1.0f + e1 + e2 + e3);
        if (c.lane < 4 && (!dry || tv[0] == 12345.678f)) { const int e = c.lane == 0 ? ti[0] : c.lane == 1 ? ti[1] : c.lane == 2 ? ti[2] : ti[3]; const float w = (c.lane == 0 ? 1.0f : c.lane == 1 ? e1 : c.lane == 2 ? e2 : e3) * inv;
            const int pos = __hip_atomic_fetch_add(hist + e, 1, __ATOMIC_RELAXED, __HIP_MEMORY_SCOPE_WORKGROUP);
            TOKE[m * 4 + c.lane] = e | (pos << 8); TOKW[m * 4 + c.lane] = w; }
    }
    __syncthreads();
    if (c.tid < 32 && !dry) { const int base = atomicAdd(ctl + CW_COUNT + c.tid, hist[c.tid]); ctl[CW_WGBASE + c.bid * 32 + c.tid] = base; }
    __syncthreads();
}

__device__ __forceinline__ void phase10(const Params& p, const Ctx& c) {
    unsigned char* ws = p.ws; int* ctl = (int*)(ws + WS_CTL); const int* TOKE = (const int*)(ws + WS_TOKE); const float* TOKW = (const float*)(ws + WS_TOKW);
    int* SLOTOF = (int*)(ws + WS_SLOTOF); float* ROWW = (float*)(ws + WS_ROWW);
    LAS int* pst = (LAS int*)(c.lds + L_HIST + 128);
    if (c.tid == 0) { int acc = 0;
        for (int e = 0; e < 32; ++e) { const int cnt = __hip_atomic_load(ctl + CW_COUNT + e, __ATOMIC_RELAXED, __HIP_MEMORY_SCOPE_AGENT); const int nt = (cnt + 255) >> 8;
            pst[e] = acc * 256;
            if (c.bid == 0) for (int t = 0; t < nt; ++t) ctl[CW_TILE_E + acc + t] = e;
            acc += nt; }
        if (c.bid == 0) ctl[CW_NTILES] = acc; }
    __syncthreads();
    int* ROWTOK = (int*)(ws + WS_ROWTOK);
    for (int i = c.bid * NTHREADS + c.tid; i < MTOK * 4; i += c.G * NTHREADS) { const int m = i >> 2, wg = (m % c.ngw) >> 3;
        const int ew = TOKE[i], e = ew & 255; const int slot = pst[e] + ctl[CW_WGBASE + wg * 32 + e] + (ew >> 8); SLOTOF[i] = slot; ROWW[slot] = TOKW[i]; ROWTOK[slot] = m; }
}

__device__ __forceinline__ void phase14(const Params& p, const Ctx& c) {
    unsigned char* ws = p.ws; const float* __restrict__ X1 = (const float*)(ws + WS_X1); const bf16* __restrict__ YB = (const bf16*)(ws + WS_YBUF); const int* __restrict__ SLOTOF = (const int*)(ws + WS_SLOTOF);
    float* __restrict__ OUT = p.out; f32x4 g2v[4], b2v[4];
#pragma unroll
    for (int j = 0; j < 4; ++j) { g2v[j] = *(const f32x4*)(p.in[3] + 256 * j + 4 * c.lane); b2v[j] = *(const f32x4*)(p.in[4] + 256 * j + 4 * c.lane); }
    for (int m0 = 2 * c.gw; m0 < MTOK; m0 += 2 * c.ngw) {
        f32x4 v[2][4]; u32x2 yv[2][4][4];
#pragma unroll
        for (int u = 0; u < 2; ++u) { const int m = m0 + u; int sl[4];
#pragma unroll
            for (int k = 0; k < 4; ++k) sl[k] = SLOTOF[m * 4 + k];
#pragma unroll
            for (int j = 0; j < 4; ++j) { const int col = 256 * j + 4 * c.lane; v[u][j] = *(const f32x4*)(X1 + (size_t)m * 1024 + col);
#pragma unroll
                for (int k = 0; k < 4; ++k) yv[u][j][k] = *(const u32x2*)(YB + (size_t)sl[k] * 1024 + col); } }
#pragma unroll
        for (int u = 0; u < 2; ++u) { const int m = m0 + u; float s = 0.f;
#pragma unroll
            for (int j = 0; j < 4; ++j) { f32x4 a = v[u][j] * DN_ALPHA; const u32x2 y0 = yv[u][j][0], y1 = yv[u][j][1], y2 = yv[u][j][2], y3 = yv[u][j][3];
                a[0] += ((bflo(y0.x) + bflo(y1.x)) + bflo(y2.x)) + bflo(y3.x); a[1] += ((bfhi(y0.x) + bfhi(y1.x)) + bfhi(y2.x)) + bfhi(y3.x);
                a[2] += ((bflo(y0.y) + bflo(y1.y)) + bflo(y2.y)) + bflo(y3.y); a[3] += ((bfhi(y0.y) + bfhi(y1.y)) + bfhi(y2.y)) + bfhi(y3.y);
                v[u][j] = a; s += (a[0] + a[1]) + (a[2] + a[3]); }
            const float mean = wave_sum_dpp(s) * (1.0f / 1024.0f); float q = 0.f;
#pragma unroll
            for (int j = 0; j < 4; ++j) { v[u][j] = v[u][j] - mean; q += (v[u][j][0] * v[u][j][0] + v[u][j][1] * v[u][j][1]) + (v[u][j][2] * v[u][j][2] + v[u][j][3] * v[u][j][3]); }
            const float rstd = 1.0f / sqrtf(wave_sum_dpp(q) * (1.0f / 1024.0f) + LN_EPS);
#pragma unroll
            for (int j = 0; j < 4; ++j) *(f32x4*)(OUT + (size_t)m * 1024 + 256 * j + 4 * c.lane) = v[u][j] * rstd * g2v[j] + b2v[j]; }
    }
}

#define XB_TMO      128
#define XB_XCNT(j)  (256  + 64 * (j))
#define XB_XSUB(j)  (1280 + 64 * (j))
#define XB_XGEN(j)  (2304 + 64 * (j))
#define XB_TOP      3328
#define XB_TOPGEN   3392
#define XCD_BAR_WORDS 3456
#define XB_SPIN_CAP (1u << 18)

__device__ __forceinline__ unsigned xb_ld(unsigned* p)              { return __hip_atomic_load(p, __ATOMIC_RELAXED, __HIP_MEMORY_SCOPE_AGENT); }
__device__ __forceinline__ unsigned xb_add(unsigned* p, unsigned v) { return __hip_atomic_fetch_add(p, v, __ATOMIC_RELAXED, __HIP_MEMORY_SCOPE_AGENT); }
__device__ __forceinline__ unsigned xb_xcc_id() { return (unsigned)__builtin_amdgcn_s_getreg((3 << 11) | 20) & 0xFu; }
#define XB_SPIN(cond, bar) do { unsigned _sp = 0; while (cond) { __builtin_amdgcn_s_sleep(1); \
    if ((++_sp & 255u) == 0u) { if (xb_ld(&(bar)[XB_TMO])) break; if (_sp > XB_SPIN_CAP) { atomicAdd(&(bar)[XB_TMO], 1u); break; } } } } while (0)

struct XcdBarrier {
    unsigned* bar; unsigned x;
    volatile LAS unsigned* st;
};

__device__ __forceinline__ XcdBarrier xcd_barrier_post(unsigned* bar, volatile LAS unsigned* st) {
    XcdBarrier b; b.bar = bar; b.x = xb_xcc_id(); b.st = st;
    if (threadIdx.x == 0) (void)xb_add(&bar[XB_XCNT(b.x)], 1u);
    return b;
}
__device__ __forceinline__ void xcd_barrier_complete(unsigned* bar, unsigned x, unsigned& nloc, unsigned& nx) {
    const unsigned G = gridDim.x * gridDim.y * gridDim.z;
    unsigned sum, cnt, mine, sp = 0u;
    for (;;) {
        sum = 0u; cnt = 0u; mine = 0u;
#pragma unroll
        for (unsigned j = 0; j < 16; ++j) { const unsigned c = xb_ld(&bar[XB_XCNT(j)]); sum += c; cnt += (c > 0u) ? 1u : 0u; mine = (j == x) ? c : mine; }
        if (sum == G) break;
        __builtin_amdgcn_s_sleep(1);
        if ((++sp & 255u) == 0u) { if (xb_ld(&bar[XB_TMO])) break; if (sp > XB_SPIN_CAP) { atomicAdd(&bar[XB_TMO], 1u); break; } }
    }
    nloc = mine > 0u ? mine : 1u; nx = cnt > 0u ? cnt : 1u;
}

__device__ __forceinline__ void xcd_barrier(const XcdBarrier& b) {
    asm volatile("s_waitcnt vmcnt(0)" ::: "memory");
    __syncthreads();
    if (threadIdx.x == 0) {
        unsigned* bar = b.bar;
        __builtin_amdgcn_s_waitcnt(0);
        unsigned nloc = b.st[0], nx = b.st[1];
        if (nloc == 0u) { xcd_barrier_complete(bar, b.x, nloc, nx); b.st[0] = nloc; b.st[1] = nx; }
        const unsigned old = xb_add(&bar[XB_XSUB(b.x)], 1u);
        const unsigned gen = old / nloc;
        if (old + 1u == (gen + 1u) * nloc) {
            __builtin_amdgcn_fence(__ATOMIC_RELEASE, "agent");
            asm volatile("s_waitcnt vmcnt(0)" ::: "memory");
            const unsigned og = xb_add(&bar[XB_TOP], 1u);
            const unsigned tg = og / nx;
            if (og + 1u == (tg + 1u) * nx) xb_add(&bar[XB_TOPGEN], 1u);
            else XB_SPIN(xb_ld(&bar[XB_TOPGEN]) == tg, bar);
            __builtin_amdgcn_fence(__ATOMIC_ACQUIRE, "agent");
            xb_add(&bar[XB_XGEN(b.x)], 1u);
            asm volatile("s_waitcnt vmcnt(0)" ::: "memory");
        } else {
            XB_SPIN(xb_ld(&bar[XB_XGEN(b.x)]) == gen, bar);
            __builtin_amdgcn_fence(__ATOMIC_ACQUIRE, "agent");
            asm volatile("s_waitcnt vmcnt(0)" ::: "memory");
        }
    }
    __syncthreads();
}


constexpr int NPHASE = 15;
#ifndef MK_SPLIT
#define MK_SPLIT 0
#endif
__global__ void __launch_bounds__(NTHREADS, 2) fwd_megakernel(Params p) {
    extern __shared__ __attribute__((aligned(16))) unsigned char lds_raw[];
    Ctx c; c.lds = (LAS unsigned char*)lds_raw; c.tid = threadIdx.x; c.lane = c.tid & 63; c.wave = __builtin_amdgcn_readfirstlane(c.tid >> 6);
    c.G = gridDim.x; c.bid = blockIdx.x; c.gw = c.bid * NWAVES + c.wave; c.ngw = c.G * NWAVES;
    unsigned char* ws = p.ws;
    const int lo = p.ph_lo, hi = p.ph_hi;
#ifdef ONLY_PHASE
#define IN(k) ((k) == ONLY_PHASE && lo <= (k) && (k) < hi)
#else
#define IN(k) (lo <= (k) && (k) < hi)
#endif
#if MK_SPLIT
#define SEAM(k) do { } while (0)
#else
    cg::grid_group grid = cg::this_grid();
    { volatile LAS unsigned* st = (volatile LAS unsigned*)(c.lds + LDS_BYTES - 16); if (c.tid < 4) st[c.tid] = 0u; }
    __syncthreads();
    const XcdBarrier xbar = xcd_barrier_post((unsigned*)(ws + WS_CTL) + CW_XBAR, (volatile LAS unsigned*)(c.lds + LDS_BYTES - 16));
#define SEAM(k) do { if (IN(k) && IN((k) + 1)) { if ((k) == 0) grid.sync(); else xcd_barrier(xbar); } } while (0)
#endif
#ifndef DBL_PHASE
#define DBL_PHASE -1
#endif
#define PH(k, ...) if (IN(k)) { __VA_ARGS__; if (DBL_PHASE == (k)) { xcd_barrier(xbar); __VA_ARGS__; } }
    PH(0, phase0(p, c))
    SEAM(0);
    PH(1, { pg8::DenseOrder S; S.init(MTOK, 5376, 1024, c.G, c.bid, ws + WS_XB, ws + WS_WIN_T);
        pg8::EpiInProj E{(bf16*)(ws + WS_PRKV), (bf16*)(ws + WS_PLR), (bf16*)(ws + WS_PQ), (bf16*)(ws + WS_PK), (bf16*)(ws + WS_PAV), (bf16*)(ws + WS_PG)};
        pg8::gemm_phase<pg8::EpiInProj, pg8::DenseOrder, true, true>(c.lds, 1024, S, E); })
    SEAM(1);
    if (IN(2)) phase2(p, c);
    SEAM(2);
    PH(3, { kmean_items(p, c); pg8::DenseOrder S; S.init(MTOK, 1536, 256, c.G, c.bid, ws + WS_ALORA, ws + WS_WLORA_T);
        pg8::EpiPlainBf16 E{(bf16*)(ws + WS_LORA), 1536};
        pg8::gemm_phase<pg8::EpiPlainBf16, pg8::DenseOrder, true, true>(c.lds, 256, S, E); })
    SEAM(3);
    if (IN(5)) {
        for (int rep = 0; rep < (DBL_PHASE == 50 ? 2 : 1); ++rep) { for (int item = c.bid; item < 256; item += c.G) scan_item(p, c, item); }
        for (int rep = (DBL_PHASE == 51 ? 0 : 1); rep < 2; ++rep) {
            bf16* Oout = rep == 0 ? (bf16*)(ws + WS_MERGED) : (bf16*)(ws + WS_PQ);
            for (int v = c.bid; v < 256; v += c.G) { const int bh = v >> 2, s = v & 3;
#pragma unroll 1
                for (int i = 0; i < 4; ++i) { const int qb = (i == 0) ? s : (i == 1) ? 7 - s : (i == 2) ? 8 + s : 15 - s; att::unit(p, c, bh >> 3, bh & 7, qb, Oout); } } }
    }
    SEAM(5);
    PH(6, phase6(p, c))
    SEAM(6);
    PH(7, { pg8::DenseOrder S; S.init(MTOK, 1024, 512, c.G, c.bid, ws + WS_YRWKV, ws + WS_WR_T);
        pg8::EpiGateF32 E{(float*)(ws + WS_TMP), (const bf16*)(ws + WS_PG), 0};
        pg8::gemm_phase<pg8::EpiGateF32, pg8::DenseOrder, true, true>(c.lds, 512, S, E); })
    SEAM(7);
    PH(8, { pg8::DenseOrder S; S.init(MTOK, 1024, 512, c.G, c.bid, ws + WS_PQ, ws + WS_WA_T);
        pg8::EpiGateAddBf16 E{(const float*)(ws + WS_TMP), (const bf16*)(ws + WS_PG), 1024, (bf16*)(ws + WS_MERGED)};
        pg8::gemm_phase<pg8::EpiGateAddBf16, pg8::DenseOrder, true, true>(c.lds, 512, S, E); })
    SEAM(8);
    PH(9, { pg8::DenseOrder S; S.init(MTOK, 1024, 1024, c.G, c.bid, ws + WS_MERGED, ws + WS_WO_T);
        pg8::EpiResF32 E{(float*)(ws + WS_XPRE), p.in[0], DN_ALPHA};
        pg8::gemm_phase<pg8::EpiResF32, pg8::DenseOrder, true, true>(c.lds, 1024, S, E); })
    SEAM(9);
    if (IN(10)) { if (DBL_PHASE == 10) { phase9(p, c, true); } phase9(p, c); }
    SEAM(10);
    if (IN(11)) phase10(p, c);
    SEAM(11);
    PH(12, { const int* ctl = (const int*)(ws + WS_CTL);
        pg8::MoeOrder<true> S{(const int*)(ws + WS_ROWTOK), ctl + CW_TILE_E, ctl[CW_NTILES], 8, c.G, c.bid, (const char*)(ws + WS_X1B), (const char*)(ws + WS_W1T), (size_t)256 * 1024, (size_t)2048 * 1024};
        pg8::EpiSwiglu E{ws + WS_ACT, p.in[23], 1.0f / W1_SCALE};
        pg8::gemm_phase<pg8::EpiSwiglu, pg8::MoeOrder<true>, true, true, 1>(c.lds, 1024, S, E); })
    SEAM(12);
    PH(13, { const int* ctl = (const int*)(ws + WS_CTL);
        pg8::MoeOrder<false> S{nullptr, ctl + CW_TILE_E, ctl[CW_NTILES], 4, c.G, c.bid, (const char*)(ws + WS_ACT), (const char*)(ws + WS_W2T), (size_t)256 * 1024, (size_t)1024 * 1024};
        pg8::EpiMoe2 E{(bf16*)(ws + WS_YBUF), p.in[25], (const float*)(ws + WS_ROWW), 1.0f / W2_SCALE};
        pg8::gemm_phase<pg8::EpiMoe2, pg8::MoeOrder<false>, true, true, 1>(c.lds, 1024, S, E); })
    SEAM(13);
    PH(14, phase14(p, c))
#undef PH
#undef IN
#undef SEAM
}

extern "C" void kernel_launch(void* const* d_in, const int* in_sizes, int n_in, void* d_out, int out_size, void* d_ws, size_t ws_size, hipStream_t stream) {
    static int grid = 0;
    if (grid == 0) {
        if (n_in != 26 || in_sizes[0] != MTOK * DMODEL || out_size != MTOK * DMODEL || ws_size < WS_END) {
            fprintf(stderr, "kernel_launch: unexpected shapes / workspace (n_in %d, in0 %d, out %d, ws %zu, need %zu); nothing launched\n", n_in, n_in > 0 ? in_sizes[0] : -1, out_size, ws_size, (size_t)WS_END); grid = -1; return; }
        int dev = 0, cus = 0, per_cu = 0;
        hipGetDevice(&dev); hipDeviceGetAttribute(&cus, hipDeviceAttributeMultiprocessorCount, dev);
        hipFuncSetAttribute((const void*)fwd_megakernel, hipFuncAttributeMaxDynamicSharedMemorySize, LDS_BYTES);
        hipOccupancyMaxActiveBlocksPerMultiprocessor(&per_cu, (const void*)fwd_megakernel, NTHREADS, LDS_BYTES);
        (void)hipGetLastError();
        if (per_cu < 1) { fprintf(stderr, "kernel_launch: occupancy query says %d blocks per CU\n", per_cu); per_cu = 1; }
        grid = cus;
    }
    if (grid < 0) return;
    hipMemsetAsync((char*)d_ws + WS_CTL, 0, CTL_BYTES, stream);
    Params p{};
    for (int i = 0; i < 26; ++i) p.in[i] = (const float*)d_in[i];
    p.out = (float*)d_out; p.ws = (unsigned char*)d_ws;
#if MK_SPLIT
    for (int ph = 0; ph < NPHASE; ++ph) { p.ph_lo = ph; p.ph_hi = ph + 1; hipLaunchKernelGGL(fwd_megakernel, dim3(grid), dim3(NTHREADS), LDS_BYTES, stream, p); }
#else
    p.ph_lo = 0; p.ph_hi = NPHASE;
    void* args[] = {&p};
    hipError_t e = hipLaunchCooperativeKernel((const void*)fwd_megakernel, dim3(grid), dim3(NTHREADS), args, LDS_BYTES, stream);
    if (e != hipSuccess) fprintf(stderr, "cooperative launch failed: %s (grid %d)\n", hipGetErrorString(e), grid);
#endif
}
```

```cpp
#include <hip/hip_runtime.h>
#include <hip/hip_cooperative_groups.h>
#include <cstdio>
#include <cstdint>
namespace cg = cooperative_groups;

namespace pg8 {
#define PG8_LAS __attribute__((address_space(3)))
typedef unsigned short bf16_t;
typedef short bf16x8 __attribute__((ext_vector_type(8)));
typedef float f32x4 __attribute__((ext_vector_type(4)));
typedef float f32x2 __attribute__((ext_vector_type(2)));
typedef unsigned u32x4 __attribute__((ext_vector_type(4)));
typedef unsigned u32x2 __attribute__((ext_vector_type(2)));
typedef int i32x4 __attribute__((ext_vector_type(4)));
typedef int i32x8 __attribute__((ext_vector_type(8)));
constexpr int BM = 256, BK = 64, HALF = 128, HTB = HALF * BK * 2  , STAGE_BYTES = 8 * HTB, NXCD = 8, WGM = 8;

__host__ __device__ __forceinline__ int lds_byte(int r, int c) { const int st = (r >> 4) * 2 + (c >> 5), rr = r & 15, cc = c & 31, ob = rr * 64 + cc * 2; return st * 1024 + (ob ^ (((ob >> 9) & 1) << 5)); }
__host__ __device__ __forceinline__ void stage_rc(int b, int& R, int& C) { const int st = b / 1024, sb = b % 1024, swz = sb ^ (((sb >> 9) & 1) << 5); R = (st >> 1) * 16 + swz / 64; C = (st & 1) * 32 + (swz % 64) / 2; }
__host__ __device__ __forceinline__ int perm32(int rho) { const int n = rho >> 4, i = rho & 15; return 8 * (i >> 2) + 4 * n + (i & 3); }

struct Unit { int pm, pn, aux; const char* A; const char* B; };

struct DenseOrder {
    static constexpr bool GATHER = false; const int* rowmap;
    int nM, nN, nwg, G, c; const char* A; const char* B; size_t tstep;
    __device__ __forceinline__ void init(int M, int N, int K, int G_, int c_, const void* A_, const void* B_) { nM = M / BM; nN = N / BM; nwg = nM * nN; G = G_; c = c_; A = (const char*)A_; B = (const char*)B_; tstep = (size_t)BM * K * 2; }
    __device__ __forceinline__ bool next(int i, Unit& u) const {
        const long L = (long)i * G + c; if (L >= nwg) return false;
        int wgid = (int)L; { const int q = nwg / NXCD, r = nwg % NXCD, xcd = wgid % NXCD, off = wgid / NXCD; wgid = (xcd < r ? xcd * (q + 1) : r * (q + 1) + (xcd - r) * q) + off; }
        const int nig = WGM * nN, gid = wgid / nig, fm = gid * WGM, gsz = (nM - fm) < WGM ? (nM - fm) : WGM;
        u.pm = fm + ((wgid % nig) % gsz); u.pn = (wgid % nig) / gsz; u.aux = 0;
        u.A = A + (size_t)u.pm * tstep; u.B = B + (size_t)u.pn * tstep; return true;
    }
    __device__ __forceinline__ void a_ready(const Unit&) const {}
    __device__ __forceinline__ void done(const Unit&) const {}
};
template <bool GATHER_> struct MoeOrder {
    static constexpr bool GATHER = GATHER_; const int* rowmap;
    const int* tile_e; int ntiles, npn, G, c; const char* A; const char* B; size_t tstep, estride;
    __device__ __forceinline__ bool next(int i, Unit& u) const {
        const long L = (long)i * G + c; if (L >= (long)ntiles * npn) return false;
        const int tile = (int)(L / npn), pn = (int)(L % npn); const int e = tile_e[tile];
        u.pm = tile; u.pn = pn; u.aux = e; u.A = GATHER_ ? A : A + (size_t)tile * tstep; u.B = B + (size_t)e * estride + (size_t)pn * tstep; return true;
    }
    __device__ __forceinline__ void a_ready(const Unit&) const {}
    __device__ __forceinline__ void done(const Unit&) const {}
};

__device__ __forceinline__ unsigned cvt_pk_bf16(float lo, float hi) { unsigned r; asm volatile("v_cvt_pk_bf16_f32 %0, %1, %2" : "=v"(r) : "v"(lo), "v"(hi)); return r; }
__device__ __forceinline__ float bf_lo(unsigned w) { return __builtin_bit_cast(float, w << 16); }
__device__ __forceinline__ float bf_hi(unsigned w) { return __builtin_bit_cast(float, w & 0xffff0000u); }
__device__ __forceinline__ float sigm(float x) { return 1.0f / (1.0f + __expf(-x)); }

__device__ __forceinline__ void st8(bf16_t* p, f32x4 v0, f32x4 v1) { u32x4 w; w.x = cvt_pk_bf16(v0[0], v0[1]); w.y = cvt_pk_bf16(v0[2], v0[3]); w.z = cvt_pk_bf16(v1[0], v1[1]); w.w = cvt_pk_bf16(v1[2], v1[3]); *(u32x4*)p = w; }

struct EpiPlainBf16 {
    static constexpr bool PERM = true, AFTER_DRAIN = false;
    bf16_t* O; int ldc;
    __device__ __forceinline__ void operator()(const f32x4 (&acc)[2][2][4][2], const Unit& u, int wr, int wc, int fr, int fq) const {
        const int row0 = u.pm * BM + wr * 64 + fr, col0 = u.pn * BM + wc * 32 + 8 * fq;
#pragma unroll
        for (int ai = 0; ai < 2; ++ai)
#pragma unroll
            for (int m = 0; m < 4; ++m) { bf16_t* rowp = O + (size_t)(row0 + ai * HALF + m * 16) * ldc + col0;
#pragma unroll
                for (int bj = 0; bj < 2; ++bj) st8(rowp + bj * HALF, acc[ai][bj][m][0], acc[ai][bj][m][1]); }
    }
};
struct EpiInProj {
    static constexpr bool PERM = true, AFTER_DRAIN = false;
    bf16_t *rkv, *lr, *q, *k, *v, *g;
    __device__ __forceinline__ void operator()(const f32x4 (&acc)[2][2][4][2], const Unit& u, int wr, int wc, int fr, int fq) const {
        const int pn = u.pn; bf16_t* base; int ldc, colt;
        if (pn < 6) { base = rkv; ldc = 1536; colt = pn * 256; } else if (pn == 6) { base = lr; ldc = 256; colt = 0; }
        else if (pn < 9) { base = q; ldc = 512; colt = (pn - 7) * 256; } else if (pn < 11) { base = k; ldc = 512; colt = (pn - 9) * 256; }
        else if (pn < 13) { base = v; ldc = 512; colt = (pn - 11) * 256; } else { base = g; ldc = 2048; colt = (pn - 13) * 256; }
        const int row0 = u.pm * BM + wr * 64 + fr, col0 = colt + wc * 32 + 8 * fq;
#pragma unroll
        for (int ai = 0; ai < 2; ++ai)
#pragma unroll
            for (int m = 0; m < 4; ++m) { bf16_t* rowp = base + (size_t)(row0 + ai * HALF + m * 16) * ldc + col0;
#pragma unroll
                for (int bj = 0; bj < 2; ++bj) st8(rowp + bj * HALF, acc[ai][bj][m][0], acc[ai][bj][m][1]); }
    }
};
struct EpiGateF32 {
    static constexpr bool PERM = true, AFTER_DRAIN = false;
    float* T; const bf16_t* G; int goff;
    __device__ __forceinline__ void operator()(const f32x4 (&acc)[2][2][4][2], const Unit& u, int wr, int wc, int fr, int fq) const {
        const int row0 = u.pm * BM + wr * 64 + fr, col0 = u.pn * BM + wc * 32 + 8 * fq;
#pragma unroll
        for (int ai = 0; ai < 2; ++ai)
#pragma unroll
            for (int m = 0; m < 4; ++m) { const size_t row = (size_t)(row0 + ai * HALF + m * 16);
#pragma unroll
                for (int bj = 0; bj < 2; ++bj) { const int col = col0 + bj * HALF; const u32x4 gw = *(const u32x4*)(G + row * 2048 + goff + col);
                    f32x4 a = acc[ai][bj][m][0], b = acc[ai][bj][m][1];
                    a[0] *= sigm(bf_lo(gw.x)); a[1] *= sigm(bf_hi(gw.x)); a[2] *= sigm(bf_lo(gw.y)); a[3] *= sigm(bf_hi(gw.y));
                    b[0] *= sigm(bf_lo(gw.z)); b[1] *= sigm(bf_hi(gw.z)); b[2] *= sigm(bf_lo(gw.w)); b[3] *= sigm(bf_hi(gw.w));
                    *(f32x4*)(T + row * 1024 + col) = a; *(f32x4*)(T + row * 1024 + col + 4) = b; } }
    }
};
struct EpiGateAddBf16 {
    static constexpr bool PERM = true, AFTER_DRAIN = false;
    const float* T; const bf16_t* G; int goff; bf16_t* O;
    __device__ __forceinline__ void operator()(const f32x4 (&acc)[2][2][4][2], const Unit& u, int wr, int wc, int fr, int fq) const {
        const int row0 = u.pm * BM + wr * 64 + fr, col0 = u.pn * BM + wc * 32 + 8 * fq;
#pragma unroll
        for (int ai = 0; ai < 2; ++ai)
#pragma unroll
            for (int m = 0; m < 4; ++m) { const size_t row = (size_t)(row0 + ai * HALF + m * 16);
#pragma unroll
                for (int bj = 0; bj < 2; ++bj) { const int col = col0 + bj * HALF; const u32x4 gw = *(const u32x4*)(G + row * 2048 + goff + col);
                    f32x4 a = acc[ai][bj][m][0], b = acc[ai][bj][m][1]; const f32x4 ta = *(const f32x4*)(T + row * 1024 + col), tb = *(const f32x4*)(T + row * 1024 + col + 4);
                    a[0] = ta[0] + a[0] * sigm(bf_lo(gw.x)); a[1] = ta[1] + a[1] * sigm(bf_hi(gw.x)); a[2] = ta[2] + a[2] * sigm(bf_lo(gw.y)); a[3] = ta[3] + a[3] * sigm(bf_hi(gw.y));
                    b[0] = tb[0] + b[0] * sigm(bf_lo(gw.z)); b[1] = tb[1] + b[1] * sigm(bf_hi(gw.z)); b[2] = tb[2] + b[2] * sigm(bf_lo(gw.w)); b[3] = tb[3] + b[3] * sigm(bf_hi(gw.w));
                    st8(O + row * 1024 + col, a, b); } }
    }
};
struct EpiResF32 {
    static constexpr bool PERM = false, AFTER_DRAIN = false;
    float* C; const float* X; float alpha;
    __device__ __forceinline__ void operator()(const f32x4 (&acc)[2][2][4][2], const Unit& u, int wr, int wc, int fr, int fq) const {
        const int row0 = u.pm * BM + wr * 64 + fr, col0 = u.pn * BM + wc * 32 + 4 * fq;
#pragma unroll
        for (int ai = 0; ai < 2; ++ai)
#pragma unroll
            for (int m = 0; m < 4; ++m) { const size_t off = (size_t)(row0 + ai * HALF + m * 16) * 1024 + col0;
#pragma unroll
                for (int bj = 0; bj < 2; ++bj)
#pragma unroll
                    for (int n = 0; n < 2; ++n) { const f32x4 xv = *(const f32x4*)(X + off + bj * HALF + n * 16); *(f32x4*)(C + off + bj * HALF + n * 16) = acc[ai][bj][m][n] + xv * alpha; } }
    }
};
__device__ __forceinline__ unsigned pk4_fp8(float a, float b, float c, float d) { int w = 0; w = __builtin_amdgcn_cvt_pk_fp8_f32(a, b, w, false); w = __builtin_amdgcn_cvt_pk_fp8_f32(c, d, w, true); return (unsigned)w; }
struct EpiSwiglu {
    static constexpr bool PERM = true, AFTER_DRAIN = false;
    unsigned char* O; const float* bin; float sc;
    __device__ __forceinline__ void operator()(const f32x4 (&acc)[2][2][4][2], const Unit& u, int wr, int wc, int fr, int fq) const {
        const int row0 = u.pm * BM + wr * 64 + fr, c0 = u.pn * HALF + wc * 32 + 8 * fq; const float* bb = bin + (size_t)u.aux * 2048 + c0;
        const f32x4 bg0 = *(const f32x4*)(bb), bg1 = *(const f32x4*)(bb + 4), bl0 = *(const f32x4*)(bb + 1024), bl1 = *(const f32x4*)(bb + 1028);
#pragma unroll
        for (int ai = 0; ai < 2; ++ai)
#pragma unroll
            for (int m = 0; m < 4; ++m) { const size_t row = (size_t)(row0 + ai * HALF + m * 16);
                f32x4 o0, o1; const f32x4 g0 = acc[ai][0][m][0] * sc + bg0, g1 = acc[ai][0][m][1] * sc + bg1, l0 = acc[ai][1][m][0] * sc + bl0, l1 = acc[ai][1][m][1] * sc + bl1;
#pragma unroll
                for (int j = 0; j < 4; ++j) { const float ga = fminf(g0[j], 7.0f), la = fminf(fmaxf(l0[j], -7.0f), 7.0f); o0[j] = ga * sigm(1.702f * ga) * (la + 1.0f);
                                              const float gb = fminf(g1[j], 7.0f), lb = fminf(fmaxf(l1[j], -7.0f), 7.0f); o1[j] = gb * sigm(1.702f * gb) * (lb + 1.0f); }
                u32x2 w; w.x = pk4_fp8(o0[0], o0[1], o0[2], o0[3]); w.y = pk4_fp8(o1[0], o1[1], o1[2], o1[3]); *(u32x2*)(O + row * 1024 + c0) = w; }
    }
};
struct EpiMoe2 {
    static constexpr bool PERM = true, AFTER_DRAIN = false;
    bf16_t* O; const float* bout; const float* roww; float sc;
    __device__ __forceinline__ void operator()(const f32x4 (&acc)[2][2][4][2], const Unit& u, int wr, int wc, int fr, int fq) const {
        const int row0 = u.pm * BM + wr * 64 + fr, col0 = u.pn * BM + wc * 32 + 8 * fq; const float* bb = bout + (size_t)u.aux * 1024 + col0;
        f32x4 bv[2][2];
#pragma unroll
        for (int bj = 0; bj < 2; ++bj) { bv[bj][0] = *(const f32x4*)(bb + bj * HALF); bv[bj][1] = *(const f32x4*)(bb + bj * HALF + 4); }
#pragma unroll
        for (int ai = 0; ai < 2; ++ai)
#pragma unroll
            for (int m = 0; m < 4; ++m) { const size_t row = (size_t)(row0 + ai * HALF + m * 16); const float w = roww[row];
#pragma unroll
                for (int bj = 0; bj < 2; ++bj) st8(O + row * 1024 + col0 + bj * HALF, (acc[ai][bj][m][0] * sc + bv[bj][0]) * w, (acc[ai][bj][m][1] * sc + bv[bj][1]) * w); }
    }
};

template <class Epi, class Sched, bool ALIGN_EPI = false, bool SP2 = false, int ESZ = 2  >
__device__ __forceinline__ void gemm_phase(PG8_LAS unsigned char* lds, const int K, const Sched& S, const Epi& E) {
    const int tid = threadIdx.x, wid = __builtin_amdgcn_readfirstlane(tid >> 6), lane = tid & 63, wr = wid >> 2, wc = wid & 3, fr = lane & 15, fq = lane >> 4;
    const int nt = K * ESZ / (BK * 2);
    unsigned vA0[2], vA1[2], nvA0[2], nvA1[2], voffB[2];
#pragma unroll
    for (int i = 0; i < 2; ++i) { int R, C; stage_rc(tid * 16 + i * 8192, R, C); const int Rb = Epi::PERM ? ((R & ~31) + perm32(R & 31)) : R;
        vA0[i] = (unsigned)(R * K * ESZ + C * 2); vA1[i] = 0u; nvA0[i] = 0u; nvA1[i] = 0u; voffB[i] = (unsigned)(Rb * K * ESZ + C * 2); }
    const size_t kstep = (size_t)(BK * 2);
    const size_t hstep = (size_t)HALF * K * ESZ;
    const unsigned ldsw = (unsigned)wid * 1024u;
    const int ac0 = ESZ == 2 ? fq * 8 : (fq >> 1) * 32 + (fq & 1) * 16, ac1 = ESZ == 2 ? 32 + fq * 8 : ac0 + 8;
    const int aoffk[2] = {lds_byte(wr * 64 + fr, ac0), lds_byte(wr * 64 + fr, ac1)}, boffk[2] = {lds_byte(wc * 32 + fr, ac0), lds_byte(wc * 32 + fr, ac1)};
#define PG8_SA(b, h) (((b) * 2 + (h)) * HTB)
#define PG8_SB(b, h) ((4 + (b) * 2 + (h)) * HTB)
#define PG8_STAGE(bufoff, gbase, voff) do { _Pragma("unroll") for (int _i = 0; _i < 2; ++_i) \
        __builtin_amdgcn_global_load_lds((const unsigned*)((const char*)(gbase) + (voff)[_i]), (PG8_LAS unsigned*)(lds + (bufoff) + ldsw + _i * 8192), 16, 0, 0); } while (0)
#define PG8_STAGE_A(bufoff, gbase, hf, nx) do { if constexpr (!Sched::GATHER) { PG8_STAGE(bufoff, (gbase) + (hf) * hstep, vA0); } \
        else { if (hf) { PG8_STAGE(bufoff, gbase, vA1); } else { PG8_STAGE(bufoff, gbase, vA0); } } } while (0)
#define PG8_STAGE_AN(bufoff, gbase, hf) do { if constexpr (!Sched::GATHER) { PG8_STAGE(bufoff, (gbase) + (hf) * hstep, vA0); } \
        else { if (hf) { PG8_STAGE(bufoff, gbase, wA1); } else { PG8_STAGE(bufoff, gbase, wA0); } } } while (0)
#define PG8_LDA(dst, b, h) do { _Pragma("unroll") for (int m = 0; m < 4; ++m) { if constexpr (ESZ == 2) { _Pragma("unroll") for (int k = 0; k < 2; ++k) dst[m][k] = *(const PG8_LAS bf16x8*)(lds + PG8_SA(b, h) + aoffk[k] + m * 2048); } \
        else { const i32x4 lo_ = *(const PG8_LAS i32x4*)(lds + PG8_SA(b, h) + aoffk[0] + m * 2048), hi_ = *(const PG8_LAS i32x4*)(lds + PG8_SA(b, h) + aoffk[1] + m * 2048); \
               dst##8[m] = (i32x8){lo_[0], lo_[1], lo_[2], lo_[3], hi_[0], hi_[1], hi_[2], hi_[3]}; } } } while (0)
#define PG8_LDB(dst, b, h) do { _Pragma("unroll") for (int n = 0; n < 2; ++n) { if constexpr (ESZ == 2) { _Pragma("unroll") for (int k = 0; k < 2; ++k) dst[n][k] = *(const PG8_LAS bf16x8*)(lds + PG8_SB(b, h) + boffk[k] + n * 2048); } \
        else { const i32x4 lo_ = *(const PG8_LAS i32x4*)(lds + PG8_SB(b, h) + boffk[0] + n * 2048), hi_ = *(const PG8_LAS i32x4*)(lds + PG8_SB(b, h) + boffk[1] + n * 2048); \
               dst##8[n] = (i32x8){lo_[0], lo_[1], lo_[2], lo_[3], hi_[0], hi_[1], hi_[2], hi_[3]}; } } } while (0)
#define PG8_MMA(ai, bj, At, Bt) do { __builtin_amdgcn_s_setprio(1); _Pragma("unroll") for (int m = 0; m < 4; ++m) _Pragma("unroll") for (int n = 0; n < 2; ++n) { \
        if constexpr (ESZ == 2) { _Pragma("unroll") for (int k = 0; k < 2; ++k) acc[ai][bj][m][n] = __builtin_amdgcn_mfma_f32_16x16x32_bf16(Bt[n][k], At[m][k], acc[ai][bj][m][n], 0, 0, 0); } \
        else { asm volatile("v_mfma_scale_f32_16x16x128_f8f6f4 %0, %1, %2, %0, %3, %3 op_sel_hi:[0,0,0]" : "+v"(acc[ai][bj][m][n]) : "v"(Bt##8[n]), "v"(At##8[m]), "v"(scale1)); } } \
        __builtin_amdgcn_s_setprio(0); } while (0)
#define PG8_WAIT_V(n) asm volatile("s_waitcnt vmcnt(" #n ")" ::: "memory")
#define PG8_WAIT_L(n) asm volatile("s_waitcnt lgkmcnt(" #n ")" ::: "memory")
#define PG8_BAR __builtin_amdgcn_s_barrier()
#define PG8_SCHED __builtin_amdgcn_sched_barrier(0)
    Unit cur, nxt; int ui = 0;
    if (!S.next(0, cur)) return;
    if constexpr (Sched::GATHER) {
#pragma unroll
        for (int i = 0; i < 2; ++i) { int R, C; stage_rc(tid * 16 + i * 8192, R, C); vA0[i] = (unsigned)S.rowmap[cur.pm * BM + R] * (unsigned)(K * ESZ) + (unsigned)C * 2u; vA1[i] = (unsigned)S.rowmap[cur.pm * BM + HALF + R] * (unsigned)(K * ESZ) + (unsigned)C * 2u; nvA0[i] = vA0[i]; nvA1[i] = vA1[i]; }
    }
    f32x4 acc[2][2][4][2];
#pragma unroll
    for (int a = 0; a < 2; ++a)
#pragma unroll
        for (int b = 0; b < 2; ++b)
#pragma unroll
            for (int m = 0; m < 4; ++m)
#pragma unroll
                for (int n = 0; n < 2; ++n) acc[a][b][m][n] = (f32x4){0.f, 0.f, 0.f, 0.f};
    const int scale1 = 0x7F7F7F7F;
    bf16x8 At[4][2], B0[2][2], B1[2][2]; i32x8 At8[4], B08[2], B18[2];
    const char* cA = cur.A; const char* cB = cur.B;
    S.a_ready(cur);
    if constexpr (SP2) {
        PG8_STAGE(PG8_SB(0, 0), cB, voffB); PG8_STAGE(PG8_SB(0, 1), cB + hstep, voffB); PG8_STAGE_A(PG8_SA(0, 0), cA, 0, 0); PG8_STAGE_A(PG8_SA(0, 1), cA, 1, 0);
        if (wr == 1) PG8_BAR;
        PG8_WAIT_V(2); PG8_BAR;
        PG8_STAGE(PG8_SB(1, 0), cB + kstep, voffB); PG8_STAGE_A(PG8_SA(1, 0), cA + kstep, 0, 0); PG8_STAGE(PG8_SB(1, 1), cB + hstep + kstep, voffB);
        PG8_WAIT_V(6); PG8_BAR;
    } else {
        PG8_STAGE(PG8_SB(0, 0), cB, voffB); PG8_STAGE_A(PG8_SA(0, 0), cA, 0, 0); PG8_STAGE(PG8_SB(0, 1), cB + hstep, voffB); PG8_STAGE_A(PG8_SA(0, 1), cA, 1, 0);
        if (wr == 1) PG8_BAR;
        PG8_WAIT_V(4); PG8_BAR;
        PG8_STAGE(PG8_SB(1, 0), cB + kstep, voffB); PG8_STAGE_A(PG8_SA(1, 0), cA + kstep, 0, 0); PG8_STAGE(PG8_SB(1, 1), cB + hstep + kstep, voffB);
        PG8_WAIT_V(6); PG8_BAR;
    }
    for (;;) {
        const bool has_next = S.next(ui + 1, nxt);
        const char* nA = has_next ? nxt.A : cA; const char* nB = has_next ? nxt.B : cB;
        if constexpr (Sched::GATHER) { if (has_next) {
#pragma unroll
            for (int i = 0; i < 2; ++i) { int R, C; stage_rc(tid * 16 + i * 8192, R, C); nvA0[i] = (unsigned)S.rowmap[nxt.pm * BM + R] * (unsigned)(K * ESZ) + (unsigned)C * 2u; nvA1[i] = (unsigned)S.rowmap[nxt.pm * BM + HALF + R] * (unsigned)(K * ESZ) + (unsigned)C * 2u; } } }
#pragma unroll 1
        for (int t = 0; t < nt; t += 2) {
            const bool last = (t == nt - 2);
            const char* a1 = cA + (size_t)(t + 1) * kstep;
            const char* a2 = last ? nA : cA + (size_t)(t + 2) * kstep; const char* b2 = last ? nB : cB + (size_t)(t + 2) * kstep;
            const char* a3 = a2 + kstep; const char* b3 = b2 + kstep;
            if (last && has_next) S.a_ready(nxt);
            unsigned wA0[2] = {vA0[0], vA0[1]}, wA1[2] = {vA1[0], vA1[1]}; (void)wA0; (void)wA1;
            if constexpr (Sched::GATHER) { if (last) { asm volatile("" : "+v"(nvA0[0]), "+v"(nvA0[1]), "+v"(nvA1[0]), "+v"(nvA1[1])); wA0[0] = nvA0[0]; wA0[1] = nvA0[1]; wA1[0] = nvA1[0]; wA1[1] = nvA1[1]; } }
            if constexpr (SP2) {
            PG8_LDB(B0, 0, 0); PG8_LDB(B1, 0, 1); PG8_SCHED; PG8_LDA(At, 0, 0); PG8_STAGE_A(PG8_SA(1, 1), a1, 1, 0);
            PG8_WAIT_V(8); PG8_WAIT_L(0); PG8_BAR; PG8_MMA(0, 0, At, B0); PG8_MMA(0, 1, At, B1); PG8_BAR; PG8_SCHED;
            PG8_LDA(At, 0, 1); PG8_STAGE(PG8_SB(0, 0), b2, voffB); PG8_STAGE(PG8_SB(0, 1), b2 + hstep, voffB); PG8_STAGE_AN(PG8_SA(0, 0), a2, 0);
            PG8_WAIT_V(8); PG8_WAIT_L(0); PG8_BAR; PG8_MMA(1, 0, At, B0); PG8_MMA(1, 1, At, B1); PG8_BAR; PG8_SCHED;
            PG8_LDB(B0, 1, 0); PG8_LDB(B1, 1, 1); PG8_SCHED; PG8_LDA(At, 1, 0); PG8_STAGE_AN(PG8_SA(0, 1), a2, 1);
            PG8_WAIT_V(8); PG8_WAIT_L(0); PG8_BAR; PG8_MMA(0, 0, At, B0); PG8_MMA(0, 1, At, B1); PG8_BAR; PG8_SCHED;
            PG8_LDA(At, 1, 1); PG8_STAGE(PG8_SB(1, 0), b3, voffB); PG8_STAGE(PG8_SB(1, 1), b3 + hstep, voffB); PG8_STAGE_AN(PG8_SA(1, 0), a3, 0);
            PG8_WAIT_V(8); PG8_WAIT_L(0); PG8_BAR; PG8_MMA(1, 0, At, B0); PG8_MMA(1, 1, At, B1); PG8_BAR; PG8_SCHED;
            } else {
            PG8_LDB(B0, 0, 0); PG8_SCHED; PG8_LDA(At, 0, 0); PG8_STAGE_A(PG8_SA(1, 1), a1, 1, 0);
            PG8_WAIT_L(8); PG8_BAR; PG8_WAIT_L(0); PG8_MMA(0, 0, At, B0); PG8_BAR; PG8_SCHED;
            PG8_LDB(B1, 0, 1); PG8_STAGE(PG8_SB(0, 0), b2, voffB);
            PG8_BAR; PG8_WAIT_L(0); PG8_MMA(0, 1, At, B1); PG8_BAR;
            PG8_LDA(At, 0, 1); PG8_STAGE_AN(PG8_SA(0, 0), a2, 0);
            PG8_BAR; PG8_WAIT_L(0); PG8_MMA(1, 0, At, B0); PG8_BAR; PG8_SCHED;
            PG8_STAGE(PG8_SB(0, 1), b2 + hstep, voffB);
            PG8_WAIT_V(6); PG8_BAR; PG8_MMA(1, 1, At, B1); PG8_BAR;
            PG8_LDB(B0, 1, 0); PG8_SCHED; PG8_LDA(At, 1, 0); PG8_STAGE_AN(PG8_SA(0, 1), a2, 1);
            PG8_WAIT_L(8); PG8_BAR; PG8_WAIT_L(0); PG8_MMA(0, 0, At, B0); PG8_BAR; PG8_SCHED;
            PG8_LDB(B1, 1, 1); PG8_STAGE(PG8_SB(1, 0), b3, voffB);
            PG8_BAR; PG8_WAIT_L(0); PG8_MMA(0, 1, At, B1); PG8_BAR;
            PG8_LDA(At, 1, 1); PG8_STAGE_AN(PG8_SA(1, 0), a3, 0);
            PG8_BAR; PG8_WAIT_L(0); PG8_MMA(1, 0, At, B0); PG8_BAR; PG8_SCHED;
            PG8_STAGE(PG8_SB(1, 1), b3 + hstep, voffB);
            PG8_WAIT_V(6); PG8_BAR; PG8_MMA(1, 1, At, B1); PG8_BAR;
            }
        }
        if constexpr (ALIGN_EPI) { if (wr == 0) PG8_BAR; }
        if constexpr (ESZ == 1) asm volatile("s_nop 15\n\ts_nop 15" ::: "memory");
        if constexpr (!Epi::AFTER_DRAIN) { E(acc, cur, wr, wc, fr, fq); S.done(cur); }
        if (!has_next) break;
#pragma unroll
        for (int a = 0; a < 2; ++a)
#pragma unroll
            for (int b = 0; b < 2; ++b)
#pragma unroll
                for (int m = 0; m < 4; ++m)
#pragma unroll
                    for (int n = 0; n < 2; ++n) acc[a][b][m][n] = (f32x4){0.f, 0.f, 0.f, 0.f};
        cur = nxt; cA = nA; cB = nB; ++ui;
        if constexpr (Sched::GATHER) { vA0[0] = nvA0[0]; vA0[1] = nvA0[1]; vA1[0] = nvA1[0]; vA1[1] = nvA1[1]; }
        if constexpr (ALIGN_EPI) { if (wr == 1) PG8_BAR; }
    }
    PG8_WAIT_V(0);
    if constexpr (!ALIGN_EPI) { if (wr == 0) PG8_BAR; }
    PG8_BAR;
    if constexpr (Epi::AFTER_DRAIN) { E.fused(acc, cur, wr, wc, fr, fq, lds, wid, lane); S.done(cur); }
#undef PG8_SA
#undef PG8_SB
#undef PG8_STAGE
#undef PG8_STAGE_A
#undef PG8_STAGE_AN
#undef PG8_LDA
#undef PG8_LDB
#undef PG8_MMA
#undef PG8_WAIT_V
#undef PG8_WAIT_L
#undef PG8_BAR
#undef PG8_SCHED
}
}


#define LAS __attribute__((address_space(3)))
typedef unsigned short bf16;
typedef float f32x4 __attribute__((ext_vector_type(4)));
typedef float f32x2 __attribute__((ext_vector_type(2)));
typedef float f32x16 __attribute__((ext_vector_type(16)));
typedef unsigned u32x4 __attribute__((ext_vector_type(4)));
typedef unsigned u32x2 __attribute__((ext_vector_type(2)));
typedef short bf16x8 __attribute__((ext_vector_type(8)));
typedef short s16x4 __attribute__((ext_vector_type(4)));

constexpr int NB = 8, SEQ = 4096, DMODEL = 1024, MTOK = NB * SEQ, NHEAD = 8, HDIM = 64, BRD = 512;
constexpr int NEXP = 32, TOPK = 4, MAXTILES = 544, MAXSLOTS = MAXTILES * 256;
constexpr float DN_ALPHA = 1.189207115002721f, LN_EPS = 1e-5f, GN_EPS = 64e-5f;
constexpr int NWAVES = 8, NTHREADS = 512;
constexpr float W1_SCALE = 32.0f, W2_SCALE = 64.0f;
constexpr int LDS_BYTES = 155648;

constexpr size_t MiB = 1u << 20;
constexpr size_t WS_CTL = 0, CTL_BYTES = 128 * 1024;
constexpr size_t WS_WIN_T = 1 * MiB, WS_WLORA_T = 12 * MiB, WS_WR_T = 13 * MiB, WS_WA_T = 14 * MiB, WS_WO_T = 15 * MiB, WS_W1T = 17 * MiB, WS_W2T = 145 * MiB;
constexpr size_t WS_KMEAN = 209 * MiB, WS_ROPE = 209 * MiB + 512 * 1024, WS_TOKE = 210 * MiB, WS_TOKW = 210 * MiB + 512 * 1024, WS_SLOTOF = 211 * MiB, WS_ROWTOK = 212 * MiB, WS_ROWW = 213 * MiB, WS_INVN = 214 * MiB;
constexpr size_t WS_D = 216 * MiB;
constexpr size_t WS_PG = WS_D, WS_PQ = WS_D + 128 * MiB, WS_PK = WS_D + 160 * MiB, WS_PAV = WS_D + 192 * MiB, WS_PRKV = WS_D + 224 * MiB, WS_PLR = WS_D + 320 * MiB;
constexpr size_t WS_LORA = WS_D + 320 * MiB, WS_ALORA = WS_D + 416 * MiB, WS_XB = WS_D + 432 * MiB, WS_BONUS = WS_D + 416 * MiB;
constexpr size_t WS_YRAW = WS_D + 480 * MiB, WS_YRWKV = WS_D + 544 * MiB, WS_SCANOP = WS_D + 544 * MiB  , WS_TMP = WS_D + 416 * MiB, WS_MERGED = WS_D + 544 * MiB, WS_XPRE = WS_D + 608 * MiB;
constexpr size_t WS_X1 = WS_D, WS_X1B = WS_D + 128 * MiB, WS_XPERM = WS_D + 192 * MiB, WS_ACT = WS_D + 464 * MiB, WS_YBUF = WS_D + 192 * MiB;
constexpr size_t WS_END = WS_D + 800 * MiB;
constexpr int CW_COUNT = 0, CW_NTILES = 64, CW_TILE_E = 128, CW_WGBASE = 1024, CW_XBAR = 16384, CW_ATTQ = 96;

struct Params { const float* in[26]; float* out; unsigned char* ws; int ph_lo, ph_hi; };
struct Ctx { LAS unsigned char* lds; int tid, lane, wave, gw, ngw, G, bid; };
#ifndef PROBE_ID
#define PROBE_ID 0
#endif
constexpr int CW_PROBE = 100;
#define PROBE_T0(id) unsigned long long _pt##id = 0; if (PROBE_ID == (id) && blockIdx.x == 0 && threadIdx.x == 0) _pt##id = __builtin_amdgcn_s_memrealtime()
#define PROBE_T1(id, ws_) do { if (PROBE_ID == (id) && blockIdx.x == 0 && threadIdx.x == 0) { const unsigned long long _d = __builtin_amdgcn_s_memrealtime() - _pt##id; atomicAdd((unsigned*)((ws_) + WS_CTL) + CW_PROBE, (unsigned)_d); } } while (0)

__device__ __forceinline__ unsigned f2bf(float f) { unsigned u = __builtin_bit_cast(unsigned, f); return (u + 0x7fffu + ((u >> 16) & 1u)) >> 16; }
__device__ __forceinline__ unsigned pk2(float lo, float hi) { return f2bf(lo) | (f2bf(hi) << 16); }
__device__ __forceinline__ float bf2f(bf16 v) { return __builtin_bit_cast(float, (unsigned)v << 16); }
__device__ __forceinline__ float bflo(unsigned w) { return __builtin_bit_cast(float, w << 16); }
__device__ __forceinline__ float bfhi(unsigned w) { return __builtin_bit_cast(float, w & 0xffff0000u); }
__device__ __forceinline__ float wave_sum(float v) {
#pragma unroll
    for (int o = 1; o < 64; o <<= 1) v += __shfl_xor(v, o);
    return v;
}
__device__ __forceinline__ float sigmf(float x) { return 1.0f / (1.0f + __expf(-x)); }
template <int CTRL> __device__ __forceinline__ float dppf(float x) { return __builtin_bit_cast(float, __builtin_amdgcn_update_dpp(0, __builtin_bit_cast(int, x), CTRL, 0xF, 0xF, true)); }
__device__ __forceinline__ float row16_sum(float x) {
    x += dppf<0xB1>(x);
    x += dppf<0x4E>(x);
    x += dppf<0x141>(x);
    x += dppf<0x140>(x);
    return x;
}
__device__ __forceinline__ float sum8(float x) { x += dppf<0xB1>(x); x += dppf<0x4E>(x); x += dppf<0x141>(x); return x; }

__device__ __forceinline__ void transpose_item(const float* W, int K, int N, bf16* WT, int k0, int n0, int dst_row0, LAS float* scr, int lane) {
#pragma unroll 8
    for (int i = 0; i < 32; ++i) { const int kk = 2 * i + (lane >> 5); scr[kk * 33 + (lane & 31)] = W[(size_t)(k0 + kk) * N + n0 + (lane & 31)]; }
    asm volatile("s_waitcnt lgkmcnt(0)" ::: "memory");
    const int c = lane & 7;
#pragma unroll
    for (int j = 0; j < 4; ++j) { const int n = (lane >> 3) + 8 * j; const LAS float* s = scr + (8 * c) * 33 + n;
        u32x4 o; o.x = pk2(s[0 * 33], s[1 * 33]); o.y = pk2(s[2 * 33], s[3 * 33]); o.z = pk2(s[4 * 33], s[5 * 33]); o.w = pk2(s[6 * 33], s[7 * 33]);
        *(u32x4*)(WT + (size_t)(dst_row0 + n) * K + k0 + 8 * c) = o; }
    asm volatile("s_waitcnt lgkmcnt(0)" ::: "memory");
}
__device__ __forceinline__ unsigned pk4f8(float a, float b, float c, float d) { int w = 0; w = __builtin_amdgcn_cvt_pk_fp8_f32(a, b, w, false); w = __builtin_amdgcn_cvt_pk_fp8_f32(c, d, w, true); return (unsigned)w; }
__device__ __forceinline__ void transpose_item_f8(const float* W, int K, int N, unsigned char* WT, int k0, int n0, int dst_row0, float scale, LAS float* scr, int lane) {
#pragma unroll 8
    for (int i = 0; i < 32; ++i) { const int kk = 2 * i + (lane >> 5); scr[kk * 33 + (lane & 31)] = W[(size_t)(k0 + kk) * N + n0 + (lane & 31)] * scale; }
    asm volatile("s_waitcnt lgkmcnt(0)" ::: "memory");
    const int c = lane & 3;
#pragma unroll
    for (int j = 0; j < 2; ++j) { const int n = (lane >> 2) + 16 * j; const LAS float* s = scr + (16 * c) * 33 + n;
        u32x4 o; o.x = pk4f8(s[0 * 33], s[1 * 33], s[2 * 33], s[3 * 33]); o.y = pk4f8(s[4 * 33], s[5 * 33], s[6 * 33], s[7 * 33]); o.z = pk4f8(s[8 * 33], s[9 * 33], s[10 * 33], s[11 * 33]); o.w = pk4f8(s[12 * 33], s[13 * 33], s[14 * 33], s[15 * 33]);
        *(u32x4*)(WT + (size_t)(dst_row0 + n) * K + k0 + 16 * c) = o; }
    asm volatile("s_waitcnt lgkmcnt(0)" ::: "memory");
}
__device__ __forceinline__ void phase0(const Params& p, const Ctx& c) {
    unsigned char* ws = p.ws;
    LAS float* scr = (LAS float*)(c.lds + c.wave * 16384);
    constexpr int I0 = 16 * 168, I1 = 8 * 32, I2 = 8 * 32, I3 = 16 * 32, I4 = 32 * 1024, I5 = 32 * 512, NIT = I0 + I1 + I2 + I3 + I4 + I5;
    for (int it = c.gw; it < NIT; it += c.ngw) {
        int r = it;
        if (r < I0) { transpose_item(p.in[5], 1024, 5376, (bf16*)(ws + WS_WIN_T), 64 * (r / 168), 32 * (r % 168), 32 * (r % 168), scr, c.lane); continue; } r -= I0;
        if (r < I1) { transpose_item(p.in[17], 512, 1024, (bf16*)(ws + WS_WR_T), 64 * (r / 32), 32 * (r % 32), 32 * (r % 32), scr, c.lane); continue; } r -= I1;
        if (r < I2) { transpose_item(p.in[18], 512, 1024, (bf16*)(ws + WS_WA_T), 64 * (r / 32), 32 * (r % 32), 32 * (r % 32), scr, c.lane); continue; } r -= I2;
        if (r < I3) { transpose_item(p.in[19], 1024, 1024, (bf16*)(ws + WS_WO_T), 64 * (r / 32), 32 * (r % 32), 32 * (r % 32), scr, c.lane); continue; } r -= I3;
        if (r < I4) { const int e = r >> 10, rr = r & 1023, n0 = 32 * (rr & 63);
            const int dst = n0 < 1024 ? (n0 >> 7) * 256 + (n0 & 127) : ((n0 - 1024) >> 7) * 256 + 128 + ((n0 - 1024) & 127);
            transpose_item_f8(p.in[22] + (size_t)e * 1024 * 2048, 1024, 2048, ws + WS_W1T + (size_t)e * 2048 * 1024, 64 * (rr >> 6), n0, dst, W1_SCALE, scr, c.lane); continue; } r -= I4;
        { const int e = r >> 9, rr = r & 511; transpose_item_f8(p.in[24] + (size_t)e * 1024 * 1024, 1024, 1024, ws + WS_W2T + (size_t)e * 1024 * 1024, 64 * (rr >> 5), 32 * (rr & 31), 32 * (rr & 31), W2_SCALE, scr, c.lane); }
    }
    const int gt = c.bid * NTHREADS + c.tid, ngt = c.G * NTHREADS;
    { bf16* WL = (bf16*)(ws + WS_WLORA_T); const float* du = p.in[8]; const float* iu = p.in[10]; const float* gu = p.in[11];
      for (int i = gt; i < 1536 * 256; i += ngt) { const int n = i >> 8, k = i & 255; float v = 0.f;
          if (n < 512) { if (k < 64) v = du[k * 512 + n]; } else if (n < 1024) { if (k >= 64 && k < 128) v = iu[(k - 64) * 512 + (n - 512)]; } else { if (k >= 128) v = gu[(k - 128) * 512 + (n - 1024)]; }
          WL[i] = (bf16)f2bf(v); } }
    { float* RT = (float*)(ws + WS_ROPE); for (int i = gt; i < SEQ * 8; i += ngt) { const int pos = i >> 3, j = i & 7; float sn, cs; sincosf((float)pos * powf(500000.0f, -(float)j * 0.125f), &sn, &cs); RT[pos * 16 + j] = cs; RT[pos * 16 + 8 + j] = sn; }
      int* RTK = (int*)(ws + WS_ROWTOK); for (int i = gt; i < MAXSLOTS; i += ngt) RTK[i] = 0;
      float* KMz = (float*)(ws + WS_KMEAN); for (int i = gt; i < NB * NHEAD * 16 * 64; i += ngt) KMz[i] = 0.f; }
    { const f32x4* x4 = (const f32x4*)p.in[0]; u32x2* o = (u32x2*)(ws + WS_XB);
      for (int i = gt; i < MTOK * DMODEL / 4; i += ngt) { const f32x4 v = x4[i]; u32x2 w; w.x = pk2(v[0], v[1]); w.y = pk2(v[2], v[3]); o[i] = w; } }
}

__device__ __forceinline__ void phase2(const Params& p, const Ctx& c) {
    unsigned char* ws = p.ws;
    { const bf16* __restrict__ PLR = (const bf16*)(ws + WS_PLR); bf16* __restrict__ AL = (bf16*)(ws + WS_ALORA); const float* mix = p.in[6] + 1536;
      const int j0 = c.lane * 4; const f32x4 mx = *(const f32x4*)(mix + j0);
      for (int m0 = 4 * c.gw; m0 < MTOK; m0 += 4 * c.ngw) {
          u32x2 r[5]; u32x2 z; z.x = 0u; z.y = 0u; r[0] = z;
          if ((m0 & (SEQ - 1)) != 0) r[0] = *(const u32x2*)(PLR + (size_t)(m0 - 1) * 256 + j0);
#pragma unroll
          for (int u = 0; u < 4; ++u) r[u + 1] = *(const u32x2*)(PLR + (size_t)(m0 + u) * 256 + j0);
#pragma unroll
          for (int u = 0; u < 4; ++u) { const f32x4 cu = {bflo(r[u + 1].x), bfhi(r[u + 1].x), bflo(r[u + 1].y), bfhi(r[u + 1].y)}, pv = {bflo(r[u].x), bfhi(r[u].x), bflo(r[u].y), bfhi(r[u].y)};
              f32x4 s = cu + (pv - cu) * mx;
#pragma unroll
              for (int i = 0; i < 4; ++i) { if (c.lane < 16) s[i] = tanhf(s[i]); else if (c.lane >= 32) s[i] = sigmf(s[i]); }
              u32x2 o; o.x = pk2(s[0], s[1]); o.y = pk2(s[2], s[3]); *(u32x2*)(AL + (size_t)(m0 + u) * 256 + j0) = o; } } }
    { bf16* Q = (bf16*)(ws + WS_PQ); bf16* K = (bf16*)(ws + WS_PK); const float* RT = (const float*)(ws + WS_ROPE);
      for (int g = c.gw; g < MTOK / 4; g += c.ngw) { const int tok = 4 * g + (c.lane >> 4), which = (c.lane >> 3) & 1, h = c.lane & 7;
          bf16* P = (which ? K : Q) + (size_t)tok * 512 + h * 64; const float* rt = RT + (size_t)(tok & (SEQ - 1)) * 16;
          const u32x4 a = *(const u32x4*)P, bq = *(const u32x4*)(P + 8); const f32x4 c0 = *(const f32x4*)rt, c1 = *(const f32x4*)(rt + 4), s0 = *(const f32x4*)(rt + 8), s1 = *(const f32x4*)(rt + 12);
          const float x1[8] = {bflo(a.x), bfhi(a.x), bflo(a.y), bfhi(a.y), bflo(a.z), bfhi(a.z), bflo(a.w), bfhi(a.w)}, x2[8] = {bflo(bq.x), bfhi(bq.x), bflo(bq.y), bfhi(bq.y), bflo(bq.z), bfhi(bq.z), bflo(bq.w), bfhi(bq.w)};
          const float cs[8] = {c0[0], c0[1], c0[2], c0[3], c1[0], c1[1], c1[2], c1[3]}, sn[8] = {s0[0], s0[1], s0[2], s0[3], s1[0], s1[1], s1[2], s1[3]};
          float o1[8], o2[8];
#pragma unroll
          for (int i = 0; i < 8; ++i) { o1[i] = x1[i] * cs[i] - x2[i] * sn[i]; o2[i] = x2[i] * cs[i] + x1[i] * sn[i]; }
          u32x4 w1, w2; w1.x = pk2(o1[0], o1[1]); w1.y = pk2(o1[2], o1[3]); w1.z = pk2(o1[4], o1[5]); w1.w = pk2(o1[6], o1[7]); w2.x = pk2(o2[0], o2[1]); w2.y = pk2(o2[2], o2[3]); w2.z = pk2(o2[4], o2[5]); w2.w = pk2(o2[6], o2[7]);
          *(u32x4*)P = w1; *(u32x4*)(P + 8) = w2; } }
    { const bf16* __restrict__ RKV = (const bf16*)(ws + WS_PRKV); float* __restrict__ INVN = (float*)(ws + WS_INVN); const int ch = 8 * c.lane;
      const f32x4 mk0 = *(const f32x4*)(p.in[6] + 512 + ch), mk1 = *(const f32x4*)(p.in[6] + 512 + ch + 4), kc0 = *(const f32x4*)(p.in[12] + ch), kc1 = *(const f32x4*)(p.in[12] + ch + 4);
      for (int m0 = 2 * c.gw; m0 < MTOK; m0 += 2 * c.ngw) { u32x4 cu[2], pv[2];
#pragma unroll
          for (int u = 0; u < 2; ++u) { const size_t m = (size_t)(m0 + u); cu[u] = *(const u32x4*)(RKV + m * 1536 + 512 + ch); pv[u] = (u32x4){0u, 0u, 0u, 0u}; if (((m0 + u) & (SEQ - 1)) != 0) pv[u] = *(const u32x4*)(RKV + (m - 1) * 1536 + 512 + ch); }
#pragma unroll
          for (int u = 0; u < 2; ++u) { const f32x4 k0 = {bflo(cu[u].x), bfhi(cu[u].x), bflo(cu[u].y), bfhi(cu[u].y)}, k1 = {bflo(cu[u].z), bfhi(cu[u].z), bflo(cu[u].w), bfhi(cu[u].w)};
              const f32x4 q0 = {bflo(pv[u].x), bfhi(pv[u].x), bflo(pv[u].y), bfhi(pv[u].y)}, q1 = {bflo(pv[u].z), bfhi(pv[u].z), bflo(pv[u].w), bfhi(pv[u].w)};
              const f32x4 a = (k0 + (q0 - k0) * mk0) * kc0, bq = (k1 + (q1 - k1) * mk1) * kc1;
              float ss = ((a[0] * a[0] + a[1] * a[1]) + (a[2] * a[2] + a[3] * a[3])) + ((bq[0] * bq[0] + bq[1] * bq[1]) + (bq[2] * bq[2] + bq[3] * bq[3])); ss = sum8(ss);
              if ((c.lane & 7) == 0) INVN[(size_t)(m0 + u) * 8 + (c.lane >> 3)] = 1.0f / fmaxf(sqrtf(ss), 1e-12f); } } }
}
__device__ __forceinline__ void kmean_items(const Params& p, const Ctx& c) {
    const bf16* __restrict__ K = (const bf16*)(p.ws + WS_PK); float* KM = (float*)(p.ws + WS_KMEAN);
    for (int item = c.bid; item < NB * 32; item += c.G) { const int b = item >> 5, blk = (item >> 1) & 15, hf = item & 1, h = c.tid >> 6, d = c.tid & 63; const bf16* kp = K + ((size_t)b * SEQ + blk * 256 + hf * 128) * 512 + c.tid; float s = 0.f;
#pragma unroll 32
        for (int tok = 0; tok < 128; ++tok) s += bf2f(kp[(size_t)tok * 512]);
        atomicAdd(KM + ((size_t)((b * 8 + h) * 16 + blk)) * 64 + d, s * (1.0f / 256.0f)); }
}

__device__ __forceinline__ float wave_sum_dpp(float x) {
    x = row16_sum(x);
    x += __builtin_bit_cast(float, __builtin_amdgcn_update_dpp(0, __builtin_bit_cast(int, x), 0x142, 0xA, 0xF, false));
    x += __builtin_bit_cast(float, __builtin_amdgcn_update_dpp(0, __builtin_bit_cast(int, x), 0x143, 0xC, 0xF, false));
    return __builtin_bit_cast(float, __builtin_amdgcn_readlane(__builtin_bit_cast(int, x), 63));
}
__device__ __forceinline__ f32x4 unpk4(u32x2 w) { return (f32x4){bflo(w.x), bfhi(w.x), bflo(w.y), bfhi(w.y)}; }
constexpr int CK_NH = 0, CK_RH = 2048, CK_ABT = 4096, CK_KBT = 6144, CK_VT = 8192, CK_GC = 10240, CK_MKAT = 10496, CK_MART = 11008, CK_MKRT = 11520, CK_TMT = 12032, CK_COPY = 12544  , CK_AB = 12544, CK_KB = 14592, CK_MAA = 16640, CK_STRIDE = 17664;
__device__ __forceinline__ float dpp_shr1(float x) { return dppf<0x111>(x); }
__device__ __forceinline__ f32x4 scan16(f32x4 x) {
#pragma unroll
    for (int i = 0; i < 4; ++i) { float v = x[i]; v += dppf<0x111>(v); v += dppf<0x112>(v); v += dppf<0x114>(v); v += dppf<0x118>(v); x[i] = v; }
    return x;
}
__device__ __forceinline__ u32x2 pk4bf(f32x4 v) { u32x2 w; w.x = pk2(v[0], v[1]); w.y = pk2(v[2], v[3]); return w; }
__device__ __forceinline__ bf16x8 mk8(u32x2 lo, u32x2 hi) { u32x4 w; w.x = lo.x; w.y = lo.y; w.z = hi.x; w.w = hi.y; return __builtin_bit_cast(bf16x8, w); }
__device__ __forceinline__ void ck_load(u32x2 (&raw)[8], float& invn, const bf16* RKVh, const bf16* LOh, const float* INVN, int h, size_t m, bool has_prev) {
    const bf16* row = RKVh + m * 1536;
    raw[0] = *(const u32x2*)(row); raw[1] = *(const u32x2*)(row + 512); raw[2] = *(const u32x2*)(row + 1024);
    u32x2 z; z.x = 0u; z.y = 0u; raw[3] = z; raw[4] = z; raw[5] = z;
    if (has_prev) { raw[3] = *(const u32x2*)(row - 1536); raw[4] = *(const u32x2*)(row - 1536 + 512); raw[5] = *(const u32x2*)(row - 1536 + 1024); }
    raw[6] = *(const u32x2*)(LOh + m * 1536); raw[7] = *(const u32x2*)(LOh + m * 1536 + 512); invn = INVN[m * 8 + h];
}
#define LDS_BARRIER() do { asm volatile("s_waitcnt lgkmcnt(0)" ::: "memory"); __builtin_amdgcn_s_barrier(); asm volatile("" ::: "memory"); } while (0)
__device__ __forceinline__ void scan_prep(const Params& p, const Ctx& c) {
    const int cc1 = c.tid >> 8, cq = (c.tid >> 4) & 15, t1 = c.tid & 15;
    const int lane = c.lane, row = lane & 15, g = lane >> 4;
    const float* INVN = (const float*)(p.ws + WS_INVN);
    constexpr int NITEM = NB * NHEAD * (SEQ / 32);
    u32x2 raw[8]; float invn;
    int item = c.bid;
    if (item < NITEM) { const int bh = item >> 7, it = item & 127, h = bh & 7, ch0 = h * 64 + 4 * cq; const size_t m = (size_t)(bh >> 3) * SEQ + it * 32 + cc1 * 16 + t1;
        ck_load(raw, invn, (const bf16*)(p.ws + WS_PRKV) + ch0, (const bf16*)(p.ws + WS_LORA) + ch0, INVN, h, m, (it * 32 + cc1 * 16 + t1) != 0); }
    int par = 0;
    for (; item < NITEM; item += c.G, par ^= 1) {
        const int bh = item >> 7, it = item & 127, h = bh & 7, ch0 = h * 64 + 4 * cq;
        LAS unsigned char* lds = c.lds + par * (2 * CK_STRIDE);
        const f32x4 mr = *(const f32x4*)(p.in[6] + ch0), mk = *(const f32x4*)(p.in[6] + 512 + ch0), mv = *(const f32x4*)(p.in[6] + 1024 + ch0);
        const f32x4 w0 = *(const f32x4*)(p.in[7] + ch0), a0 = *(const f32x4*)(p.in[9] + ch0), kkc = *(const f32x4*)(p.in[12] + ch0), kac = *(const f32x4*)(p.in[13] + ch0);
        { LAS unsigned char* cb = lds + cc1 * CK_STRIDE;
          f32x4 r = unpk4(raw[0]), kx = unpk4(raw[1]), v = unpk4(raw[2]); const f32x4 rp = unpk4(raw[3]), kp = unpk4(raw[4]), vp = unpk4(raw[5]), lw = unpk4(raw[6]), la = unpk4(raw[7]);
          r = r + (rp - r) * mr; kx = kx + (kp - kx) * mk; v = v + (vp - v) * mv;
          f32x4 lam, a;
#pragma unroll
          for (int i = 0; i < 4; ++i) { lam[i] = 0.6065306597126334f * __builtin_amdgcn_rcpf(1.0f + __expf(-(w0[i] + lw[i]))); a[i] = __builtin_amdgcn_rcpf(1.0f + __expf(-(a0[i] + la[i]))); }
          const f32x4 kk = kx * kkc * invn; const f32x4 kmod = kx * ((a - 1.0f) * kac + 1.0f);
          const f32x4 L = scan16(lam);
          f32x4 gt, gm, ig, gc;
#pragma unroll
          for (int i = 0; i < 4; ++i) { gt[i] = __expf(-L[i]); ig[i] = __builtin_amdgcn_rcpf(gt[i]);
              const float sh = dppf<0x111>(gt[i]); gm[i] = (t1 == 0) ? 1.0f : sh;
              gc[i] = dppf<0x140>(gt[i]); }
          const f32x4 nh = -(kk * gm), rh = r * gt, ab = kk * a * ig, kb = kmod * ig;
          *(LAS u32x2*)(cb + CK_NH + (t1 * 64 + 4 * cq) * 2) = pk4bf(nh); *(LAS u32x2*)(cb + CK_RH + (t1 * 64 + 4 * cq) * 2) = pk4bf(rh);
          *(LAS u32x2*)(cb + CK_AB + (t1 * 64 + 4 * cq) * 2) = pk4bf(ab); *(LAS u32x2*)(cb + CK_KB + (t1 * 64 + 4 * cq) * 2) = pk4bf(kb);
#pragma unroll
          for (int e = 0; e < 4; ++e) { *(LAS bf16*)(cb + CK_ABT + ((4 * cq + e) * 16 + t1) * 2) = (bf16)f2bf(ab[e]); *(LAS bf16*)(cb + CK_KBT + ((4 * cq + e) * 16 + t1) * 2) = (bf16)f2bf(kb[e]);
                                        *(LAS bf16*)(cb + CK_VT + ((4 * cq + e) * 16 + t1) * 2) = (bf16)f2bf(v[e]); }
          if (t1 == 0) *(LAS f32x4*)(cb + CK_GC + 4 * cq * 4) = gc;
        }
        { const int nx = item + c.G; if (nx < NITEM) { const int bh2 = nx >> 7, it2 = nx & 127, h2 = bh2 & 7, ch2 = h2 * 64 + 4 * cq; const size_t m2 = (size_t)(bh2 >> 3) * SEQ + it2 * 32 + cc1 * 16 + t1;
            ck_load(raw, invn, (const bf16*)(p.ws + WS_PRKV) + ch2, (const bf16*)(p.ws + WS_LORA) + ch2, INVN, h2, m2, (it2 * 32 + cc1 * 16 + t1) != 0); } }
        LDS_BARRIER();
        { const int cc = c.wave >> 2, I = (c.wave >> 1) & 1, J = c.wave & 1; LAS unsigned char* cb = lds + cc * CK_STRIDE;
          const LAS unsigned char* X = cb + (I ? CK_KB : CK_AB); const LAS unsigned char* Yh = cb + (J ? CK_RH : CK_NH);
          f32x4 acc = {0.f, 0.f, 0.f, 0.f};
#pragma unroll
          for (int ks = 0; ks < 2; ++ks) { const bf16x8 af = *(const LAS bf16x8*)(X + (row * 64 + 32 * ks + 8 * g) * 2), bfr = *(const LAS bf16x8*)(Yh + (row * 64 + 32 * ks + 8 * g) * 2);
              acc = __builtin_amdgcn_mfma_f32_16x16x32_bf16(af, bfr, acc, 0, 0, 0); }
          const int t = row;
          if (I == 0 && J == 0) {
#pragma unroll
              for (int r = 0; r < 4; ++r) { const int s = 4 * g + r; *(LAS float*)(cb + CK_MAA + (s * 16 + t) * 4) = (s < t) ? acc[r] : 0.f; }
              asm volatile("s_waitcnt lgkmcnt(0)" ::: "memory");
              float tm[16];
#pragma unroll
              for (int i = 0; i < 16; ++i) tm[i] = (i == row) ? 1.0f : 0.0f;
#pragma unroll
              for (int s = 0; s < 15; ++s) { const LAS float* mrow = (const LAS float*)(cb + CK_MAA) + s * 16;
#pragma unroll
                  for (int i = (s + 1) / 4; i < 4; ++i) { const f32x4 m4 = *(const LAS f32x4*)(mrow + 4 * i);
#pragma unroll
                      for (int e = 0; e < 4; ++e) { const int tt = 4 * i + e; if (tt > s) tm[tt] += tm[s] * m4[e]; } } }
#pragma unroll
              for (int e = 0; e < 4; ++e) { const float v_ = g == 0 ? tm[e] : g == 1 ? tm[4 + e] : g == 2 ? tm[8 + e] : tm[12 + e]; *(LAS bf16*)(cb + CK_TMT + ((4 * g + e) * 16 + row) * 2) = (bf16)f2bf(v_); }
          } else { f32x4 mvv;
#pragma unroll
              for (int r = 0; r < 4; ++r) { const int s = 4 * g + r; const bool keep = (J == 0) ? (s < t) : (s <= t); mvv[r] = keep ? acc[r] : 0.f; }
              *(LAS u32x2*)(cb + ((I == 1 && J == 0) ? CK_MKAT : (I == 0 ? CK_MART : CK_MKRT)) + (t * 16 + 4 * g) * 2) = pk4bf(mvv); }
        }
        LDS_BARRIER();
        { unsigned char* dst = p.ws + WS_SCANOP + (size_t)item * (2 * CK_COPY);
          for (int i = c.tid; i < 2 * (CK_COPY / 16); i += NTHREADS) { const int cc = i >= (CK_COPY / 16), off = (i - cc * (CK_COPY / 16)) * 16; *(u32x4*)(dst + cc * CK_COPY + off) = *(const LAS u32x4*)(lds + cc * CK_STRIDE + off); } }
    }
}
__device__ __forceinline__ void scan_chain(const Params& p, const Ctx& c, int bh) {
    const int b = bh >> 3, h = bh & 7; const size_t mb = (size_t)b * SEQ;
    const int lane = c.lane, row = lane & 15, g = lane >> 4, rg = c.wave & 3;
    constexpr int NIT = SEQ / 32, NPC = 2 * CK_COPY / 16;
    const unsigned char* src = p.ws + WS_SCANOP + (size_t)bh * NIT * (2 * CK_COPY);
    f32x4 S[4];
#pragma unroll
    for (int q = 0; q < 4; ++q) S[q] = (f32x4){0.f, 0.f, 0.f, 0.f};
    u32x4 st[4];
#pragma unroll
    for (int i = 0; i < 4; ++i) { const int pc = c.tid + i * NTHREADS; if (pc < NPC) st[i] = *(const u32x4*)(src + (size_t)pc * 16); }
#pragma unroll
    for (int i = 0; i < 4; ++i) { const int pc = c.tid + i * NTHREADS; if (pc < NPC) *(LAS u32x4*)(c.lds + pc * 16) = st[i]; }
    LDS_BARRIER();
    for (int it = 0; it < NIT; ++it) {
        LAS unsigned char* lds = c.lds + (it & 1) * (2 * CK_COPY);
        if (it + 1 < NIT) {
#pragma unroll
            for (int i = 0; i < 4; ++i) { const int pc = c.tid + i * NTHREADS; if (pc < NPC) st[i] = *(const u32x4*)(src + (size_t)(it + 1) * (2 * CK_COPY) + (size_t)pc * 16); } }
        if (c.wave < 4) {
#pragma unroll 1
            for (int cc = 0; cc < 2; ++cc) {
                const LAS unsigned char* cb = lds + cc * CK_COPY; const u32x2 z2 = {0u, 0u}; const bf16x8 z8 = {0, 0, 0, 0, 0, 0, 0, 0};
                bf16x8 nh[2], rhf[2], kbt[4]; u32x2 abt[4]; f32x4 gcv[4];
#pragma unroll
                for (int ks = 0; ks < 2; ++ks) { nh[ks] = mk8(*(const LAS u32x2*)(cb + CK_NH + (row * 64 + 32 * ks + 4 * g) * 2), *(const LAS u32x2*)(cb + CK_NH + (row * 64 + 32 * ks + 16 + 4 * g) * 2));
                                                 rhf[ks] = mk8(*(const LAS u32x2*)(cb + CK_RH + (row * 64 + 32 * ks + 4 * g) * 2), *(const LAS u32x2*)(cb + CK_RH + (row * 64 + 32 * ks + 16 + 4 * g) * 2)); }
                bf16x8 Vf = z8, mkat = z8, mkrt = z8;
                if (g < 2) { Vf = *(const LAS bf16x8*)(cb + CK_VT + ((rg * 16 + row) * 16 + 8 * g) * 2); mkat = *(const LAS bf16x8*)(cb + CK_MKAT + (row * 16 + 8 * g) * 2); mkrt = *(const LAS bf16x8*)(cb + CK_MKRT + (row * 16 + 8 * g) * 2); }
                const u32x2 mart = *(const LAS u32x2*)(cb + CK_MART + (row * 16 + 4 * g) * 2), tmt = *(const LAS u32x2*)(cb + CK_TMT + (row * 16 + 4 * g) * 2);
#pragma unroll
                for (int q = 0; q < 4; ++q) { abt[q] = *(const LAS u32x2*)(cb + CK_ABT + ((16 * q + row) * 16 + 4 * g) * 2); kbt[q] = z8; if (g < 2) kbt[q] = *(const LAS bf16x8*)(cb + CK_KBT + ((16 * q + row) * 16 + 8 * g) * 2);
                                              gcv[q] = *(const LAS f32x4*)(cb + CK_GC + (16 * q + 4 * g) * 4); }
                bf16x8 Sb[2];
#pragma unroll
                for (int ks = 0; ks < 2; ++ks) Sb[ks] = mk8(pk4bf(S[2 * ks]), pk4bf(S[2 * ks + 1]));
                f32x4 D = {0.f, 0.f, 0.f, 0.f};
                D = __builtin_amdgcn_mfma_f32_16x16x32_bf16(nh[0], Sb[0], D, 0, 0, 0); D = __builtin_amdgcn_mfma_f32_16x16x32_bf16(nh[1], Sb[1], D, 0, 0, 0); D = __builtin_amdgcn_mfma_f32_16x16x32_bf16(mkat, Vf, D, 0, 0, 0);
                f32x4 SAt = {0.f, 0.f, 0.f, 0.f};
                SAt = __builtin_amdgcn_mfma_f32_16x16x32_bf16(mk8(tmt, z2), mk8(pk4bf(D), z2), SAt, 0, 0, 0);
                const bf16x8 SAf = mk8(pk4bf(SAt), z2);
                f32x4 Y = {0.f, 0.f, 0.f, 0.f};
                Y = __builtin_amdgcn_mfma_f32_16x16x32_bf16(rhf[0], Sb[0], Y, 0, 0, 0); Y = __builtin_amdgcn_mfma_f32_16x16x32_bf16(rhf[1], Sb[1], Y, 0, 0, 0);
                Y = __builtin_amdgcn_mfma_f32_16x16x32_bf16(mk8(mart, z2), SAf, Y, 0, 0, 0); Y = __builtin_amdgcn_mfma_f32_16x16x32_bf16(mkrt, Vf, Y, 0, 0, 0);
                { float* yo = (float*)(p.ws + WS_YRAW) + (mb + (size_t)it * 32 + cc * 16 + 4 * g) * 512 + h * 64 + rg * 16 + row;
#pragma unroll
                  for (int r = 0; r < 4; ++r) yo[(size_t)r * 512] = Y[r]; }
#pragma unroll
                for (int q = 0; q < 4; ++q) { f32x4 Cq = S[q];
                    Cq = __builtin_amdgcn_mfma_f32_16x16x32_bf16(mk8(abt[q], z2), SAf, Cq, 0, 0, 0); Cq = __builtin_amdgcn_mfma_f32_16x16x32_bf16(kbt[q], Vf, Cq, 0, 0, 0);
                    S[q] = Cq * gcv[q]; }
            }
        }
        if (it + 1 < NIT) { LAS unsigned char* nl = c.lds + ((it + 1) & 1) * (2 * CK_COPY);
#pragma unroll
            for (int i = 0; i < 4; ++i) { const int pc = c.tid + i * NTHREADS; if (pc < NPC) *(LAS u32x4*)(nl + pc * 16) = st[i]; } }
        LDS_BARRIER();
    }
}

namespace att {
constexpr int L_K = 0, L_V = 16384, L_KM = 32768, L_SEL = 36864, L_WS = 37888;
constexpr float C2 = 0.125f * 1.4426950408889634f;
__device__ __forceinline__ int crow(int r, int hi) { return (r & 3) + 8 * (r >> 2) + 4 * hi; }
typedef __bf16 bf16x2_t __attribute__((ext_vector_type(2)));
__device__ __forceinline__ unsigned cvtpk(float lo, float hi) { f32x2 v = {lo, hi}; bf16x2_t b = __builtin_convertvector(v, bf16x2_t); return __builtin_bit_cast(unsigned, b); }
typedef short v4i16_t __attribute__((ext_vector_type(4)));
__device__ __forceinline__ s16x4 vtr(const LAS unsigned char* p) { return __builtin_bit_cast(s16x4, __builtin_amdgcn_ds_read_tr16_b64_v4i16((LAS v4i16_t*)p)); }

__device__ __forceinline__ void unit(const Params& p, const Ctx& c, int b, int h, int qb, bf16* Oout) {
    const int tid = c.tid, lane = c.lane, wid = c.wave, r32 = lane & 31, hi = lane >> 5;
    bf16* Q = (bf16*)(p.ws + WS_PQ); const bf16* K = (const bf16*)(p.ws + WS_PK); const bf16* V = (const bf16*)(p.ws + WS_PAV); const float* KMg = (const float*)(p.ws + WS_KMEAN);
    const size_t rowbase = (size_t)b * SEQ; const int q0 = qb * 256;
    LAS unsigned char* lds = c.lds; LAS float* kml = (LAS float*)(lds + L_KM); LAS unsigned* sell = (LAS unsigned*)(lds + L_SEL); LAS float* wsf = (LAS float*)(lds + L_WS) + wid * 64;
    for (int i = tid; i < qb * 64; i += NTHREADS) kml[i] = KMg[(size_t)((b * 8 + h) * 16) * 64 + i];
    __syncthreads();
    if (tid < 256) {
        const bf16* qrow = Q + (rowbase + q0 + tid) * 512 + h * 64; float qv[64];
#pragma unroll
        for (int i = 0; i < 8; ++i) { const u32x4 w = *(const u32x4*)(qrow + 8 * i); qv[8 * i] = bflo(w.x); qv[8 * i + 1] = bfhi(w.x); qv[8 * i + 2] = bflo(w.y); qv[8 * i + 3] = bfhi(w.y); qv[8 * i + 4] = bflo(w.z); qv[8 * i + 5] = bfhi(w.z); qv[8 * i + 6] = bflo(w.w); qv[8 * i + 7] = bfhi(w.w); }
        float v0 = -INFINITY, v1 = -INFINITY, v2 = -INFINITY; int i0 = -1, i1 = -1, i2 = -1;
        for (int j = 0; j < qb; ++j) { float g = 0.f;
#pragma unroll
            for (int d = 0; d < 64; d += 4) { const f32x4 km = *(const LAS f32x4*)(kml + j * 64 + d); g += qv[d] * km[0] + qv[d + 1] * km[1] + qv[d + 2] * km[2] + qv[d + 3] * km[3]; }
            if (g > v0) { v2 = v1; i2 = i1; v1 = v0; i1 = i0; v0 = g; i0 = j; } else if (g > v1) { v2 = v1; i2 = i1; v1 = g; i1 = j; } else if (g > v2) { v2 = g; i2 = j; } }
        unsigned msk = 0u; if (i0 >= 0) msk |= 1u << i0; if (i1 >= 0) msk |= 1u << i1; if (i2 >= 0) msk |= 1u << i2;
        sell[tid] = msk;
    }
    __syncthreads();
    const bf16* Qw = Q + (rowbase + q0 + wid * 32) * 512 + h * 64; bf16x8 qr[4];
#pragma unroll
    for (int d0 = 0; d0 < 4; ++d0) qr[d0] = *(const bf16x8*)(Qw + (size_t)r32 * 512 + d0 * 16 + hi * 8);
    const unsigned mysel = sell[wid * 32 + r32]; const int qrel = wid * 32 + r32;
    float m_run = -INFINITY, l_run = 0.f; f32x16 o0 = {}, o1 = {};
    const int krow = tid & 63, kch = tid >> 6; const bf16* ksrc = K + (rowbase + krow) * 512 + h * 64 + kch * 8; const int kdst = kch * 1024 + krow * 16;
    const int vrow = 16 * (wid & 3) + (lane >> 2), vcol = (wid >> 2) * 32 + (lane & 3) * 8; const bf16* vsrc = V + (rowbase + vrow) * 512 + h * 64 + vcol; const int vdst = wid * 1024 + lane * 16;
    const int kfo = hi * 1024 + r32 * 16; const int vfo = ((lane >> 4) & 1) * 32 + (lane & 3) * 8 + (4 * hi + ((lane & 15) >> 2)) * 64;
    const int ntile = 4 * qb + 4;
    u32x4 kreg = *(const u32x4*)(ksrc), vreg = *(const u32x4*)(vsrc);
    for (int it = 0; it < ntile; ++it) {
        LAS unsigned char* Ks = lds + L_K + (it & 1) * 8192; LAS unsigned char* Vs = lds + L_V + (it & 1) * 8192;
        *(LAS u32x4*)(Ks + kdst) = kreg; *(LAS u32x4*)(Vs + vdst) = vreg;
        __syncthreads();
        if (it + 1 < ntile) { kreg = *(const u32x4*)(ksrc + (size_t)(it + 1) * 64 * 512); vreg = *(const u32x4*)(vsrc + (size_t)(it + 1) * 64 * 512); }
        const int blk = it >> 2; const bool band = blk == qb; const int jb = it & 3;
        bool lane_on = band ? (64 * jb <= qrel) : (((mysel >> blk) & 1u) != 0u);
        if (__any(lane_on)) {
            f32x16 p0 = {}, p1 = {};
#pragma unroll
            for (int d0 = 0; d0 < 4; ++d0) { const bf16x8 k0 = *(const LAS bf16x8*)(Ks + kfo + d0 * 2048), k1 = *(const LAS bf16x8*)(Ks + kfo + d0 * 2048 + 512);
                p0 = __builtin_amdgcn_mfma_f32_32x32x16_bf16(k0, qr[d0], p0, 0, 0, 0); p1 = __builtin_amdgcn_mfma_f32_32x32x16_bf16(k1, qr[d0], p1, 0, 0, 0); }
#pragma unroll
            for (int r = 0; r < 16; ++r) { const int kv = 64 * jb + crow(r, hi);
                const bool ok0 = band ? (kv <= qrel) : lane_on, ok1 = band ? (kv + 32 <= qrel) : lane_on;
                p0[r] = ok0 ? p0[r] * C2 : -INFINITY; p1[r] = ok1 ? p1[r] * C2 : -INFINITY; }
            float rm = fmaxf(p0[0], p1[0]);
#pragma unroll
            for (int r = 1; r < 16; ++r) rm = fmaxf(rm, fmaxf(p0[r], p1[r]));
            rm = fmaxf(rm, __shfl_xor(rm, 32));
            const float m_new = fmaxf(m_run, rm); const float m_use = (m_new == -INFINITY) ? 0.f : m_new;
            const float alpha = __builtin_amdgcn_exp2f(m_run - m_use);
            float ps = 0.f;
#pragma unroll
            for (int r = 0; r < 16; ++r) { p0[r] = __builtin_amdgcn_exp2f(p0[r] - m_use); p1[r] = __builtin_amdgcn_exp2f(p1[r] - m_use); ps += p0[r] + p1[r]; }
            l_run = l_run * alpha + ps; m_run = m_new;
            if (__any(alpha != 1.0f)) {
                if (hi == 0) wsf[r32] = alpha;
                asm volatile("s_waitcnt lgkmcnt(0)" ::: "memory");
#pragma unroll
                for (int r = 0; r < 16; ++r) { const float f = wsf[crow(r, hi)]; o0[r] *= f; o1[r] *= f; }
                asm volatile("s_waitcnt lgkmcnt(0)" ::: "memory");
            }
            u32x4 pw[4];
            pw[0] = (u32x4){cvtpk(p0[0], p0[1]), cvtpk(p0[2], p0[3]), cvtpk(p0[4], p0[5]), cvtpk(p0[6], p0[7])};
            pw[1] = (u32x4){cvtpk(p0[8], p0[9]), cvtpk(p0[10], p0[11]), cvtpk(p0[12], p0[13]), cvtpk(p0[14], p0[15])};
            pw[2] = (u32x4){cvtpk(p1[0], p1[1]), cvtpk(p1[2], p1[3]), cvtpk(p1[4], p1[5]), cvtpk(p1[6], p1[7])};
            pw[3] = (u32x4){cvtpk(p1[8], p1[9]), cvtpk(p1[10], p1[11]), cvtpk(p1[12], p1[13]), cvtpk(p1[14], p1[15])};
#pragma unroll
            for (int ks = 0; ks < 4; ++ks) {
                const s16x4 a0 = vtr(Vs + vfo + ks * 1024), a1 = vtr(Vs + vfo + ks * 1024 + 512), b0 = vtr(Vs + vfo + 4096 + ks * 1024), b1 = vtr(Vs + vfo + 4096 + ks * 1024 + 512);
                const bf16x8 va = {a0[0], a0[1], a0[2], a0[3], a1[0], a1[1], a1[2], a1[3]}, vb = {b0[0], b0[1], b0[2], b0[3], b1[0], b1[1], b1[2], b1[3]};
                const bf16x8 pa = __builtin_bit_cast(bf16x8, pw[ks]);
                o0 = __builtin_amdgcn_mfma_f32_32x32x16_bf16(pa, va, o0, 0, 0, 0); o1 = __builtin_amdgcn_mfma_f32_32x32x16_bf16(pa, vb, o1, 0, 0, 0);
            }
        }
    }
    l_run += __shfl_xor(l_run, 32);
    if (hi == 0) wsf[32 + r32] = l_run;
    asm volatile("s_waitcnt lgkmcnt(0)" ::: "memory");
    bf16* Ow = Oout + (rowbase + q0 + wid * 32) * 512 + h * 64;
#pragma unroll
    for (int r = 0; r < 16; ++r) { const int qr_ = crow(r, hi); const float rl = 1.0f / wsf[32 + qr_];
        Ow[(size_t)qr_ * 512 + r32] = (bf16)f2bf(o0[r] * rl); Ow[(size_t)qr_ * 512 + 32 + r32] = (bf16)f2bf(o1[r] * rl); }
    __syncthreads();
}
}

__device__ __forceinline__ void unp8(u32x4 w, f32x4& a, f32x4& b) { a = (f32x4){bflo(w.x), bfhi(w.x), bflo(w.y), bfhi(w.y)}; b = (f32x4){bflo(w.z), bfhi(w.z), bflo(w.w), bfhi(w.w)}; }
__device__ __forceinline__ void phase6(const Params& p, const Ctx& c) {
    unsigned char* ws = p.ws; const float* __restrict__ YR = (const float*)(ws + WS_YRAW); const bf16* __restrict__ RKV = (const bf16*)(ws + WS_PRKV); const bf16* __restrict__ LO = (const bf16*)(ws + WS_LORA); bf16* __restrict__ YO = (bf16*)(ws + WS_YRWKV);
    const int ch = 8 * c.lane;
    for (int m0 = c.gw; m0 < MTOK; m0 += c.ngw) { const size_t m = (size_t)m0;
        const f32x4 y0 = *(const f32x4*)(YR + m * 512 + ch), y1 = *(const f32x4*)(YR + m * 512 + ch + 4); const u32x4 gw_ = *(const u32x4*)(LO + m * 1536 + 1024 + ch), law = *(const u32x4*)(LO + m * 1536 + 512 + ch);
        const u32x4 rw_ = *(const u32x4*)(RKV + m * 1536 + ch), kw_ = *(const u32x4*)(RKV + m * 1536 + 512 + ch), vw_ = *(const u32x4*)(RKV + m * 1536 + 1024 + ch);
        u32x4 rpw = {0u, 0u, 0u, 0u}, kpw = rpw, vpw = rpw;
        if ((m0 & (SEQ - 1)) != 0) { rpw = *(const u32x4*)(RKV + (m - 1) * 1536 + ch); kpw = *(const u32x4*)(RKV + (m - 1) * 1536 + 512 + ch); vpw = *(const u32x4*)(RKV + (m - 1) * 1536 + 1024 + ch); }
        f32x4 r0, r1, k0, k1, v0, v1, rp0, rp1, kp0, kp1, vp0, vp1, la0, la1, g0, g1v;
        unp8(rw_, r0, r1); unp8(kw_, k0, k1); unp8(vw_, v0, v1); unp8(rpw, rp0, rp1); unp8(kpw, kp0, kp1); unp8(vpw, vp0, vp1); unp8(law, la0, la1); unp8(gw_, g0, g1v);
        const float* mix = p.in[6];
        r0 = r0 + (rp0 - r0) * *(const f32x4*)(mix + ch); r1 = r1 + (rp1 - r1) * *(const f32x4*)(mix + ch + 4);
        k0 = k0 + (kp0 - k0) * *(const f32x4*)(mix + 512 + ch); k1 = k1 + (kp1 - k1) * *(const f32x4*)(mix + 512 + ch + 4);
        v0 = v0 + (vp0 - v0) * *(const f32x4*)(mix + 1024 + ch); v1 = v1 + (vp1 - v1) * *(const f32x4*)(mix + 1024 + ch + 4);
        const f32x4 a00 = *(const f32x4*)(p.in[9] + ch), a01 = *(const f32x4*)(p.in[9] + ch + 4), ka0 = *(const f32x4*)(p.in[13] + ch), ka1 = *(const f32x4*)(p.in[13] + ch + 4), rk0 = *(const f32x4*)(p.in[14] + ch), rk1 = *(const f32x4*)(p.in[14] + ch + 4);
        f32x4 a0v, a1v;
#pragma unroll
        for (int i = 0; i < 4; ++i) { a0v[i] = 1.0f / (1.0f + __expf(-(a00[i] + la0[i]))); a1v[i] = 1.0f / (1.0f + __expf(-(a01[i] + la1[i]))); }
        const f32x4 km0 = k0 * ((a0v - 1.0f) * ka0 + 1.0f), km1 = k1 * ((a1v - 1.0f) * ka1 + 1.0f);
        const f32x4 pb0 = r0 * km0 * rk0, pb1 = r1 * km1 * rk1; const float bs = sum8(((pb0[0] + pb0[1]) + (pb0[2] + pb0[3])) + ((pb1[0] + pb1[1]) + (pb1[2] + pb1[3])));
        float s = ((y0[0] + y0[1]) + (y0[2] + y0[3])) + ((y1[0] + y1[1]) + (y1[2] + y1[3]));
        const float mu = sum8(s) * (1.0f / 64.0f); const f32x4 d0 = y0 - mu, d1 = y1 - mu;
        float q = ((d0[0] * d0[0] + d0[1] * d0[1]) + (d0[2] * d0[2] + d0[3] * d0[3])) + ((d1[0] * d1[0] + d1[1] * d1[1]) + (d1[2] * d1[2] + d1[3] * d1[3]));
        const float rs = rsqrtf(sum8(q) * (1.0f / 64.0f) + GN_EPS);
        const f32x4 o0 = (d0 * rs * *(const f32x4*)(p.in[15] + ch) + *(const f32x4*)(p.in[16] + ch) + v0 * bs) * g0, o1 = (d1 * rs * *(const f32x4*)(p.in[15] + ch + 4) + *(const f32x4*)(p.in[16] + ch + 4) + v1 * bs) * g1v;
        u32x4 w; w.x = pk2(o0[0], o0[1]); w.y = pk2(o0[2], o0[3]); w.z = pk2(o1[0], o1[1]); w.w = pk2(o1[2], o1[3]);
        *(u32x4*)(YO + m * 512 + ch) = w;
    }
}

constexpr int RW_PITCH = 36;
constexpr int L_HIST = 1024 * RW_PITCH * 4;
__device__ __forceinline__ void phase9(const Params& p, const Ctx& c, const bool dry = false) {
    unsigned char* ws = p.ws; const float* XP = (const float*)(ws + WS_XPRE); float* X1 = (float*)(ws + WS_X1); unsigned char* X1F = (unsigned char*)(ws + WS_X1B);
    int* ctl = (int*)(ws + WS_CTL); int* TOKE = (int*)(ws + WS_TOKE); float* TOKW = (float*)(ws + WS_TOKW);
    const float* g1 = p.in[1]; const float* b1 = p.in[2]; const float* RW = p.in[20]; const float* RB = p.in[21];
    LAS float* rw = (LAS float*)c.lds; LAS int* hist = (LAS int*)(c.lds + L_HIST);
    for (int i = c.tid; i < 1024 * 8; i += NTHREADS) { const int row = i >> 3, q = i & 7; *(LAS f32x4*)(rw + row * RW_PITCH + 4 * q) = *(const f32x4*)(RW + row * 32 + 4 * q); }
    if (c.tid < 32) { hist[c.tid] = 0; ((LAS float*)(c.lds + L_HIST + 256))[c.tid] = RB[c.tid]; }
    __syncthreads();
    float gv[16], bvv[16]; LAS float* rbl = (LAS float*)(c.lds + L_HIST + 256);
#pragma unroll
    for (int i = 0; i < 16; ++i) { gv[i] = g1[c.lane + 64 * i]; bvv[i] = b1[c.lane + 64 * i]; }
    for (int m = c.gw; m < MTOK; m += c.ngw) {
        const float* xr = XP + (size_t)m * 1024 + c.lane; float v[16]; float s = 0.f;
#pragma unroll
        for (int i = 0; i < 16; ++i) { v[i] = xr[64 * i]; s += v[i]; }
        const float mean = wave_sum_dpp(s) * (1.0f / 1024.0f); float s2 = 0.f;
#pragma unroll
        for (int i = 0; i < 16; ++i) { v[i] -= mean; s2 += v[i] * v[i]; }
        const float rstd = 1.0f / sqrtf(wave_sum_dpp(s2) * (1.0f / 1024.0f) + LN_EPS);
        float acc[32];
#pragma unroll
        for (int e = 0; e < 32; ++e) acc[e] = 0.f;
#pragma unroll
        for (int i = 0; i < 16; ++i) { const int col = c.lane + 64 * i; const float xv = v[i] * rstd * gv[i] + bvv[i];
            X1[(size_t)m * 1024 + col] = xv; X1F[(size_t)m * 1024 + col] = (unsigned char)(__builtin_amdgcn_cvt_pk_fp8_f32(xv, xv, 0, false) & 0xff);
            const LAS float* wr_ = rw + col * RW_PITCH;
#pragma unroll
            for (int q = 0; q < 8; ++q) { const f32x4 w4 = *(const LAS f32x4*)(wr_ + 4 * q); acc[4 * q] += xv * w4[0]; acc[4 * q + 1] += xv * w4[1]; acc[4 * q + 2] += xv * w4[2]; acc[4 * q + 3] += xv * w4[3]; }
            __builtin_amdgcn_sched_barrier(0); }
#pragma unroll
        for (int e = 0; e < 32; ++e) acc[e] = wave_sum_dpp(acc[e]) + rbl[e];
        float tv[4]; int ti[4]; unsigned used = 0u;
#pragma unroll
        for (int k = 0; k < 4; ++k) { float bv = -INFINITY; int bi = 0;
#pragma unroll
            for (int e = 0; e < 32; ++e) { const bool ok = ((used >> e) & 1u) == 0u && acc[e] > bv; bv = ok ? acc[e] : bv; bi = ok ? e : bi; }
            tv[k] = bv; ti[k] = bi; used |= 1u << bi; }
        const float e1 = __expf(tv[1] - tv[0]), e2 = __expf(tv[2] - tv[0]), e3 = __expf(tv[3] - tv[0]); const float inv = 1.0f / (1.0f + e1 + e2 + e3);
        if (c.lane < 4 && (!dry || tv[0] == 12345.678f)) { const int e = c.lane == 0 ? ti[0] : c.lane == 1 ? ti[1] : c.lane == 2 ? ti[2] : ti[3]; const float w = (c.lane == 0 ? 1.0f : c.lane == 1 ? e1 : c.lane == 2 ? e2 : e3) * inv;
            const int pos = __hip_atomic_fetch_add(hist + e, 1, __ATOMIC_RELAXED, __HIP_MEMORY_SCOPE_WORKGROUP);
            TOKE[m * 4 + c.lane] = e | (pos << 8); TOKW[m * 4 + c.lane] = w; }
    }
    __syncthreads();
    if (c.tid < 32 && !dry) { const int base = atomicAdd(ctl + CW_COUNT + c.tid, hist[c.tid]); ctl[CW_WGBASE + c.bid * 32 + c.tid] = base; }
    __syncthreads();
}

__device__ __forceinline__ void phase10(const Params& p, const Ctx& c) {
    unsigned char* ws = p.ws; int* ctl = (int*)(ws + WS_CTL); const int* TOKE = (const int*)(ws + WS_TOKE); const float* TOKW = (const float*)(ws + WS_TOKW);
    int* SLOTOF = (int*)(ws + WS_SLOTOF); float* ROWW = (float*)(ws + WS_ROWW);
    LAS int* pst = (LAS int*)(c.lds + L_HIST + 128);
    if (c.tid == 0) { int acc = 0;
        for (int e = 0; e < 32; ++e) { const int cnt = __hip_atomic_load(ctl + CW_COUNT + e, __ATOMIC_RELAXED, __HIP_MEMORY_SCOPE_AGENT); const int nt = (cnt + 255) >> 8;
            pst[e] = acc * 256;
            if (c.bid == 0) for (int t = 0; t < nt; ++t) ctl[CW_TILE_E + acc + t] = e;
            acc += nt; }
        if (c.bid == 0) ctl[CW_NTILES] = acc; }
    __syncthreads();
    int* ROWTOK = (int*)(ws + WS_ROWTOK);
    for (int i = c.bid * NTHREADS + c.tid; i < MTOK * 4; i += c.G * NTHREADS) { const int m = i >> 2, wg = (m % c.ngw) >> 3;
        const int ew = TOKE[i], e = ew & 255; const int slot = pst[e] + ctl[CW_WGBASE + wg * 32 + e] + (ew >> 8); SLOTOF[i] = slot; ROWW[slot] = TOKW[i]; ROWTOK[slot] = m; }
}

__device__ __forceinline__ void phase14(const Params& p, const Ctx& c) {
    unsigned char* ws = p.ws; const float* __restrict__ X1 = (const float*)(ws + WS_X1); const bf16* __restrict__ YB = (const bf16*)(ws + WS_YBUF); const int* __restrict__ SLOTOF = (const int*)(ws + WS_SLOTOF);
    float* __restrict__ OUT = p.out; f32x4 g2v[4], b2v[4];
#pragma unroll
    for (int j = 0; j < 4; ++j) { g2v[j] = *(const f32x4*)(p.in[3] + 256 * j + 4 * c.lane); b2v[j] = *(const f32x4*)(p.in[4] + 256 * j + 4 * c.lane); }
    for (int m0 = 2 * c.gw; m0 < MTOK; m0 += 2 * c.ngw) {
        f32x4 v[2][4]; u32x2 yv[2][4][4];
#pragma unroll
        for (int u = 0; u < 2; ++u) { const int m = m0 + u; int sl[4];
#pragma unroll
            for (int k = 0; k < 4; ++k) sl[k] = SLOTOF[m * 4 + k];
#pragma unroll
            for (int j = 0; j < 4; ++j) { const int col = 256 * j + 4 * c.lane; v[u][j] = *(const f32x4*)(X1 + (size_t)m * 1024 + col);
#pragma unroll
                for (int k = 0; k < 4; ++k) yv[u][j][k] = *(const u32x2*)(YB + (size_t)sl[k] * 1024 + col); } }
#pragma unroll
        for (int u = 0; u < 2; ++u) { const int m = m0 + u; float s = 0.f;
#pragma unroll
            for (int j = 0; j < 4; ++j) { f32x4 a = v[u][j] * DN_ALPHA; const u32x2 y0 = yv[u][j][0], y1 = yv[u][j][1], y2 = yv[u][j][2], y3 = yv[u][j][3];
                a[0] += ((bflo(y0.x) + bflo(y1.x)) + bflo(y2.x)) + bflo(y3.x); a[1] += ((bfhi(y0.x) + bfhi(y1.x)) + bfhi(y2.x)) + bfhi(y3.x);
                a[2] += ((bflo(y0.y) + bflo(y1.y)) + bflo(y2.y)) + bflo(y3.y); a[3] += ((bfhi(y0.y) + bfhi(y1.y)) + bfhi(y2.y)) + bfhi(y3.y);
                v[u][j] = a; s += (a[0] + a[1]) + (a[2] + a[3]); }
            const float mean = wave_sum_dpp(s) * (1.0f / 1024.0f); float q = 0.f;
#pragma unroll
            for (int j = 0; j < 4; ++j) { v[u][j] = v[u][j] - mean; q += (v[u][j][0] * v[u][j][0] + v[u][j][1] * v[u][j][1]) + (v[u][j][2] * v[u][j][2] + v[u][j][3] * v[u][j][3]); }
            const float rstd = 1.0f / sqrtf(wave_sum_dpp(q) * (1.0f / 1024.0f) + LN_EPS);
#pragma unroll
            for (int j = 0; j < 4; ++j) *(f32x4*)(OUT + (size_t)m * 1024 + 256 * j + 4 * c.lane) = v[u][j] * rstd * g2v[j] + b2v[j]; }
    }
}

#define XB_TMO      128
#define XB_XCNT(j)  (256  + 64 * (j))
#define XB_XSUB(j)  (1280 + 64 * (j))
#define XB_XGEN(j)  (2304 + 64 * (j))
#define XB_TOP      3328
#define XB_TOPGEN   3392
#define XCD_BAR_WORDS 3456
#define XB_SPIN_CAP (1u << 18)

__device__ __forceinline__ unsigned xb_ld(unsigned* p)              { return __hip_atomic_load(p, __ATOMIC_RELAXED, __HIP_MEMORY_SCOPE_AGENT); }
__device__ __forceinline__ unsigned xb_add(unsigned* p, unsigned v) { return __hip_atomic_fetch_add(p, v, __ATOMIC_RELAXED, __HIP_MEMORY_SCOPE_AGENT); }
__device__ __forceinline__ unsigned xb_xcc_id() { return (unsigned)__builtin_amdgcn_s_getreg((3 << 11) | 20) & 0xFu; }
#define XB_SPIN(cond, bar) do { unsigned _sp = 0; while (cond) { __builtin_amdgcn_s_sleep(1); \
    if ((++_sp & 255u) == 0u) { if (xb_ld(&(bar)[XB_TMO])) break; if (_sp > XB_SPIN_CAP) { atomicAdd(&(bar)[XB_TMO], 1u); break; } } } } while (0)

struct XcdBarrier {
    unsigned* bar; unsigned x;
    volatile LAS unsigned* st;
};

__device__ __forceinline__ XcdBarrier xcd_barrier_post(unsigned* bar, volatile LAS unsigned* st) {
    XcdBarrier b; b.bar = bar; b.x = xb_xcc_id(); b.st = st;
    if (threadIdx.x == 0) (void)xb_add(&bar[XB_XCNT(b.x)], 1u);
    return b;
}
__device__ __forceinline__ void xcd_barrier_complete(unsigned* bar, unsigned x, unsigned& nloc, unsigned& nx) {
    const unsigned G = gridDim.x * gridDim.y * gridDim.z;
    unsigned sum, cnt, mine, sp = 0u;
    for (;;) {
        sum = 0u; cnt = 0u; mine = 0u;
#pragma unroll
        for (unsigned j = 0; j < 16; ++j) { const unsigned c = xb_ld(&bar[XB_XCNT(j)]); sum += c; cnt += (c > 0u) ? 1u : 0u; mine = (j == x) ? c : mine; }
        if (sum == G) break;
        __builtin_amdgcn_s_sleep(1);
        if ((++sp & 255u) == 0u) { if (xb_ld(&bar[XB_TMO])) break; if (sp > XB_SPIN_CAP) { atomicAdd(&bar[XB_TMO], 1u); break; } }
    }
    nloc = mine > 0u ? mine : 1u; nx = cnt > 0u ? cnt : 1u;
}

__device__ __forceinline__ void xcd_barrier(const XcdBarrier& b) {
    asm volatile("s_waitcnt vmcnt(0)" ::: "memory");
    __syncthreads();
    if (threadIdx.x == 0) {
        unsigned* bar = b.bar;
        __builtin_amdgcn_s_waitcnt(0);
        unsigned nloc = b.st[0], nx = b.st[1];
        if (nloc == 0u) { xcd_barrier_complete(bar, b.x, nloc, nx); b.st[0] = nloc; b.st[1] = nx; }
        const unsigned old = xb_add(&bar[XB_XSUB(b.x)], 1u);
        const unsigned gen = old / nloc;
        if (old + 1u == (gen + 1u) * nloc) {
            __builtin_amdgcn_fence(__ATOMIC_RELEASE, "agent");
            asm volatile("s_waitcnt vmcnt(0)" ::: "memory");
            const unsigned og = xb_add(&bar[XB_TOP], 1u);
            const unsigned tg = og / nx;
            if (og + 1u == (tg + 1u) * nx) xb_add(&bar[XB_TOPGEN], 1u);
            else XB_SPIN(xb_ld(&bar[XB_TOPGEN]) == tg, bar);
            __builtin_amdgcn_fence(__ATOMIC_ACQUIRE, "agent");
            xb_add(&bar[XB_XGEN(b.x)], 1u);
            asm volatile("s_waitcnt vmcnt(0)" ::: "memory");
        } else {
            XB_SPIN(xb_ld(&bar[XB_XGEN(b.x)]) == gen, bar);
            __builtin_amdgcn_fence(__ATOMIC_ACQUIRE, "agent");
            asm volatile("s_waitcnt vmcnt(0)" ::: "memory");
        }
    }
    __syncthreads();
}


constexpr int NPHASE = 15;
#ifndef MK_SPLIT
#define MK_SPLIT 0
#endif
__global__ void __launch_bounds__(NTHREADS, 2) fwd_megakernel(Params p) {
    extern __shared__ __attribute__((aligned(16))) unsigned char lds_raw[];
    Ctx c; c.lds = (LAS unsigned char*)lds_raw; c.tid = threadIdx.x; c.lane = c.tid & 63; c.wave = __builtin_amdgcn_readfirstlane(c.tid >> 6);
    c.G = gridDim.x; c.bid = blockIdx.x; c.gw = c.bid * NWAVES + c.wave; c.ngw = c.G * NWAVES;
    unsigned char* ws = p.ws;
    const int lo = p.ph_lo, hi = p.ph_hi;
#ifdef ONLY_PHASE
#define IN(k) ((k) == ONLY_PHASE && lo <= (k) && (k) < hi)
#else
#define IN(k) (lo <= (k) && (k) < hi)
#endif
#if MK_SPLIT
#define SEAM(k) do { } while (0)
#else
    cg::grid_group grid = cg::this_grid();
    { volatile LAS unsigned* st = (volatile LAS unsigned*)(c.lds + LDS_BYTES - 16); if (c.tid < 4) st[c.tid] = 0u; }
    __syncthreads();
    const XcdBarrier xbar = xcd_barrier_post((unsigned*)(ws + WS_CTL) + CW_XBAR, (volatile LAS unsigned*)(c.lds + LDS_BYTES - 16));
#define SEAM(k) do { if (IN(k) && IN((k) + 1)) { if ((k) == 0) grid.sync(); else xcd_barrier(xbar); } } while (0)
#endif
#ifndef DBL_PHASE
#define DBL_PHASE -1
#endif
#define PH(k, ...) if (IN(k)) { __VA_ARGS__; if (DBL_PHASE == (k)) { xcd_barrier(xbar); __VA_ARGS__; } }
    PH(0, phase0(p, c))
    SEAM(0);
    PH(1, { pg8::DenseOrder S; S.init(MTOK, 5376, 1024, c.G, c.bid, ws + WS_XB, ws + WS_WIN_T);
        pg8::EpiInProj E{(bf16*)(ws + WS_PRKV), (bf16*)(ws + WS_PLR), (bf16*)(ws + WS_PQ), (bf16*)(ws + WS_PK), (bf16*)(ws + WS_PAV), (bf16*)(ws + WS_PG)};
        pg8::gemm_phase<pg8::EpiInProj, pg8::DenseOrder, true, true>(c.lds, 1024, S, E); })
    SEAM(1);
    if (IN(2)) phase2(p, c);
    SEAM(2);
    PH(3, { kmean_items(p, c); pg8::DenseOrder S; S.init(MTOK, 1536, 256, c.G, c.bid, ws + WS_ALORA, ws + WS_WLORA_T);
        pg8::EpiPlainBf16 E{(bf16*)(ws + WS_LORA), 1536};
        pg8::gemm_phase<pg8::EpiPlainBf16, pg8::DenseOrder, true, true>(c.lds, 256, S, E); })
    SEAM(3);
    { PROBE_T0(5); if (IN(4)) scan_prep(p, c); PROBE_T1(5, ws); }
    SEAM(4);
    if (IN(5)) {
        { PROBE_T0(1); for (int bh = c.bid; bh < NB * NHEAD; bh += c.G) scan_chain(p, c, bh); PROBE_T1(1, ws); }
        { int* ctl = (int*)(ws + WS_CTL); LAS int* qs = (LAS int*)(c.lds + 65536);
          for (;;) { if (c.tid == 0) *qs = atomicAdd(ctl + CW_ATTQ, 1);
              __syncthreads(); const int u = *qs; __syncthreads();
              if (u >= 1024) break;
              const int qb = 15 - (u >> 6), bh = u & 63; att::unit(p, c, bh >> 3, bh & 7, qb, (bf16*)(ws + WS_PQ)); } }
    }
    SEAM(5);
    PH(6, phase6(p, c))
    SEAM(6);
    PH(7, { pg8::DenseOrder S; S.init(MTOK, 1024, 512, c.G, c.bid, ws + WS_YRWKV, ws + WS_WR_T);
        pg8::EpiGateF32 E{(float*)(ws + WS_TMP), (const bf16*)(ws + WS_PG), 0};
        pg8::gemm_phase<pg8::EpiGateF32, pg8::DenseOrder, true, true>(c.lds, 512, S, E); })
    SEAM(7);
    PH(8, { pg8::DenseOrder S; S.init(MTOK, 1024, 512, c.G, c.bid, ws + WS_PQ, ws + WS_WA_T);
        pg8::EpiGateAddBf16 E{(const float*)(ws + WS_TMP), (const bf16*)(ws + WS_PG), 1024, (bf16*)(ws + WS_MERGED)};
        pg8::gemm_phase<pg8::EpiGateAddBf16, pg8::DenseOrder, true, true>(c.lds, 512, S, E); })
    SEAM(8);
    PH(9, { pg8::DenseOrder S; S.init(MTOK, 1024, 1024, c.G, c.bid, ws + WS_MERGED, ws + WS_WO_T);
        pg8::EpiResF32 E{(float*)(ws + WS_XPRE), p.in[0], DN_ALPHA};
        pg8::gemm_phase<pg8::EpiResF32, pg8::DenseOrder, true, true>(c.lds, 1024, S, E); })
    SEAM(9);
    if (IN(10)) { if (DBL_PHASE == 10) { phase9(p, c, true); } phase9(p, c); }
    SEAM(10);
    if (IN(11)) phase10(p, c);
    SEAM(11);
    PH(12, { const int* ctl = (const int*)(ws + WS_CTL);
        pg8::MoeOrder<true> S{(const int*)(ws + WS_ROWTOK), ctl + CW_TILE_E, ctl[CW_NTILES], 8, c.G, c.bid, (const char*)(ws + WS_X1B), (const char*)(ws + WS_W1T), (size_t)256 * 1024, (size_t)2048 * 1024};
        pg8::EpiSwiglu E{ws + WS_ACT, p.in[23], 1.0f / W1_SCALE};
        pg8::gemm_phase<pg8::EpiSwiglu, pg8::MoeOrder<true>, true, true, 1>(c.lds, 1024, S, E); })
    SEAM(12);
    PH(13, { const int* ctl = (const int*)(ws + WS_CTL);
        pg8::MoeOrder<false> S{nullptr, ctl + CW_TILE_E, ctl[CW_NTILES], 4, c.G, c.bid, (const char*)(ws + WS_ACT), (const char*)(ws + WS_W2T), (size_t)256 * 1024, (size_t)1024 * 1024};
        pg8::EpiMoe2 E{(bf16*)(ws + WS_YBUF), p.in[25], (const float*)(ws + WS_ROWW), 1.0f / W2_SCALE};
        pg8::gemm_phase<pg8::EpiMoe2, pg8::MoeOrder<false>, true, true, 1>(c.lds, 1024, S, E); })
    SEAM(13);
    PH(14, phase14(p, c))
#undef PH
    if (PROBE_ID != 0 && blockIdx.x == 0 && threadIdx.x == 0) { const unsigned ticks = __hip_atomic_load((unsigned*)(ws + WS_CTL) + CW_PROBE, __ATOMIC_RELAXED, __HIP_MEMORY_SCOPE_AGENT); const unsigned long long t0 = __builtin_amdgcn_s_memrealtime(); while (__builtin_amdgcn_s_memrealtime() - t0 < 10ull * ticks) __builtin_amdgcn_s_sleep(8); }
#undef IN
#undef SEAM
}

extern "C" void kernel_launch(void* const* d_in, const int* in_sizes, int n_in, void* d_out, int out_size, void* d_ws, size_t ws_size, hipStream_t stream) {
    static int grid = 0;
    if (grid == 0) {
        if (n_in != 26 || in_sizes[0] != MTOK * DMODEL || out_size != MTOK * DMODEL || ws_size < WS_END) {
            fprintf(stderr, "kernel_launch: unexpected shapes / workspace (n_in %d, in0 %d, out %d, ws %zu, need %zu); nothing launched\n", n_in, n_in > 0 ? in_sizes[0] : -1, out_size, ws_size, (size_t)WS_END); grid = -1; return; }
        int dev = 0, cus = 0, per_cu = 0;
        hipGetDevice(&dev); hipDeviceGetAttribute(&cus, hipDeviceAttributeMultiprocessorCount, dev);
        hipFuncSetAttribute((const void*)fwd_megakernel, hipFuncAttributeMaxDynamicSharedMemorySize, LDS_BYTES);
        hipOccupancyMaxActiveBlocksPerMultiprocessor(&per_cu, (const void*)fwd_megakernel, NTHREADS, LDS_BYTES);
        (void)hipGetLastError();
        if (per_cu < 1) { fprintf(stderr, "kernel_launch: occupancy query says %d blocks per CU\n", per_cu); per_cu = 1; }
        grid = cus;
    }
    if (grid < 0) return;
    hipMemsetAsync((char*)d_ws + WS_CTL, 0, CTL_BYTES, stream);
    Params p{};
    for (int i = 0; i < 26; ++i) p.in[i] = (const float*)d_in[i];
    p.out = (float*)d_out; p.ws = (unsigned char*)d_ws;
#if MK_SPLIT
    for (int ph = 0; ph < NPHASE; ++ph) { p.ph_lo = ph; p.ph_hi = ph + 1; hipLaunchKernelGGL(fwd_megakernel, dim3(grid), dim3(NTHREADS), LDS_BYTES, stream, p); }
#else
    p.ph_lo = 0; p.ph_hi = NPHASE;
    void* args[] = {&p};
    hipError_t e = hipLaunchCooperativeKernel((const void*)fwd_megakernel, dim3(grid), dim3(NTHREADS), args, LDS_BYTES, stream);
    if (e != hipSuccess) fprintf(stderr, "cooperative launch failed: %s (grid %d)\n", hipGetErrorString(e), grid);
#endif
}
```

```cpp
#include <hip/hip_runtime.h>
#include <hip/hip_cooperative_groups.h>
#include <cstdio>
#include <cstdint>
namespace cg = cooperative_groups;

namespace pg8 {
#define PG8_LAS __attribute__((address_space(3)))
typedef unsigned short bf16_t;
typedef short bf16x8 __attribute__((ext_vector_type(8)));
typedef float f32x4 __attribute__((ext_vector_type(4)));
typedef float f32x2 __attribute__((ext_vector_type(2)));
typedef unsigned u32x4 __attribute__((ext_vector_type(4)));
typedef unsigned u32x2 __attribute__((ext_vector_type(2)));
typedef int i32x4 __attribute__((ext_vector_type(4)));
typedef int i32x8 __attribute__((ext_vector_type(8)));
constexpr int BM = 256, BK = 64, HALF = 128, HTB = HALF * BK * 2  , STAGE_BYTES = 8 * HTB, NXCD = 8, WGM = 8;

__host__ __device__ __forceinline__ int lds_byte(int r, int c) { const int st = (r >> 4) * 2 + (c >> 5), rr = r & 15, cc = c & 31, ob = rr * 64 + cc * 2; return st * 1024 + (ob ^ (((ob >> 9) & 1) << 5)); }
__host__ __device__ __forceinline__ void stage_rc(int b, int& R, int& C) { const int st = b / 1024, sb = b % 1024, swz = sb ^ (((sb >> 9) & 1) << 5); R = (st >> 1) * 16 + swz / 64; C = (st & 1) * 32 + (swz % 64) / 2; }
__host__ __device__ __forceinline__ int perm32(int rho) { const int n = rho >> 4, i = rho & 15; return 8 * (i >> 2) + 4 * n + (i & 3); }

struct Unit { int pm, pn, aux; const char* A; const char* B; };

struct DenseOrder {
    static constexpr bool GATHER = false; const int* rowmap;
    int nM, nN, nwg, G, c; const char* A; const char* B; size_t tstep;
    __device__ __forceinline__ void init(int M, int N, int K, int G_, int c_, const void* A_, const void* B_) { nM = M / BM; nN = N / BM; nwg = nM * nN; G = G_; c = c_; A = (const char*)A_; B = (const char*)B_; tstep = (size_t)BM * K * 2; }
    __device__ __forceinline__ bool next(int i, Unit& u) const {
        const long L = (long)i * G + c; if (L >= nwg) return false;
        int wgid = (int)L; { const int q = nwg / NXCD, r = nwg % NXCD, xcd = wgid % NXCD, off = wgid / NXCD; wgid = (xcd < r ? xcd * (q + 1) : r * (q + 1) + (xcd - r) * q) + off; }
        const int nig = WGM * nN, gid = wgid / nig, fm = gid * WGM, gsz = (nM - fm) < WGM ? (nM - fm) : WGM;
        u.pm = fm + ((wgid % nig) % gsz); u.pn = (wgid % nig) / gsz; u.aux = 0;
        u.A = A + (size_t)u.pm * tstep; u.B = B + (size_t)u.pn * tstep; return true;
    }
    __device__ __forceinline__ void a_ready(const Unit&) const {}
    __device__ __forceinline__ void done(const Unit&) const {}
};
template <bool GATHER_> struct MoeOrder {
    static constexpr bool GATHER = GATHER_; const int* rowmap;
    const int* tile_e; int ntiles, npn, G, c; const char* A; const char* B; size_t tstep, estride;
    __device__ __forceinline__ bool next(int i, Unit& u) const {
        const long L = (long)i * G + c; if (L >= (long)ntiles * npn) return false;
        const int tile = (int)(L / npn), pn = (int)(L % npn); const int e = tile_e[tile];
        u.pm = tile; u.pn = pn; u.aux = e; u.A = GATHER_ ? A : A + (size_t)tile * tstep; u.B = B + (size_t)e * estride + (size_t)pn * tstep; return true;
    }
    __device__ __forceinline__ void a_ready(const Unit&) const {}
    __device__ __forceinline__ void done(const Unit&) const {}
};

__device__ __forceinline__ unsigned cvt_pk_bf16(float lo, float hi) { unsigned r; asm volatile("v_cvt_pk_bf16_f32 %0, %1, %2" : "=v"(r) : "v"(lo), "v"(hi)); return r; }
__device__ __forceinline__ float bf_lo(unsigned w) { return __builtin_bit_cast(float, w << 16); }
__device__ __forceinline__ float bf_hi(unsigned w) { return __builtin_bit_cast(float, w & 0xffff0000u); }
__device__ __forceinline__ float sigm(float x) { return 1.0f / (1.0f + __expf(-x)); }

__device__ __forceinline__ void st8(bf16_t* p, f32x4 v0, f32x4 v1) { u32x4 w; w.x = cvt_pk_bf16(v0[0], v0[1]); w.y = cvt_pk_bf16(v0[2], v0[3]); w.z = cvt_pk_bf16(v1[0], v1[1]); w.w = cvt_pk_bf16(v1[2], v1[3]); *(u32x4*)p = w; }

struct EpiPlainBf16 {
    static constexpr bool PERM = true, AFTER_DRAIN = false;
    bf16_t* O; int ldc;
    __device__ __forceinline__ void operator()(const f32x4 (&acc)[2][2][4][2], const Unit& u, int wr, int wc, int fr, int fq) const {
        const int row0 = u.pm * BM + wr * 64 + fr, col0 = u.pn * BM + wc * 32 + 8 * fq;
#pragma unroll
        for (int ai = 0; ai < 2; ++ai)
#pragma unroll
            for (int m = 0; m < 4; ++m) { bf16_t* rowp = O + (size_t)(row0 + ai * HALF + m * 16) * ldc + col0;
#pragma unroll
                for (int bj = 0; bj < 2; ++bj) st8(rowp + bj * HALF, acc[ai][bj][m][0], acc[ai][bj][m][1]); }
    }
};
struct EpiInProj {
    static constexpr bool PERM = true, AFTER_DRAIN = false;
    bf16_t *rkv, *lr, *q, *k, *v, *g;
    __device__ __forceinline__ void operator()(const f32x4 (&acc)[2][2][4][2], const Unit& u, int wr, int wc, int fr, int fq) const {
        const int pn = u.pn; bf16_t* base; int ldc, colt;
        if (pn < 6) { base = rkv; ldc = 1536; colt = pn * 256; } else if (pn == 6) { base = lr; ldc = 256; colt = 0; }
        else if (pn < 9) { base = q; ldc = 512; colt = (pn - 7) * 256; } else if (pn < 11) { base = k; ldc = 512; colt = (pn - 9) * 256; }
        else if (pn < 13) { base = v; ldc = 512; colt = (pn - 11) * 256; } else { base = g; ldc = 2048; colt = (pn - 13) * 256; }
        const int row0 = u.pm * BM + wr * 64 + fr, col0 = colt + wc * 32 + 8 * fq; const float sc = (pn == 7 || pn == 8) ? 0.125f * 1.4426950408889634f : 1.0f;
#pragma unroll
        for (int ai = 0; ai < 2; ++ai)
#pragma unroll
            for (int m = 0; m < 4; ++m) { bf16_t* rowp = base + (size_t)(row0 + ai * HALF + m * 16) * ldc + col0;
#pragma unroll
                for (int bj = 0; bj < 2; ++bj) st8(rowp + bj * HALF, acc[ai][bj][m][0] * sc, acc[ai][bj][m][1] * sc); }
    }
};
struct EpiGateF32 {
    static constexpr bool PERM = true, AFTER_DRAIN = false;
    float* T; const bf16_t* G; int goff;
    __device__ __forceinline__ void operator()(const f32x4 (&acc)[2][2][4][2], const Unit& u, int wr, int wc, int fr, int fq) const {
        const int row0 = u.pm * BM + wr * 64 + fr, col0 = u.pn * BM + wc * 32 + 8 * fq;
#pragma unroll
        for (int ai = 0; ai < 2; ++ai)
#pragma unroll
            for (int m = 0; m < 4; ++m) { const size_t row = (size_t)(row0 + ai * HALF + m * 16);
#pragma unroll
                for (int bj = 0; bj < 2; ++bj) { const int col = col0 + bj * HALF; const u32x4 gw = *(const u32x4*)(G + row * 2048 + goff + col);
                    f32x4 a = acc[ai][bj][m][0], b = acc[ai][bj][m][1];
                    a[0] *= sigm(bf_lo(gw.x)); a[1] *= sigm(bf_hi(gw.x)); a[2] *= sigm(bf_lo(gw.y)); a[3] *= sigm(bf_hi(gw.y));
                    b[0] *= sigm(bf_lo(gw.z)); b[1] *= sigm(bf_hi(gw.z)); b[2] *= sigm(bf_lo(gw.w)); b[3] *= sigm(bf_hi(gw.w));
                    *(f32x4*)(T + row * 1024 + col) = a; *(f32x4*)(T + row * 1024 + col + 4) = b; } }
    }
};
struct EpiGateAddBf16 {
    static constexpr bool PERM = true, AFTER_DRAIN = false;
    const float* T; const bf16_t* G; int goff; bf16_t* O;
    __device__ __forceinline__ void operator()(const f32x4 (&acc)[2][2][4][2], const Unit& u, int wr, int wc, int fr, int fq) const {
        const int row0 = u.pm * BM + wr * 64 + fr, col0 = u.pn * BM + wc * 32 + 8 * fq;
#pragma unroll
        for (int ai = 0; ai < 2; ++ai)
#pragma unroll
            for (int m = 0; m < 4; ++m) { const size_t row = (size_t)(row0 + ai * HALF + m * 16);
#pragma unroll
                for (int bj = 0; bj < 2; ++bj) { const int col = col0 + bj * HALF; const u32x4 gw = *(const u32x4*)(G + row * 2048 + goff + col);
                    f32x4 a = acc[ai][bj][m][0], b = acc[ai][bj][m][1]; const f32x4 ta = *(const f32x4*)(T + row * 1024 + col), tb = *(const f32x4*)(T + row * 1024 + col + 4);
                    a[0] = ta[0] + a[0] * sigm(bf_lo(gw.x)); a[1] = ta[1] + a[1] * sigm(bf_hi(gw.x)); a[2] = ta[2] + a[2] * sigm(bf_lo(gw.y)); a[3] = ta[3] + a[3] * sigm(bf_hi(gw.y));
                    b[0] = tb[0] + b[0] * sigm(bf_lo(gw.z)); b[1] = tb[1] + b[1] * sigm(bf_hi(gw.z)); b[2] = tb[2] + b[2] * sigm(bf_lo(gw.w)); b[3] = tb[3] + b[3] * sigm(bf_hi(gw.w));
                    st8(O + row * 1024 + col, a, b); } }
    }
};
struct EpiResF32 {
    static constexpr bool PERM = false, AFTER_DRAIN = false;
    float* C; const float* X; float alpha;
    __device__ __forceinline__ void operator()(const f32x4 (&acc)[2][2][4][2], const Unit& u, int wr, int wc, int fr, int fq) const {
        const int row0 = u.pm * BM + wr * 64 + fr, col0 = u.pn * BM + wc * 32 + 4 * fq;
#pragma unroll
        for (int ai = 0; ai < 2; ++ai)
#pragma unroll
            for (int m = 0; m < 4; ++m) { const size_t off = (size_t)(row0 + ai * HALF + m * 16) * 1024 + col0;
#pragma unroll
                for (int bj = 0; bj < 2; ++bj)
#pragma unroll
                    for (int n = 0; n < 2; ++n) { const f32x4 xv = *(const f32x4*)(X + off + bj * HALF + n * 16); *(f32x4*)(C + off + bj * HALF + n * 16) = acc[ai][bj][m][n] + xv * alpha; } }
    }
};
__device__ __forceinline__ unsigned pk4_fp8(float a, float b, float c, float d) { int w = 0; w = __builtin_amdgcn_cvt_pk_fp8_f32(a, b, w, false); w = __builtin_amdgcn_cvt_pk_fp8_f32(c, d, w, true); return (unsigned)w; }
struct EpiSwiglu {
    static constexpr bool PERM = true, AFTER_DRAIN = false;
    unsigned char* O; const float* bin; float sc;
    __device__ __forceinline__ void operator()(const f32x4 (&acc)[2][2][4][2], const Unit& u, int wr, int wc, int fr, int fq) const {
        const int row0 = u.pm * BM + wr * 64 + fr, c0 = u.pn * HALF + wc * 32 + 8 * fq; const float* bb = bin + (size_t)u.aux * 2048 + c0;
        const f32x4 bg0 = *(const f32x4*)(bb), bg1 = *(const f32x4*)(bb + 4), bl0 = *(const f32x4*)(bb + 1024), bl1 = *(const f32x4*)(bb + 1028);
#pragma unroll
        for (int ai = 0; ai < 2; ++ai)
#pragma unroll
            for (int m = 0; m < 4; ++m) { const size_t row = (size_t)(row0 + ai * HALF + m * 16);
                f32x4 o0, o1; const f32x4 g0 = acc[ai][0][m][0] * sc + bg0, g1 = acc[ai][0][m][1] * sc + bg1, l0 = acc[ai][1][m][0] * sc + bl0, l1 = acc[ai][1][m][1] * sc + bl1;
#pragma unroll
                for (int j = 0; j < 4; ++j) { const float ga = fminf(g0[j], 7.0f), la = fminf(fmaxf(l0[j], -7.0f), 7.0f); o0[j] = ga * sigm(1.702f * ga) * (la + 1.0f);
                                              const float gb = fminf(g1[j], 7.0f), lb = fminf(fmaxf(l1[j], -7.0f), 7.0f); o1[j] = gb * sigm(1.702f * gb) * (lb + 1.0f); }
                u32x2 w; w.x = pk4_fp8(o0[0], o0[1], o0[2], o0[3]); w.y = pk4_fp8(o1[0], o1[1], o1[2], o1[3]); *(u32x2*)(O + row * 1024 + c0) = w; }
    }
};
struct EpiMoe2 {
    static constexpr bool PERM = true, AFTER_DRAIN = false;
    bf16_t* O; const float* bout; const float* roww; float sc;
    __device__ __forceinline__ void operator()(const f32x4 (&acc)[2][2][4][2], const Unit& u, int wr, int wc, int fr, int fq) const {
        const int row0 = u.pm * BM + wr * 64 + fr, col0 = u.pn * BM + wc * 32 + 8 * fq; const float* bb = bout + (size_t)u.aux * 1024 + col0;
        f32x4 bv[2][2];
#pragma unroll
        for (int bj = 0; bj < 2; ++bj) { bv[bj][0] = *(const f32x4*)(bb + bj * HALF); bv[bj][1] = *(const f32x4*)(bb + bj * HALF + 4); }
#pragma unroll
        for (int ai = 0; ai < 2; ++ai)
#pragma unroll
            for (int m = 0; m < 4; ++m) { const size_t row = (size_t)(row0 + ai * HALF + m * 16); const float w = roww[row];
#pragma unroll
                for (int bj = 0; bj < 2; ++bj) st8(O + row * 1024 + col0 + bj * HALF, (acc[ai][bj][m][0] * sc + bv[bj][0]) * w, (acc[ai][bj][m][1] * sc + bv[bj][1]) * w); }
    }
};

template <class Epi, class Sched, bool ALIGN_EPI = false, bool SP2 = false, int ESZ = 2  >
__device__ __forceinline__ void gemm_phase(PG8_LAS unsigned char* lds, const int K, const Sched& S, const Epi& E) {
    const int tid = threadIdx.x, wid = __builtin_amdgcn_readfirstlane(tid >> 6), lane = tid & 63, wr = wid >> 2, wc = wid & 3, fr = lane & 15, fq = lane >> 4;
    const int nt = K * ESZ / (BK * 2);
    unsigned vA0[2], vA1[2], nvA0[2], nvA1[2], voffB[2];
#pragma unroll
    for (int i = 0; i < 2; ++i) { int R, C; stage_rc(tid * 16 + i * 8192, R, C); const int Rb = Epi::PERM ? ((R & ~31) + perm32(R & 31)) : R;
        vA0[i] = (unsigned)(R * K * ESZ + C * 2); vA1[i] = 0u; nvA0[i] = 0u; nvA1[i] = 0u; voffB[i] = (unsigned)(Rb * K * ESZ + C * 2); }
    const size_t kstep = (size_t)(BK * 2);
    const size_t hstep = (size_t)HALF * K * ESZ;
    const unsigned ldsw = (unsigned)wid * 1024u;
    const int ac0 = ESZ == 2 ? fq * 8 : (fq >> 1) * 32 + (fq & 1) * 16, ac1 = ESZ == 2 ? 32 + fq * 8 : ac0 + 8;
    const int aoffk[2] = {lds_byte(wr * 64 + fr, ac0), lds_byte(wr * 64 + fr, ac1)}, boffk[2] = {lds_byte(wc * 32 + fr, ac0), lds_byte(wc * 32 + fr, ac1)};
#define PG8_SA(b, h) (((b) * 2 + (h)) * HTB)
#define PG8_SB(b, h) ((4 + (b) * 2 + (h)) * HTB)
#define PG8_STAGE(bufoff, gbase, voff) do { _Pragma("unroll") for (int _i = 0; _i < 2; ++_i) \
        __builtin_amdgcn_global_load_lds((const unsigned*)((const char*)(gbase) + (voff)[_i]), (PG8_LAS unsigned*)(lds + (bufoff) + ldsw + _i * 8192), 16, 0, 0); } while (0)
#define PG8_STAGE_A(bufoff, gbase, hf, nx) do { if constexpr (!Sched::GATHER) { PG8_STAGE(bufoff, (gbase) + (hf) * hstep, vA0); } \
        else { if (hf) { PG8_STAGE(bufoff, gbase, vA1); } else { PG8_STAGE(bufoff, gbase, vA0); } } } while (0)
#define PG8_STAGE_AN(bufoff, gbase, hf) do { if constexpr (!Sched::GATHER) { PG8_STAGE(bufoff, (gbase) + (hf) * hstep, vA0); } \
        else { if (hf) { PG8_STAGE(bufoff, gbase, wA1); } else { PG8_STAGE(bufoff, gbase, wA0); } } } while (0)
#define PG8_LDA(dst, b, h) do { _Pragma("unroll") for (int m = 0; m < 4; ++m) { if constexpr (ESZ == 2) { _Pragma("unroll") for (int k = 0; k < 2; ++k) dst[m][k] = *(const PG8_LAS bf16x8*)(lds + PG8_SA(b, h) + aoffk[k] + m * 2048); } \
        else { const i32x4 lo_ = *(const PG8_LAS i32x4*)(lds + PG8_SA(b, h) + aoffk[0] + m * 2048), hi_ = *(const PG8_LAS i32x4*)(lds + PG8_SA(b, h) + aoffk[1] + m * 2048); \
               dst##8[m] = (i32x8){lo_[0], lo_[1], lo_[2], lo_[3], hi_[0], hi_[1], hi_[2], hi_[3]}; } } } while (0)
#define PG8_LDB(dst, b, h) do { _Pragma("unroll") for (int n = 0; n < 2; ++n) { if constexpr (ESZ == 2) { _Pragma("unroll") for (int k = 0; k < 2; ++k) dst[n][k] = *(const PG8_LAS bf16x8*)(lds + PG8_SB(b, h) + boffk[k] + n * 2048); } \
        else { const i32x4 lo_ = *(const PG8_LAS i32x4*)(lds + PG8_SB(b, h) + boffk[0] + n * 2048), hi_ = *(const PG8_LAS i32x4*)(lds + PG8_SB(b, h) + boffk[1] + n * 2048); \
               dst##8[n] = (i32x8){lo_[0], lo_[1], lo_[2], lo_[3], hi_[0], hi_[1], hi_[2], hi_[3]}; } } } while (0)
#define PG8_MMA(ai, bj, At, Bt) do { __builtin_amdgcn_s_setprio(1); _Pragma("unroll") for (int m = 0; m < 4; ++m) _Pragma("unroll") for (int n = 0; n < 2; ++n) { \
        if constexpr (ESZ == 2) { _Pragma("unroll") for (int k = 0; k < 2; ++k) acc[ai][bj][m][n] = __builtin_amdgcn_mfma_f32_16x16x32_bf16(Bt[n][k], At[m][k], acc[ai][bj][m][n], 0, 0, 0); } \
        else { asm volatile("v_mfma_scale_f32_16x16x128_f8f6f4 %0, %1, %2, %0, %3, %3 op_sel_hi:[0,0,0]" : "+v"(acc[ai][bj][m][n]) : "v"(Bt##8[n]), "v"(At##8[m]), "v"(scale1)); } } \
        __builtin_amdgcn_s_setprio(0); } while (0)
#define PG8_WAIT_V(n) asm volatile("s_waitcnt vmcnt(" #n ")" ::: "memory")
#define PG8_WAIT_L(n) asm volatile("s_waitcnt lgkmcnt(" #n ")" ::: "memory")
#define PG8_BAR __builtin_amdgcn_s_barrier()
#define PG8_SCHED __builtin_amdgcn_sched_barrier(0)
    Unit cur, nxt; int ui = 0;
    if (!S.next(0, cur)) return;
    if constexpr (Sched::GATHER) {
#pragma unroll
        for (int i = 0; i < 2; ++i) { int R, C; stage_rc(tid * 16 + i * 8192, R, C); vA0[i] = (unsigned)S.rowmap[cur.pm * BM + R] * (unsigned)(K * ESZ) + (unsigned)C * 2u; vA1[i] = (unsigned)S.rowmap[cur.pm * BM + HALF + R] * (unsigned)(K * ESZ) + (unsigned)C * 2u; nvA0[i] = vA0[i]; nvA1[i] = vA1[i]; }
    }
    f32x4 acc[2][2][4][2];
#pragma unroll
    for (int a = 0; a < 2; ++a)
#pragma unroll
        for (int b = 0; b < 2; ++b)
#pragma unroll
            for (int m = 0; m < 4; ++m)
#pragma unroll
                for (int n = 0; n < 2; ++n) acc[a][b][m][n] = (f32x4){0.f, 0.f, 0.f, 0.f};
    const int scale1 = 0x7F7F7F7F;
    bf16x8 At[4][2], B0[2][2], B1[2][2]; i32x8 At8[4], B08[2], B18[2];
    const char* cA = cur.A; const char* cB = cur.B;
    S.a_ready(cur);
    if constexpr (SP2) {
        PG8_STAGE(PG8_SB(0, 0), cB, voffB); PG8_STAGE(PG8_SB(0, 1), cB + hstep, voffB); PG8_STAGE_A(PG8_SA(0, 0), cA, 0, 0); PG8_STAGE_A(PG8_SA(0, 1), cA, 1, 0);
        if (wr == 1) PG8_BAR;
        PG8_WAIT_V(2); PG8_BAR;
        PG8_STAGE(PG8_SB(1, 0), cB + kstep, voffB); PG8_STAGE_A(PG8_SA(1, 0), cA + kstep, 0, 0); PG8_STAGE(PG8_SB(1, 1), cB + hstep + kstep, voffB);
        PG8_WAIT_V(6); PG8_BAR;
    } else {
        PG8_STAGE(PG8_SB(0, 0), cB, voffB); PG8_STAGE_A(PG8_SA(0, 0), cA, 0, 0); PG8_STAGE(PG8_SB(0, 1), cB + hstep, voffB); PG8_STAGE_A(PG8_SA(0, 1), cA, 1, 0);
        if (wr == 1) PG8_BAR;
        PG8_WAIT_V(4); PG8_BAR;
        PG8_STAGE(PG8_SB(1, 0), cB + kstep, voffB); PG8_STAGE_A(PG8_SA(1, 0), cA + kstep, 0, 0); PG8_STAGE(PG8_SB(1, 1), cB + hstep + kstep, voffB);
        PG8_WAIT_V(6); PG8_BAR;
    }
    for (;;) {
        const bool has_next = S.next(ui + 1, nxt);
        const char* nA = has_next ? nxt.A : cA; const char* nB = has_next ? nxt.B : cB;
        if constexpr (Sched::GATHER) { if (has_next) {
#pragma unroll
            for (int i = 0; i < 2; ++i) { int R, C; stage_rc(tid * 16 + i * 8192, R, C); nvA0[i] = (unsigned)S.rowmap[nxt.pm * BM + R] * (unsigned)(K * ESZ) + (unsigned)C * 2u; nvA1[i] = (unsigned)S.rowmap[nxt.pm * BM + HALF + R] * (unsigned)(K * ESZ) + (unsigned)C * 2u; } } }
#pragma unroll 1
        for (int t = 0; t < nt; t += 2) {
            const bool last = (t == nt - 2);
            const char* a1 = cA + (size_t)(t + 1) * kstep;
            const char* a2 = last ? nA : cA + (size_t)(t + 2) * kstep; const char* b2 = last ? nB : cB + (size_t)(t + 2) * kstep;
            const char* a3 = a2 + kstep; const char* b3 = b2 + kstep;
            if (last && has_next) S.a_ready(nxt);
            unsigned wA0[2] = {vA0[0], vA0[1]}, wA1[2] = {vA1[0], vA1[1]}; (void)wA0; (void)wA1;
            if constexpr (Sched::GATHER) { if (last) { asm volatile("" : "+v"(nvA0[0]), "+v"(nvA0[1]), "+v"(nvA1[0]), "+v"(nvA1[1])); wA0[0] = nvA0[0]; wA0[1] = nvA0[1]; wA1[0] = nvA1[0]; wA1[1] = nvA1[1]; } }
            if constexpr (SP2) {
            PG8_LDB(B0, 0, 0); PG8_LDB(B1, 0, 1); PG8_SCHED; PG8_LDA(At, 0, 0); PG8_STAGE_A(PG8_SA(1, 1), a1, 1, 0);
            PG8_WAIT_V(8); PG8_WAIT_L(0); PG8_BAR; PG8_MMA(0, 0, At, B0); PG8_MMA(0, 1, At, B1); PG8_BAR; PG8_SCHED;
            PG8_LDA(At, 0, 1); PG8_STAGE(PG8_SB(0, 0), b2, voffB); PG8_STAGE(PG8_SB(0, 1), b2 + hstep, voffB); PG8_STAGE_AN(PG8_SA(0, 0), a2, 0);
            PG8_WAIT_V(8); PG8_WAIT_L(0); PG8_BAR; PG8_MMA(1, 0, At, B0); PG8_MMA(1, 1, At, B1); PG8_BAR; PG8_SCHED;
            PG8_LDB(B0, 1, 0); PG8_LDB(B1, 1, 1); PG8_SCHED; PG8_LDA(At, 1, 0); PG8_STAGE_AN(PG8_SA(0, 1), a2, 1);
            PG8_WAIT_V(8); PG8_WAIT_L(0); PG8_BAR; PG8_MMA(0, 0, At, B0); PG8_MMA(0, 1, At, B1); PG8_BAR; PG8_SCHED;
            PG8_LDA(At, 1, 1); PG8_STAGE(PG8_SB(1, 0), b3, voffB); PG8_STAGE(PG8_SB(1, 1), b3 + hstep, voffB); PG8_STAGE_AN(PG8_SA(1, 0), a3, 0);
            PG8_WAIT_V(8); PG8_WAIT_L(0); PG8_BAR; PG8_MMA(1, 0, At, B0); PG8_MMA(1, 1, At, B1); PG8_BAR; PG8_SCHED;
            } else {
            PG8_LDB(B0, 0, 0); PG8_SCHED; PG8_LDA(At, 0, 0); PG8_STAGE_A(PG8_SA(1, 1), a1, 1, 0);
            PG8_WAIT_L(8); PG8_BAR; PG8_WAIT_L(0); PG8_MMA(0, 0, At, B0); PG8_BAR; PG8_SCHED;
            PG8_LDB(B1, 0, 1); PG8_STAGE(PG8_SB(0, 0), b2, voffB);
            PG8_BAR; PG8_WAIT_L(0); PG8_MMA(0, 1, At, B1); PG8_BAR;
            PG8_LDA(At, 0, 1); PG8_STAGE_AN(PG8_SA(0, 0), a2, 0);
            PG8_BAR; PG8_WAIT_L(0); PG8_MMA(1, 0, At, B0); PG8_BAR; PG8_SCHED;
            PG8_STAGE(PG8_SB(0, 1), b2 + hstep, voffB);
            PG8_WAIT_V(6); PG8_BAR; PG8_MMA(1, 1, At, B1); PG8_BAR;
            PG8_LDB(B0, 1, 0); PG8_SCHED; PG8_LDA(At, 1, 0); PG8_STAGE_AN(PG8_SA(0, 1), a2, 1);
            PG8_WAIT_L(8); PG8_BAR; PG8_WAIT_L(0); PG8_MMA(0, 0, At, B0); PG8_BAR; PG8_SCHED;
            PG8_LDB(B1, 1, 1); PG8_STAGE(PG8_SB(1, 0), b3, voffB);
            PG8_BAR; PG8_WAIT_L(0); PG8_MMA(0, 1, At, B1); PG8_BAR;
            PG8_LDA(At, 1, 1); PG8_STAGE_AN(PG8_SA(1, 0), a3, 0);
            PG8_BAR; PG8_WAIT_L(0); PG8_MMA(1, 0, At, B0); PG8_BAR; PG8_SCHED;
            PG8_STAGE(PG8_SB(1, 1), b3 + hstep, voffB);
            PG8_WAIT_V(6); PG8_BAR; PG8_MMA(1, 1, At, B1); PG8_BAR;
            }
        }
        if constexpr (ALIGN_EPI) { if (wr == 0) PG8_BAR; }
        if constexpr (ESZ == 1) asm volatile("s_nop 15\n\ts_nop 15" ::: "memory");
        if constexpr (!Epi::AFTER_DRAIN) { E(acc, cur, wr, wc, fr, fq); S.done(cur); }
        if (!has_next) break;
#pragma unroll
        for (int a = 0; a < 2; ++a)
#pragma unroll
            for (int b = 0; b < 2; ++b)
#pragma unroll
                for (int m = 0; m < 4; ++m)
#pragma unroll
                    for (int n = 0; n < 2; ++n) acc[a][b][m][n] = (f32x4){0.f, 0.f, 0.f, 0.f};
        cur = nxt; cA = nA; cB = nB; ++ui;
        if constexpr (Sched::GATHER) { vA0[0] = nvA0[0]; vA0[1] = nvA0[1]; vA1[0] = nvA1[0]; vA1[1] = nvA1[1]; }
        if constexpr (ALIGN_EPI) { if (wr == 1) PG8_BAR; }
    }
    PG8_WAIT_V(0);
    if constexpr (!ALIGN_EPI) { if (wr == 0) PG8_BAR; }
    PG8_BAR;
    if constexpr (Epi::AFTER_DRAIN) { E.fused(acc, cur, wr, wc, fr, fq, lds, wid, lane); S.done(cur); }
#undef PG8_SA
#undef PG8_SB
#undef PG8_STAGE
#undef PG8_STAGE_A
#undef PG8_STAGE_AN
#undef PG8_LDA
#undef PG8_LDB
#undef PG8_MMA
#undef PG8_WAIT_V
#undef PG8_WAIT_L
#undef PG8_BAR
#undef PG8_SCHED
}
}


#define LAS __attribute__((address_space(3)))
typedef unsigned short bf16;
typedef float f32x4 __attribute__((ext_vector_type(4)));
typedef float f32x2 __attribute__((ext_vector_type(2)));
typedef float f32x16 __attribute__((ext_vector_type(16)));
typedef unsigned u32x4 __attribute__((ext_vector_type(4)));
typedef unsigned u32x2 __attribute__((ext_vector_type(2)));
typedef short bf16x8 __attribute__((ext_vector_type(8)));
typedef short s16x4 __attribute__((ext_vector_type(4)));

constexpr int NB = 8, SEQ = 4096, DMODEL = 1024, MTOK = NB * SEQ, NHEAD = 8, HDIM = 64, BRD = 512;
constexpr int NEXP = 32, TOPK = 4, MAXTILES = 544, MAXSLOTS = MAXTILES * 256;
constexpr float DN_ALPHA = 1.189207115002721f, LN_EPS = 1e-5f, GN_EPS = 64e-5f;
constexpr int NWAVES = 8, NTHREADS = 512;
constexpr float W1_SCALE = 32.0f, W2_SCALE = 64.0f;
constexpr int LDS_BYTES = 155648;

constexpr size_t MiB = 1u << 20;
constexpr size_t WS_CTL = 0, CTL_BYTES = 128 * 1024;
constexpr size_t WS_WIN_T = 1 * MiB, WS_WLORA_T = 12 * MiB, WS_WR_T = 13 * MiB, WS_WA_T = 14 * MiB, WS_WO_T = 15 * MiB, WS_W1T = 17 * MiB, WS_W2T = 145 * MiB;
constexpr size_t WS_KMEAN = 209 * MiB, WS_ROPE = 209 * MiB + 512 * 1024, WS_TOKE = 210 * MiB, WS_TOKW = 210 * MiB + 512 * 1024, WS_SLOTOF = 211 * MiB, WS_ROWTOK = 212 * MiB, WS_ROWW = 213 * MiB, WS_INVN = 214 * MiB;
constexpr size_t WS_D = 216 * MiB;
constexpr size_t WS_PG = WS_D, WS_PQ = WS_D + 128 * MiB, WS_PK = WS_D + 160 * MiB, WS_PAV = WS_D + 192 * MiB, WS_PRKV = WS_D + 224 * MiB, WS_PLR = WS_D + 320 * MiB;
constexpr size_t WS_LORA = WS_D + 320 * MiB, WS_ALORA = WS_D + 416 * MiB, WS_XB = WS_D + 432 * MiB, WS_BONUS = WS_D + 416 * MiB;
constexpr size_t WS_YRAW = WS_D + 480 * MiB, WS_YRWKV = WS_D + 544 * MiB, WS_SCANOP = WS_D + 544 * MiB  , WS_TMP = WS_D + 416 * MiB, WS_MERGED = WS_D + 544 * MiB, WS_XPRE = WS_D + 608 * MiB;
constexpr size_t WS_X1 = WS_D, WS_X1B = WS_D + 128 * MiB, WS_XPERM = WS_D + 192 * MiB, WS_ACT = WS_D + 464 * MiB, WS_YBUF = WS_D + 192 * MiB;
constexpr size_t WS_END = WS_D + 800 * MiB;
constexpr int CW_COUNT = 0, CW_NTILES = 64, CW_TILE_E = 128, CW_WGBASE = 1024, CW_XBAR = 16384, CW_ATTQ = 96;

struct Params { const float* in[26]; float* out; unsigned char* ws; int ph_lo, ph_hi; };
struct Ctx { LAS unsigned char* lds; int tid, lane, wave, gw, ngw, G, bid; };
#ifndef PROBE_ID
#define PROBE_ID 0
#endif
constexpr int CW_PROBE = 100;
#define PROBE_T0(id) unsigned long long _pt##id = 0; if (PROBE_ID == (id) && blockIdx.x == 0 && threadIdx.x == 0) _pt##id = __builtin_amdgcn_s_memrealtime()
#define PROBE_T1(id, ws_) do { if (PROBE_ID == (id) && blockIdx.x == 0 && threadIdx.x == 0) { const unsigned long long _d = __builtin_amdgcn_s_memrealtime() - _pt##id; atomicAdd((unsigned*)((ws_) + WS_CTL) + CW_PROBE, (unsigned)_d); } } while (0)

__device__ __forceinline__ unsigned f2bf(float f) { unsigned u = __builtin_bit_cast(unsigned, f); return (u + 0x7fffu + ((u >> 16) & 1u)) >> 16; }
__device__ __forceinline__ unsigned pk2(float lo, float hi) { return f2bf(lo) | (f2bf(hi) << 16); }
typedef __bf16 hw_bf16x2 __attribute__((ext_vector_type(2)));
__device__ __forceinline__ unsigned hwpk2(float lo, float hi) { f32x2 v = {lo, hi}; hw_bf16x2 b = __builtin_convertvector(v, hw_bf16x2); return __builtin_bit_cast(unsigned, b); }
__device__ __forceinline__ float bf2f(bf16 v) { return __builtin_bit_cast(float, (unsigned)v << 16); }
__device__ __forceinline__ float bflo(unsigned w) { return __builtin_bit_cast(float, w << 16); }
__device__ __forceinline__ float bfhi(unsigned w) { return __builtin_bit_cast(float, w & 0xffff0000u); }
__device__ __forceinline__ float wave_sum(float v) {
#pragma unroll
    for (int o = 1; o < 64; o <<= 1) v += __shfl_xor(v, o);
    return v;
}
__device__ __forceinline__ float sigmf(float x) { return 1.0f / (1.0f + __expf(-x)); }
template <int CTRL> __device__ __forceinline__ float dppf(float x) { return __builtin_bit_cast(float, __builtin_amdgcn_update_dpp(0, __builtin_bit_cast(int, x), CTRL, 0xF, 0xF, true)); }
__device__ __forceinline__ float row16_sum(float x) {
    x += dppf<0xB1>(x);
    x += dppf<0x4E>(x);
    x += dppf<0x141>(x);
    x += dppf<0x140>(x);
    return x;
}
__device__ __forceinline__ float sum8(float x) { x += dppf<0xB1>(x); x += dppf<0x4E>(x); x += dppf<0x141>(x); return x; }

__device__ __forceinline__ void transpose_item(const float* W, int K, int N, bf16* WT, int k0, int n0, int dst_row0, LAS float* scr, int lane) {
#pragma unroll 8
    for (int i = 0; i < 32; ++i) { const int kk = 2 * i + (lane >> 5); scr[kk * 33 + (lane & 31)] = W[(size_t)(k0 + kk) * N + n0 + (lane & 31)]; }
    asm volatile("s_waitcnt lgkmcnt(0)" ::: "memory");
    const int c = lane & 7;
#pragma unroll
    for (int j = 0; j < 4; ++j) { const int n = (lane >> 3) + 8 * j; const LAS float* s = scr + (8 * c) * 33 + n;
        u32x4 o; o.x = pk2(s[0 * 33], s[1 * 33]); o.y = pk2(s[2 * 33], s[3 * 33]); o.z = pk2(s[4 * 33], s[5 * 33]); o.w = pk2(s[6 * 33], s[7 * 33]);
        *(u32x4*)(WT + (size_t)(dst_row0 + n) * K + k0 + 8 * c) = o; }
    asm volatile("s_waitcnt lgkmcnt(0)" ::: "memory");
}
__device__ __forceinline__ unsigned pk4f8(float a, float b, float c, float d) { int w = 0; w = __builtin_amdgcn_cvt_pk_fp8_f32(a, b, w, false); w = __builtin_amdgcn_cvt_pk_fp8_f32(c, d, w, true); return (unsigned)w; }
__device__ __forceinline__ void transpose_item_f8(const float* W, int K, int N, unsigned char* WT, int k0, int n0, int dst_row0, float scale, LAS float* scr, int lane) {
#pragma unroll 8
    for (int i = 0; i < 32; ++i) { const int kk = 2 * i + (lane >> 5); scr[kk * 33 + (lane & 31)] = W[(size_t)(k0 + kk) * N + n0 + (lane & 31)] * scale; }
    asm volatile("s_waitcnt lgkmcnt(0)" ::: "memory");
    const int c = lane & 3;
#pragma unroll
    for (int j = 0; j < 2; ++j) { const int n = (lane >> 2) + 16 * j; const LAS float* s = scr + (16 * c) * 33 + n;
        u32x4 o; o.x = pk4f8(s[0 * 33], s[1 * 33], s[2 * 33], s[3 * 33]); o.y = pk4f8(s[4 * 33], s[5 * 33], s[6 * 33], s[7 * 33]); o.z = pk4f8(s[8 * 33], s[9 * 33], s[10 * 33], s[11 * 33]); o.w = pk4f8(s[12 * 33], s[13 * 33], s[14 * 33], s[15 * 33]);
        *(u32x4*)(WT + (size_t)(dst_row0 + n) * K + k0 + 16 * c) = o; }
    asm volatile("s_waitcnt lgkmcnt(0)" ::: "memory");
}
__device__ __forceinline__ void phase0(const Params& p, const Ctx& c) {
    unsigned char* ws = p.ws;
    LAS float* scr = (LAS float*)(c.lds + c.wave * 16384);
    constexpr int I0 = 16 * 168, I1 = 8 * 32, I2 = 8 * 32, I3 = 16 * 32, I4 = 32 * 1024, I5 = 32 * 512, NIT = I0 + I1 + I2 + I3 + I4 + I5;
    for (int it = c.gw; it < NIT; it += c.ngw) {
        int r = it;
        if (r < I0) { transpose_item(p.in[5], 1024, 5376, (bf16*)(ws + WS_WIN_T), 64 * (r / 168), 32 * (r % 168), 32 * (r % 168), scr, c.lane); continue; } r -= I0;
        if (r < I1) { transpose_item(p.in[17], 512, 1024, (bf16*)(ws + WS_WR_T), 64 * (r / 32), 32 * (r % 32), 32 * (r % 32), scr, c.lane); continue; } r -= I1;
        if (r < I2) { transpose_item(p.in[18], 512, 1024, (bf16*)(ws + WS_WA_T), 64 * (r / 32), 32 * (r % 32), 32 * (r % 32), scr, c.lane); continue; } r -= I2;
        if (r < I3) { transpose_item(p.in[19], 1024, 1024, (bf16*)(ws + WS_WO_T), 64 * (r / 32), 32 * (r % 32), 32 * (r % 32), scr, c.lane); continue; } r -= I3;
        if (r < I4) { const int e = r >> 10, rr = r & 1023, n0 = 32 * (rr & 63);
            const int dst = n0 < 1024 ? (n0 >> 7) * 256 + (n0 & 127) : ((n0 - 1024) >> 7) * 256 + 128 + ((n0 - 1024) & 127);
            transpose_item_f8(p.in[22] + (size_t)e * 1024 * 2048, 1024, 2048, ws + WS_W1T + (size_t)e * 2048 * 1024, 64 * (rr >> 6), n0, dst, W1_SCALE, scr, c.lane); continue; } r -= I4;
        { const int e = r >> 9, rr = r & 511; transpose_item_f8(p.in[24] + (size_t)e * 1024 * 1024, 1024, 1024, ws + WS_W2T + (size_t)e * 1024 * 1024, 64 * (rr >> 5), 32 * (rr & 31), 32 * (rr & 31), W2_SCALE, scr, c.lane); }
    }
    const int gt = c.bid * NTHREADS + c.tid, ngt = c.G * NTHREADS;
    { bf16* WL = (bf16*)(ws + WS_WLORA_T); const float* du = p.in[8]; const float* iu = p.in[10]; const float* gu = p.in[11];
      for (int i = gt; i < 1536 * 256; i += ngt) { const int n = i >> 8, k = i & 255; float v = 0.f;
          if (n < 512) { if (k < 64) v = du[k * 512 + n]; } else if (n < 1024) { if (k >= 64 && k < 128) v = iu[(k - 64) * 512 + (n - 512)]; } else { if (k >= 128) v = gu[(k - 128) * 512 + (n - 1024)]; }
          WL[i] = (bf16)f2bf(v); } }
    { float* RT = (float*)(ws + WS_ROPE); for (int i = gt; i < SEQ * 8; i += ngt) { const int pos = i >> 3, j = i & 7; float sn, cs; sincosf((float)pos * powf(500000.0f, -(float)j * 0.125f), &sn, &cs); RT[pos * 16 + j] = cs; RT[pos * 16 + 8 + j] = sn; }
      int* RTK = (int*)(ws + WS_ROWTOK); for (int i = gt; i < MAXSLOTS; i += ngt) RTK[i] = 0;
      float* KMz = (float*)(ws + WS_KMEAN); for (int i = gt; i < NB * NHEAD * 16 * 64; i += ngt) KMz[i] = 0.f; }
    { const f32x4* x4 = (const f32x4*)p.in[0]; u32x2* o = (u32x2*)(ws + WS_XB);
      for (int i = gt; i < MTOK * DMODEL / 4; i += ngt) { const f32x4 v = x4[i]; u32x2 w; w.x = pk2(v[0], v[1]); w.y = pk2(v[2], v[3]); o[i] = w; } }
}

__device__ __forceinline__ void phase2(const Params& p, const Ctx& c) {
    unsigned char* ws = p.ws;
    { const bf16* __restrict__ PLR = (const bf16*)(ws + WS_PLR); bf16* __restrict__ AL = (bf16*)(ws + WS_ALORA); const float* mix = p.in[6] + 1536;
      const int j0 = c.lane * 4; const f32x4 mx = *(const f32x4*)(mix + j0);
      for (int m0 = 4 * c.gw; m0 < MTOK; m0 += 4 * c.ngw) {
          u32x2 r[5]; u32x2 z; z.x = 0u; z.y = 0u; r[0] = z;
          if ((m0 & (SEQ - 1)) != 0) r[0] = *(const u32x2*)(PLR + (size_t)(m0 - 1) * 256 + j0);
#pragma unroll
          for (int u = 0; u < 4; ++u) r[u + 1] = *(const u32x2*)(PLR + (size_t)(m0 + u) * 256 + j0);
#pragma unroll
          for (int u = 0; u < 4; ++u) { const f32x4 cu = {bflo(r[u + 1].x), bfhi(r[u + 1].x), bflo(r[u + 1].y), bfhi(r[u + 1].y)}, pv = {bflo(r[u].x), bfhi(r[u].x), bflo(r[u].y), bfhi(r[u].y)};
              f32x4 s = cu + (pv - cu) * mx;
#pragma unroll
              for (int i = 0; i < 4; ++i) { if (c.lane < 16) s[i] = tanhf(s[i]); else if (c.lane >= 32) s[i] = sigmf(s[i]); }
              u32x2 o; o.x = pk2(s[0], s[1]); o.y = pk2(s[2], s[3]); *(u32x2*)(AL + (size_t)(m0 + u) * 256 + j0) = o; } } }
    { bf16* Q = (bf16*)(ws + WS_PQ); bf16* K = (bf16*)(ws + WS_PK); const float* RT = (const float*)(ws + WS_ROPE);
      for (int g = c.gw; g < MTOK / 4; g += c.ngw) { const int tok = 4 * g + (c.lane >> 4), which = (c.lane >> 3) & 1, h = c.lane & 7;
          bf16* P = (which ? K : Q) + (size_t)tok * 512 + h * 64; const float* rt = RT + (size_t)(tok & (SEQ - 1)) * 16;
          const u32x4 a = *(const u32x4*)P, bq = *(const u32x4*)(P + 8); const f32x4 c0 = *(const f32x4*)rt, c1 = *(const f32x4*)(rt + 4), s0 = *(const f32x4*)(rt + 8), s1 = *(const f32x4*)(rt + 12);
          const float x1[8] = {bflo(a.x), bfhi(a.x), bflo(a.y), bfhi(a.y), bflo(a.z), bfhi(a.z), bflo(a.w), bfhi(a.w)}, x2[8] = {bflo(bq.x), bfhi(bq.x), bflo(bq.y), bfhi(bq.y), bflo(bq.z), bfhi(bq.z), bflo(bq.w), bfhi(bq.w)};
          const float cs[8] = {c0[0], c0[1], c0[2], c0[3], c1[0], c1[1], c1[2], c1[3]}, sn[8] = {s0[0], s0[1], s0[2], s0[3], s1[0], s1[1], s1[2], s1[3]};
          float o1[8], o2[8];
#pragma unroll
          for (int i = 0; i < 8; ++i) { o1[i] = x1[i] * cs[i] - x2[i] * sn[i]; o2[i] = x2[i] * cs[i] + x1[i] * sn[i]; }
          u32x4 w1, w2; w1.x = pk2(o1[0], o1[1]); w1.y = pk2(o1[2], o1[3]); w1.z = pk2(o1[4], o1[5]); w1.w = pk2(o1[6], o1[7]); w2.x = pk2(o2[0], o2[1]); w2.y = pk2(o2[2], o2[3]); w2.z = pk2(o2[4], o2[5]); w2.w = pk2(o2[6], o2[7]);
          *(u32x4*)P = w1; *(u32x4*)(P + 8) = w2; } }
    { const bf16* __restrict__ RKV = (const bf16*)(ws + WS_PRKV); float* __restrict__ INVN = (float*)(ws + WS_INVN); const int ch = 8 * c.lane;
      const f32x4 mk0 = *(const f32x4*)(p.in[6] + 512 + ch), mk1 = *(const f32x4*)(p.in[6] + 512 + ch + 4), kc0 = *(const f32x4*)(p.in[12] + ch), kc1 = *(const f32x4*)(p.in[12] + ch + 4);
      for (int m0 = 2 * c.gw; m0 < MTOK; m0 += 2 * c.ngw) { u32x4 cu[2], pv[2];
#pragma unroll
          for (int u = 0; u < 2; ++u) { const size_t m = (size_t)(m0 + u); cu[u] = *(const u32x4*)(RKV + m * 1536 + 512 + ch); pv[u] = (u32x4){0u, 0u, 0u, 0u}; if (((m0 + u) & (SEQ - 1)) != 0) pv[u] = *(const u32x4*)(RKV + (m - 1) * 1536 + 512 + ch); }
#pragma unroll
          for (int u = 0; u < 2; ++u) { const f32x4 k0 = {bflo(cu[u].x), bfhi(cu[u].x), bflo(cu[u].y), bfhi(cu[u].y)}, k1 = {bflo(cu[u].z), bfhi(cu[u].z), bflo(cu[u].w), bfhi(cu[u].w)};
              const f32x4 q0 = {bflo(pv[u].x), bfhi(pv[u].x), bflo(pv[u].y), bfhi(pv[u].y)}, q1 = {bflo(pv[u].z), bfhi(pv[u].z), bflo(pv[u].w), bfhi(pv[u].w)};
              const f32x4 a = (k0 + (q0 - k0) * mk0) * kc0, bq = (k1 + (q1 - k1) * mk1) * kc1;
              float ss = ((a[0] * a[0] + a[1] * a[1]) + (a[2] * a[2] + a[3] * a[3])) + ((bq[0] * bq[0] + bq[1] * bq[1]) + (bq[2] * bq[2] + bq[3] * bq[3])); ss = sum8(ss);
              if ((c.lane & 7) == 0) INVN[(size_t)(m0 + u) * 8 + (c.lane >> 3)] = 1.0f / fmaxf(sqrtf(ss), 1e-12f); } } }
}
__device__ __forceinline__ void kmean_items(const Params& p, const Ctx& c) {
    const bf16* __restrict__ K = (const bf16*)(p.ws + WS_PK); float* KM = (float*)(p.ws + WS_KMEAN);
    for (int item = c.bid; item < NB * 32; item += c.G) { const int b = item >> 5, blk = (item >> 1) & 15, hf = item & 1, h = c.tid >> 6, d = c.tid & 63; const bf16* kp = K + ((size_t)b * SEQ + blk * 256 + hf * 128) * 512 + c.tid; float s = 0.f;
#pragma unroll 32
        for (int tok = 0; tok < 128; ++tok) s += bf2f(kp[(size_t)tok * 512]);
        atomicAdd(KM + ((size_t)((b * 8 + h) * 16 + blk)) * 64 + d, s * (1.0f / 256.0f)); }
}

__device__ __forceinline__ float wave_sum_dpp(float x) {
    x = row16_sum(x);
    x += __builtin_bit_cast(float, __builtin_amdgcn_update_dpp(0, __builtin_bit_cast(int, x), 0x142, 0xA, 0xF, false));
    x += __builtin_bit_cast(float, __builtin_amdgcn_update_dpp(0, __builtin_bit_cast(int, x), 0x143, 0xC, 0xF, false));
    return __builtin_bit_cast(float, __builtin_amdgcn_readlane(__builtin_bit_cast(int, x), 63));
}
__device__ __forceinline__ f32x4 unpk4(u32x2 w) { return (f32x4){bflo(w.x), bfhi(w.x), bflo(w.y), bfhi(w.y)}; }
constexpr int CK_NH = 0, CK_RH = 2048, CK_ABT = 4096, CK_KBT = 6144, CK_VT = 8192, CK_GC = 10240, CK_MKAT = 10496, CK_MART = 11008, CK_MKRT = 11520, CK_TMT = 12032, CK_COPY = 12544  , CK_AB = 12544, CK_KB = 14592, CK_MAA = 16640, CK_STRIDE = 17664;
__device__ __forceinline__ float dpp_shr1(float x) { return dppf<0x111>(x); }
__device__ __forceinline__ f32x4 scan16(f32x4 x) {
#pragma unroll
    for (int i = 0; i < 4; ++i) { float v = x[i]; v += dppf<0x111>(v); v += dppf<0x112>(v); v += dppf<0x114>(v); v += dppf<0x118>(v); x[i] = v; }
    return x;
}
__device__ __forceinline__ u32x2 pk4bf(f32x4 v) { u32x2 w; w.x = hwpk2(v[0], v[1]); w.y = hwpk2(v[2], v[3]); return w; }
__device__ __forceinline__ bf16x8 mk8(u32x2 lo, u32x2 hi) { u32x4 w; w.x = lo.x; w.y = lo.y; w.z = hi.x; w.w = hi.y; return __builtin_bit_cast(bf16x8, w); }
__device__ __forceinline__ void ck_load(u32x2 (&raw)[8], float& invn, const bf16* RKVh, const bf16* LOh, const float* INVN, int h, size_t m, bool has_prev) {
    const bf16* row = RKVh + m * 1536;
    raw[0] = *(const u32x2*)(row); raw[1] = *(const u32x2*)(row + 512); raw[2] = *(const u32x2*)(row + 1024);
    u32x2 z; z.x = 0u; z.y = 0u; raw[3] = z; raw[4] = z; raw[5] = z;
    if (has_prev) { raw[3] = *(const u32x2*)(row - 1536); raw[4] = *(const u32x2*)(row - 1536 + 512); raw[5] = *(const u32x2*)(row - 1536 + 1024); }
    raw[6] = *(const u32x2*)(LOh + m * 1536); raw[7] = *(const u32x2*)(LOh + m * 1536 + 512); invn = INVN[m * 8 + h];
}
#define LDS_BARRIER() do { asm volatile("s_waitcnt lgkmcnt(0)" ::: "memory"); __builtin_amdgcn_s_barrier(); asm volatile("" ::: "memory"); } while (0)
__device__ __forceinline__ void scan_prep(const Params& p, const Ctx& c) {
    const int cc1 = c.tid >> 8, cq = (c.tid >> 4) & 15, t1 = c.tid & 15;
    const int lane = c.lane, row = lane & 15, g = lane >> 4;
    const float* INVN = (const float*)(p.ws + WS_INVN);
    constexpr int NITEM = NB * NHEAD * (SEQ / 32);
    u32x2 raw[8]; float invn;
    int item = c.bid;
    if (item < NITEM) { const int bh = item >> 7, it = item & 127, h = bh & 7, ch0 = h * 64 + 4 * cq; const size_t m = (size_t)(bh >> 3) * SEQ + it * 32 + cc1 * 16 + t1;
        ck_load(raw, invn, (const bf16*)(p.ws + WS_PRKV) + ch0, (const bf16*)(p.ws + WS_LORA) + ch0, INVN, h, m, (it * 32 + cc1 * 16 + t1) != 0); }
    int par = 0;
    for (; item < NITEM; item += c.G, par ^= 1) {
        const int bh = item >> 7, it = item & 127, h = bh & 7, ch0 = h * 64 + 4 * cq;
        LAS unsigned char* lds = c.lds + par * (2 * CK_STRIDE);
        const f32x4 mr = *(const f32x4*)(p.in[6] + ch0), mk = *(const f32x4*)(p.in[6] + 512 + ch0), mv = *(const f32x4*)(p.in[6] + 1024 + ch0);
        const f32x4 w0 = *(const f32x4*)(p.in[7] + ch0), a0 = *(const f32x4*)(p.in[9] + ch0), kkc = *(const f32x4*)(p.in[12] + ch0), kac = *(const f32x4*)(p.in[13] + ch0);
        { LAS unsigned char* cb = lds + cc1 * CK_STRIDE;
          f32x4 r = unpk4(raw[0]), kx = unpk4(raw[1]), v = unpk4(raw[2]); const f32x4 rp = unpk4(raw[3]), kp = unpk4(raw[4]), vp = unpk4(raw[5]), lw = unpk4(raw[6]), la = unpk4(raw[7]);
          r = r + (rp - r) * mr; kx = kx + (kp - kx) * mk; v = v + (vp - v) * mv;
          f32x4 lam, a;
#pragma unroll
          for (int i = 0; i < 4; ++i) { lam[i] = 0.6065306597126334f * __builtin_amdgcn_rcpf(1.0f + __expf(-(w0[i] + lw[i]))); a[i] = __builtin_amdgcn_rcpf(1.0f + __expf(-(a0[i] + la[i]))); }
          const f32x4 kk = kx * kkc * invn; const f32x4 kmod = kx * ((a - 1.0f) * kac + 1.0f);
          const f32x4 L = scan16(lam);
          f32x4 gt, gm, ig, gc;
#pragma unroll
          for (int i = 0; i < 4; ++i) { gt[i] = __expf(-L[i]); ig[i] = __builtin_amdgcn_rcpf(gt[i]);
              const float sh = dppf<0x111>(gt[i]); gm[i] = (t1 == 0) ? 1.0f : sh;
              gc[i] = dppf<0x140>(gt[i]); }
          const f32x4 nh = -(kk * gm), rh = r * gt, ab = kk * a * ig, kb = kmod * ig;
          *(LAS u32x2*)(cb + CK_NH + (t1 * 64 + 4 * cq) * 2) = pk4bf(nh); *(LAS u32x2*)(cb + CK_RH + (t1 * 64 + 4 * cq) * 2) = pk4bf(rh);
          *(LAS u32x2*)(cb + CK_AB + (t1 * 64 + 4 * cq) * 2) = pk4bf(ab); *(LAS u32x2*)(cb + CK_KB + (t1 * 64 + 4 * cq) * 2) = pk4bf(kb);
#pragma unroll
          for (int e = 0; e < 4; ++e) { *(LAS bf16*)(cb + CK_ABT + ((4 * cq + e) * 16 + t1) * 2) = (bf16)f2bf(ab[e]); *(LAS bf16*)(cb + CK_KBT + ((4 * cq + e) * 16 + t1) * 2) = (bf16)f2bf(kb[e]);
                                        *(LAS bf16*)(cb + CK_VT + ((4 * cq + e) * 16 + t1) * 2) = (bf16)f2bf(v[e]); }
          if (t1 == 0) *(LAS f32x4*)(cb + CK_GC + 4 * cq * 4) = gc;
        }
        { const int nx = item + c.G; if (nx < NITEM) { const int bh2 = nx >> 7, it2 = nx & 127, h2 = bh2 & 7, ch2 = h2 * 64 + 4 * cq; const size_t m2 = (size_t)(bh2 >> 3) * SEQ + it2 * 32 + cc1 * 16 + t1;
            ck_load(raw, invn, (const bf16*)(p.ws + WS_PRKV) + ch2, (const bf16*)(p.ws + WS_LORA) + ch2, INVN, h2, m2, (it2 * 32 + cc1 * 16 + t1) != 0); } }
        LDS_BARRIER();
        { const int cc = c.wave >> 2, I = (c.wave >> 1) & 1, J = c.wave & 1; LAS unsigned char* cb = lds + cc * CK_STRIDE;
          const LAS unsigned char* X = cb + (I ? CK_KB : CK_AB); const LAS unsigned char* Yh = cb + (J ? CK_RH : CK_NH);
          f32x4 acc = {0.f, 0.f, 0.f, 0.f};
#pragma unroll
          for (int ks = 0; ks < 2; ++ks) { const bf16x8 af = *(const LAS bf16x8*)(X + (row * 64 + 32 * ks + 8 * g) * 2), bfr = *(const LAS bf16x8*)(Yh + (row * 64 + 32 * ks + 8 * g) * 2);
              acc = __builtin_amdgcn_mfma_f32_16x16x32_bf16(af, bfr, acc, 0, 0, 0); }
          const int t = row;
          if (I == 0 && J == 0) {
#pragma unroll
              for (int r = 0; r < 4; ++r) { const int s = 4 * g + r; *(LAS float*)(cb + CK_MAA + (s * 16 + t) * 4) = (s < t) ? acc[r] : 0.f; }
              asm volatile("s_waitcnt lgkmcnt(0)" ::: "memory");
              float tm[16];
#pragma unroll
              for (int i = 0; i < 16; ++i) tm[i] = (i == row) ? 1.0f : 0.0f;
#pragma unroll
              for (int s = 0; s < 15; ++s) { const LAS float* mrow = (const LAS float*)(cb + CK_MAA) + s * 16;
#pragma unroll
                  for (int i = (s + 1) / 4; i < 4; ++i) { const f32x4 m4 = *(const LAS f32x4*)(mrow + 4 * i);
#pragma unroll
                      for (int e = 0; e < 4; ++e) { const int tt = 4 * i + e; if (tt > s) tm[tt] += tm[s] * m4[e]; } } }
#pragma unroll
              for (int e = 0; e < 4; ++e) { const float v_ = g == 0 ? tm[e] : g == 1 ? tm[4 + e] : g == 2 ? tm[8 + e] : tm[12 + e]; *(LAS bf16*)(cb + CK_TMT + ((4 * g + e) * 16 + row) * 2) = (bf16)f2bf(v_); }
          } else { f32x4 mvv;
#pragma unroll
              for (int r = 0; r < 4; ++r) { const int s = 4 * g + r; const bool keep = (J == 0) ? (s < t) : (s <= t); mvv[r] = keep ? acc[r] : 0.f; }
              *(LAS u32x2*)(cb + ((I == 1 && J == 0) ? CK_MKAT : (I == 0 ? CK_MART : CK_MKRT)) + (t * 16 + 4 * g) * 2) = pk4bf(mvv); }
        }
        LDS_BARRIER();
        { unsigned char* dst = p.ws + WS_SCANOP + (size_t)item * (2 * CK_COPY);
          for (int i = c.tid; i < 2 * (CK_COPY / 16); i += NTHREADS) { const int cc = i >= (CK_COPY / 16), off = (i - cc * (CK_COPY / 16)) * 16; *(u32x4*)(dst + cc * CK_COPY + off) = *(const LAS u32x4*)(lds + cc * CK_STRIDE + off); } }
    }
}
constexpr int CH_D = 4, CH_R = CH_D + 1, CH_NJ = 7, CH_SLOT = CH_NJ * 256 * 16;
__device__ __forceinline__ void chain_issue(const unsigned char* src, LAS unsigned char* ring, int it, int lw  , int lane) {
    const unsigned char* g = src + (size_t)it * (2 * CK_COPY) + (size_t)(lw * 64 + lane) * 16; LAS unsigned char* d = ring + (it % CH_R) * CH_SLOT + lw * 1024;
#pragma unroll
    for (int j = 0; j < CH_NJ; ++j) __builtin_amdgcn_global_load_lds((const unsigned*)(g + j * 4096), (LAS unsigned*)(d + j * 4096), 16, 0, 0);
}
__device__ __forceinline__ void scan_chain(const Params& p, const Ctx& c, int bh) {
    const int b = bh >> 3, h = bh & 7; const size_t mb = (size_t)b * SEQ;
    const int lane = c.lane, row = lane & 15, g = lane >> 4, rg = c.wave & 3;
    constexpr int NIT = SEQ / 32;
    const unsigned char* src = p.ws + WS_SCANOP + (size_t)bh * NIT * (2 * CK_COPY);
    f32x4 S[4];
#pragma unroll
    for (int q = 0; q < 4; ++q) S[q] = (f32x4){0.f, 0.f, 0.f, 0.f};
    if (c.wave >= 4) {
#pragma unroll
        for (int i = 0; i < CH_D; ++i) chain_issue(src, c.lds, i, c.wave - 4, lane);
        asm volatile("s_waitcnt vmcnt(21)" ::: "memory");
    }
    LDS_BARRIER();
    for (int it = 0; it < NIT; ++it) {
        LAS unsigned char* lds = c.lds + (it % CH_R) * CH_SLOT;
        PROBE_T0(7);
        if (c.wave < 4) {
#pragma unroll 1
            for (int cc = 0; cc < 2; ++cc) {
                const LAS unsigned char* cb = lds + cc * CK_COPY; const u32x2 z2 = {0u, 0u}; const bf16x8 z8 = {0, 0, 0, 0, 0, 0, 0, 0};
                bf16x8 nh[2], rhf[2], kbt[4]; u32x2 abt[4]; f32x4 gcv[4];
#pragma unroll
                for (int ks = 0; ks < 2; ++ks) { nh[ks] = mk8(*(const LAS u32x2*)(cb + CK_NH + (row * 64 + 32 * ks + 4 * g) * 2), *(const LAS u32x2*)(cb + CK_NH + (row * 64 + 32 * ks + 16 + 4 * g) * 2));
                                                 rhf[ks] = mk8(*(const LAS u32x2*)(cb + CK_RH + (row * 64 + 32 * ks + 4 * g) * 2), *(const LAS u32x2*)(cb + CK_RH + (row * 64 + 32 * ks + 16 + 4 * g) * 2)); }
                bf16x8 Vf = z8, mkat = z8, mkrt = z8;
                if (g < 2) { Vf = *(const LAS bf16x8*)(cb + CK_VT + ((rg * 16 + row) * 16 + 8 * g) * 2); mkat = *(const LAS bf16x8*)(cb + CK_MKAT + (row * 16 + 8 * g) * 2); mkrt = *(const LAS bf16x8*)(cb + CK_MKRT + (row * 16 + 8 * g) * 2); }
                const u32x2 mart = *(const LAS u32x2*)(cb + CK_MART + (row * 16 + 4 * g) * 2), tmt = *(const LAS u32x2*)(cb + CK_TMT + (row * 16 + 4 * g) * 2);
#pragma unroll
                for (int q = 0; q < 4; ++q) { abt[q] = *(const LAS u32x2*)(cb + CK_ABT + ((16 * q + row) * 16 + 4 * g) * 2); kbt[q] = z8; if (g < 2) kbt[q] = *(const LAS bf16x8*)(cb + CK_KBT + ((16 * q + row) * 16 + 8 * g) * 2);
                                              gcv[q] = *(const LAS f32x4*)(cb + CK_GC + (16 * q + 4 * g) * 4); }
                bf16x8 Sb[2];
#pragma unroll
                for (int ks = 0; ks < 2; ++ks) Sb[ks] = mk8(pk4bf(S[2 * ks]), pk4bf(S[2 * ks + 1]));
                f32x4 D = {0.f, 0.f, 0.f, 0.f};
                D = __builtin_amdgcn_mfma_f32_16x16x32_bf16(nh[0], Sb[0], D, 0, 0, 0); D = __builtin_amdgcn_mfma_f32_16x16x32_bf16(nh[1], Sb[1], D, 0, 0, 0); D = __builtin_amdgcn_mfma_f32_16x16x32_bf16(mkat, Vf, D, 0, 0, 0);
                f32x4 Y = {0.f, 0.f, 0.f, 0.f};
                Y = __builtin_amdgcn_mfma_f32_16x16x32_bf16(rhf[0], Sb[0], Y, 0, 0, 0); Y = __builtin_amdgcn_mfma_f32_16x16x32_bf16(rhf[1], Sb[1], Y, 0, 0, 0); Y = __builtin_amdgcn_mfma_f32_16x16x32_bf16(mkrt, Vf, Y, 0, 0, 0);
                f32x4 SAt = {0.f, 0.f, 0.f, 0.f};
                SAt = __builtin_amdgcn_mfma_f32_16x16x32_bf16(mk8(tmt, z2), mk8(pk4bf(D), z2), SAt, 0, 0, 0);
                const bf16x8 SAf = mk8(pk4bf(SAt), z2);
                Y = __builtin_amdgcn_mfma_f32_16x16x32_bf16(mk8(mart, z2), SAf, Y, 0, 0, 0);
                { float* yo = (float*)(p.ws + WS_YRAW) + (mb + (size_t)it * 32 + cc * 16 + 4 * g) * 512 + h * 64 + rg * 16 + row;
#pragma unroll
                  for (int r = 0; r < 4; ++r) yo[(size_t)r * 512] = Y[r]; }
#pragma unroll
                for (int q = 0; q < 4; ++q) { f32x4 Cq = S[q];
                    Cq = __builtin_amdgcn_mfma_f32_16x16x32_bf16(mk8(abt[q], z2), SAf, Cq, 0, 0, 0); Cq = __builtin_amdgcn_mfma_f32_16x16x32_bf16(kbt[q], Vf, Cq, 0, 0, 0);
                    S[q] = Cq * gcv[q]; }
            }
        }
        PROBE_T1(7, p.ws); PROBE_T0(8);
        if (c.wave >= 4) {
            if (it + CH_D < NIT) { chain_issue(src, c.lds, it + CH_D, c.wave - 4, lane); asm volatile("s_waitcnt vmcnt(21)" ::: "memory"); }
            else asm volatile("s_waitcnt vmcnt(0)" ::: "memory");
        }
        LDS_BARRIER();
        PROBE_T1(8, p.ws);
    }
}

namespace att {
constexpr int L_K = 0, L_V = 32768, L_KM = 65536 + 1024, L_SEL = L_KM + 4096, L_WS = L_SEL + 1024;
constexpr float C2 = 0.125f * 1.4426950408889634f;
__device__ __forceinline__ int crow(int r, int hi) { return (r & 3) + 8 * (r >> 2) + 4 * hi; }
typedef __bf16 bf16x2_t __attribute__((ext_vector_type(2)));
__device__ __forceinline__ unsigned cvtpk(float lo, float hi) { f32x2 v = {lo, hi}; bf16x2_t b = __builtin_convertvector(v, bf16x2_t); return __builtin_bit_cast(unsigned, b); }
typedef short v4i16_t __attribute__((ext_vector_type(4)));
__device__ __forceinline__ s16x4 vtr(const LAS unsigned char* p) { return __builtin_bit_cast(s16x4, __builtin_amdgcn_ds_read_tr16_b64_v4i16((LAS v4i16_t*)p)); }

__device__ __forceinline__ void unit(const Params& p, const Ctx& c, int b, int h, int qb, bf16* Oout) {
    const int tid = c.tid, lane = c.lane, wid = c.wave, r32 = lane & 31, hi = lane >> 5;
    bf16* Q = (bf16*)(p.ws + WS_PQ); const bf16* K = (const bf16*)(p.ws + WS_PK); const bf16* V = (const bf16*)(p.ws + WS_PAV); const float* KMg = (const float*)(p.ws + WS_KMEAN);
    const size_t rowbase = (size_t)b * SEQ; const int q0 = qb * 256;
    LAS unsigned char* lds = c.lds; LAS float* kml = (LAS float*)(lds + L_KM); LAS unsigned* sell = (LAS unsigned*)(lds + L_SEL); LAS float* wsf = (LAS float*)(lds + L_WS) + wid * 64;
    for (int i = tid; i < qb * 64; i += NTHREADS) kml[i] = KMg[(size_t)((b * 8 + h) * 16) * 64 + i];
    __syncthreads();
    if (tid < 256) {
        const bf16* qrow = Q + (rowbase + q0 + tid) * 512 + h * 64; float qv[64];
#pragma unroll
        for (int i = 0; i < 8; ++i) { const u32x4 w = *(const u32x4*)(qrow + 8 * i); qv[8 * i] = bflo(w.x); qv[8 * i + 1] = bfhi(w.x); qv[8 * i + 2] = bflo(w.y); qv[8 * i + 3] = bfhi(w.y); qv[8 * i + 4] = bflo(w.z); qv[8 * i + 5] = bfhi(w.z); qv[8 * i + 6] = bflo(w.w); qv[8 * i + 7] = bfhi(w.w); }
        float v0 = -INFINITY, v1 = -INFINITY, v2 = -INFINITY; int i0 = -1, i1 = -1, i2 = -1;
        for (int j = 0; j < qb; ++j) { float g = 0.f;
#pragma unroll
            for (int d = 0; d < 64; d += 4) { const f32x4 km = *(const LAS f32x4*)(kml + j * 64 + d); g += qv[d] * km[0] + qv[d + 1] * km[1] + qv[d + 2] * km[2] + qv[d + 3] * km[3]; }
            if (g > v0) { v2 = v1; i2 = i1; v1 = v0; i1 = i0; v0 = g; i0 = j; } else if (g > v1) { v2 = v1; i2 = i1; v1 = g; i1 = j; } else if (g > v2) { v2 = g; i2 = j; } }
        unsigned msk = 0u; if (i0 >= 0) msk |= 1u << i0; if (i1 >= 0) msk |= 1u << i1; if (i2 >= 0) msk |= 1u << i2;
        sell[tid] = msk;
    }
    __syncthreads();
    const bf16* Qw = Q + (rowbase + q0 + wid * 32) * 512 + h * 64; bf16x8 qr[4];
#pragma unroll
    for (int d0 = 0; d0 < 4; ++d0) qr[d0] = *(const bf16x8*)(Qw + (size_t)r32 * 512 + d0 * 16 + hi * 8);
    const unsigned mysel = sell[wid * 32 + r32]; const int qrel = wid * 32 + r32;
    float m_run = -INFINITY, l_run = 0.f; f32x16 o0 = {}, o1 = {};
    const int krow = tid & 63, kch = tid >> 6; const bf16* ksrc = K + (rowbase + krow) * 512 + h * 64 + kch * 8; const int kdst = kch * 1024 + krow * 16;
    const int vrow = 16 * (wid & 3) + (lane >> 2), vcol = (wid >> 2) * 32 + (lane & 3) * 8; const bf16* vsrc = V + (rowbase + vrow) * 512 + h * 64 + vcol; const int vdst = wid * 1024 + lane * 16;
    const int kfo = hi * 1024 + r32 * 16; const int vfo = ((lane >> 4) & 1) * 32 + (lane & 3) * 8 + (4 * hi + ((lane & 15) >> 2)) * 64;
    const int ntile = 4 * qb + 4;
    const unsigned kw = (unsigned)wid * 1024u;
#define ATT_DMA(t_) do { __builtin_amdgcn_global_load_lds((const unsigned*)(ksrc + (size_t)(t_) * 64 * 512), (LAS unsigned*)(lds + L_K + ((t_) & 3) * 8192 + kw), 16, 0, 0); \
                         __builtin_amdgcn_global_load_lds((const unsigned*)(vsrc + (size_t)(t_) * 64 * 512), (LAS unsigned*)(lds + L_V + ((t_) & 3) * 8192 + kw), 16, 0, 0); } while (0)
    (void)kdst; (void)vdst;
    ATT_DMA(0); ATT_DMA(1); ATT_DMA(2);
    for (int it = 0; it < ntile; ++it) {
        LAS unsigned char* Ks = lds + L_K + (it & 3) * 8192; LAS unsigned char* Vs = lds + L_V + (it & 3) * 8192;
        if (it + 2 < ntile) asm volatile("s_waitcnt vmcnt(4)" ::: "memory"); else if (it + 1 < ntile) asm volatile("s_waitcnt vmcnt(2)" ::: "memory"); else asm volatile("s_waitcnt vmcnt(0)" ::: "memory");
        asm volatile("s_waitcnt lgkmcnt(0)" ::: "memory"); __builtin_amdgcn_s_barrier(); asm volatile("" ::: "memory");
        if (it + 3 < ntile) ATT_DMA(it + 3);
        const int blk = it >> 2; const bool band = blk == qb; const int jb = it & 3;
        bool lane_on = band ? (64 * jb <= qrel) : (((mysel >> blk) & 1u) != 0u);
        if (__any(lane_on)) {
            f32x16 p0 = {}, p1 = {};
#pragma unroll
            for (int d0 = 0; d0 < 4; ++d0) { const bf16x8 k0 = *(const LAS bf16x8*)(Ks + kfo + d0 * 2048), k1 = *(const LAS bf16x8*)(Ks + kfo + d0 * 2048 + 512);
                p0 = __builtin_amdgcn_mfma_f32_32x32x16_bf16(k0, qr[d0], p0, 0, 0, 0); p1 = __builtin_amdgcn_mfma_f32_32x32x16_bf16(k1, qr[d0], p1, 0, 0, 0); }
            if (band) {
#pragma unroll
                for (int r = 0; r < 16; ++r) { const int kv = 64 * jb + crow(r, hi); p0[r] = (kv <= qrel) ? p0[r] : -INFINITY; p1[r] = (kv + 32 <= qrel) ? p1[r] : -INFINITY; }
            }
            float rm = fmaxf(fmaxf(p0[0], p1[0]), p0[1]);
#pragma unroll
            for (int r = 1; r < 16; ++r) { rm = fmaxf(fmaxf(rm, p1[r]), (r + 1 < 16) ? p0[r + 1] : p1[r]); }
            rm = lane_on ? rm : -INFINITY;
            rm = fmaxf(rm, __shfl_xor(rm, 32));
            const float m_new = fmaxf(m_run, rm); const float m_safe = (m_new == -INFINITY) ? 0.f : m_new;
            const float m_use = lane_on ? m_safe : INFINITY;
            const float alpha = __builtin_amdgcn_exp2f(m_run - m_safe);
            float ps = 0.f;
#pragma unroll
            for (int r = 0; r < 16; ++r) { p0[r] = __builtin_amdgcn_exp2f(p0[r] - m_use); p1[r] = __builtin_amdgcn_exp2f(p1[r] - m_use); ps += p0[r] + p1[r]; }
            l_run = l_run * alpha + ps; m_run = m_new;
            if (__any(alpha != 1.0f)) {
                if (hi == 0) wsf[r32] = alpha;
                asm volatile("s_waitcnt lgkmcnt(0)" ::: "memory");
#pragma unroll
                for (int r = 0; r < 16; ++r) { const float f = wsf[crow(r, hi)]; o0[r] *= f; o1[r] *= f; }
                asm volatile("s_waitcnt lgkmcnt(0)" ::: "memory");
            }
            u32x4 pw[4];
            pw[0] = (u32x4){cvtpk(p0[0], p0[1]), cvtpk(p0[2], p0[3]), cvtpk(p0[4], p0[5]), cvtpk(p0[6], p0[7])};
            pw[1] = (u32x4){cvtpk(p0[8], p0[9]), cvtpk(p0[10], p0[11]), cvtpk(p0[12], p0[13]), cvtpk(p0[14], p0[15])};
            pw[2] = (u32x4){cvtpk(p1[0], p1[1]), cvtpk(p1[2], p1[3]), cvtpk(p1[4], p1[5]), cvtpk(p1[6], p1[7])};
            pw[3] = (u32x4){cvtpk(p1[8], p1[9]), cvtpk(p1[10], p1[11]), cvtpk(p1[12], p1[13]), cvtpk(p1[14], p1[15])};
#pragma unroll
            for (int ks = 0; ks < 4; ++ks) {
                const s16x4 a0 = vtr(Vs + vfo + ks * 1024), a1 = vtr(Vs + vfo + ks * 1024 + 512), b0 = vtr(Vs + vfo + 4096 + ks * 1024), b1 = vtr(Vs + vfo + 4096 + ks * 1024 + 512);
                const bf16x8 va = {a0[0], a0[1], a0[2], a0[3], a1[0], a1[1], a1[2], a1[3]}, vb = {b0[0], b0[1], b0[2], b0[3], b1[0], b1[1], b1[2], b1[3]};
                const bf16x8 pa = __builtin_bit_cast(bf16x8, pw[ks]);
                o0 = __builtin_amdgcn_mfma_f32_32x32x16_bf16(pa, va, o0, 0, 0, 0); o1 = __builtin_amdgcn_mfma_f32_32x32x16_bf16(pa, vb, o1, 0, 0, 0);
            }
        }
    }
    l_run += __shfl_xor(l_run, 32);
    if (hi == 0) wsf[32 + r32] = l_run;
    asm volatile("s_waitcnt lgkmcnt(0)" ::: "memory");
    bf16* Ow = Oout + (rowbase + q0 + wid * 32) * 512 + h * 64;
#pragma unroll
    for (int r = 0; r < 16; ++r) { const int qr_ = crow(r, hi); const float rl = 1.0f / wsf[32 + qr_];
        Ow[(size_t)qr_ * 512 + r32] = (bf16)f2bf(o0[r] * rl); Ow[(size_t)qr_ * 512 + 32 + r32] = (bf16)f2bf(o1[r] * rl); }
    __syncthreads();
}
#undef ATT_DMA
}

__device__ __forceinline__ void unp8(u32x4 w, f32x4& a, f32x4& b) { a = (f32x4){bflo(w.x), bfhi(w.x), bflo(w.y), bfhi(w.y)}; b = (f32x4){bflo(w.z), bfhi(w.z), bflo(w.w), bfhi(w.w)}; }
__device__ __forceinline__ void phase6(const Params& p, const Ctx& c) {
    unsigned char* ws = p.ws; const float* __restrict__ YR = (const float*)(ws + WS_YRAW); const bf16* __restrict__ RKV = (const bf16*)(ws + WS_PRKV); const bf16* __restrict__ LO = (const bf16*)(ws + WS_LORA); bf16* __restrict__ YO = (bf16*)(ws + WS_YRWKV);
    const int ch = 8 * c.lane;
    for (int m0 = c.gw; m0 < MTOK; m0 += c.ngw) { const size_t m = (size_t)m0;
        const f32x4 y0 = *(const f32x4*)(YR + m * 512 + ch), y1 = *(const f32x4*)(YR + m * 512 + ch + 4); const u32x4 gw_ = *(const u32x4*)(LO + m * 1536 + 1024 + ch), law = *(const u32x4*)(LO + m * 1536 + 512 + ch);
        const u32x4 rw_ = *(const u32x4*)(RKV + m * 1536 + ch), kw_ = *(const u32x4*)(RKV + m * 1536 + 512 + ch), vw_ = *(const u32x4*)(RKV + m * 1536 + 1024 + ch);
        u32x4 rpw = {0u, 0u, 0u, 0u}, kpw = rpw, vpw = rpw;
        if ((m0 & (SEQ - 1)) != 0) { rpw = *(const u32x4*)(RKV + (m - 1) * 1536 + ch); kpw = *(const u32x4*)(RKV + (m - 1) * 1536 + 512 + ch); vpw = *(const u32x4*)(RKV + (m - 1) * 1536 + 1024 + ch); }
        f32x4 r0, r1, k0, k1, v0, v1, rp0, rp1, kp0, kp1, vp0, vp1, la0, la1, g0, g1v;
        unp8(rw_, r0, r1); unp8(kw_, k0, k1); unp8(vw_, v0, v1); unp8(rpw, rp0, rp1); unp8(kpw, kp0, kp1); unp8(vpw, vp0, vp1); unp8(law, la0, la1); unp8(gw_, g0, g1v);
        const float* mix = p.in[6];
        r0 = r0 + (rp0 - r0) * *(const f32x4*)(mix + ch); r1 = r1 + (rp1 - r1) * *(const f32x4*)(mix + ch + 4);
        k0 = k0 + (kp0 - k0) * *(const f32x4*)(mix + 512 + ch); k1 = k1 + (kp1 - k1) * *(const f32x4*)(mix + 512 + ch + 4);
        v0 = v0 + (vp0 - v0) * *(const f32x4*)(mix + 1024 + ch); v1 = v1 + (vp1 - v1) * *(const f32x4*)(mix + 1024 + ch + 4);
        const f32x4 a00 = *(const f32x4*)(p.in[9] + ch), a01 = *(const f32x4*)(p.in[9] + ch + 4), ka0 = *(const f32x4*)(p.in[13] + ch), ka1 = *(const f32x4*)(p.in[13] + ch + 4), rk0 = *(const f32x4*)(p.in[14] + ch), rk1 = *(const f32x4*)(p.in[14] + ch + 4);
        f32x4 a0v, a1v;
#pragma unroll
        for (int i = 0; i < 4; ++i) { a0v[i] = 1.0f / (1.0f + __expf(-(a00[i] + la0[i]))); a1v[i] = 1.0f / (1.0f + __expf(-(a01[i] + la1[i]))); }
        const f32x4 km0 = k0 * ((a0v - 1.0f) * ka0 + 1.0f), km1 = k1 * ((a1v - 1.0f) * ka1 + 1.0f);
        const f32x4 pb0 = r0 * km0 * rk0, pb1 = r1 * km1 * rk1; const float bs = sum8(((pb0[0] + pb0[1]) + (pb0[2] + pb0[3])) + ((pb1[0] + pb1[1]) + (pb1[2] + pb1[3])));
        float s = ((y0[0] + y0[1]) + (y0[2] + y0[3])) + ((y1[0] + y1[1]) + (y1[2] + y1[3]));
        const float mu = sum8(s) * (1.0f / 64.0f); const f32x4 d0 = y0 - mu, d1 = y1 - mu;
        float q = ((d0[0] * d0[0] + d0[1] * d0[1]) + (d0[2] * d0[2] + d0[3] * d0[3])) + ((d1[0] * d1[0] + d1[1] * d1[1]) + (d1[2] * d1[2] + d1[3] * d1[3]));
        const float rs = rsqrtf(sum8(q) * (1.0f / 64.0f) + GN_EPS);
        const f32x4 o0 = (d0 * rs * *(const f32x4*)(p.in[15] + ch) + *(const f32x4*)(p.in[16] + ch) + v0 * bs) * g0, o1 = (d1 * rs * *(const f32x4*)(p.in[15] + ch + 4) + *(const f32x4*)(p.in[16] + ch + 4) + v1 * bs) * g1v;
        u32x4 w; w.x = pk2(o0[0], o0[1]); w.y = pk2(o0[2], o0[3]); w.z = pk2(o1[0], o1[1]); w.w = pk2(o1[2], o1[3]);
        *(u32x4*)(YO + m * 512 + ch) = w;
    }
}

constexpr int RW_PITCH = 36;
constexpr int L_HIST = 1024 * RW_PITCH * 4;
__device__ __forceinline__ void phase9(const Params& p, const Ctx& c, const bool dry = false) {
    unsigned char* ws = p.ws; const float* XP = (const float*)(ws + WS_XPRE); float* X1 = (float*)(ws + WS_X1); unsigned char* X1F = (unsigned char*)(ws + WS_X1B);
    int* ctl = (int*)(ws + WS_CTL); int* TOKE = (int*)(ws + WS_TOKE); float* TOKW = (float*)(ws + WS_TOKW);
    const float* g1 = p.in[1]; const float* b1 = p.in[2]; const float* RW = p.in[20]; const float* RB = p.in[21];
    LAS float* rw = (LAS float*)c.lds; LAS int* hist = (LAS int*)(c.lds + L_HIST);
    for (int i = c.tid; i < 1024 * 8; i += NTHREADS) { const int row = i >> 3, q = i & 7; *(LAS f32x4*)(rw + row * RW_PITCH + 4 * q) = *(const f32x4*)(RW + row * 32 + 4 * q); }
    if (c.tid < 32) { hist[c.tid] = 0; ((LAS float*)(c.lds + L_HIST + 256))[c.tid] = RB[c.tid]; }
    __syncthreads();
    float gv[16], bvv[16]; LAS float* rbl = (LAS float*)(c.lds + L_HIST + 256);
#pragma unroll
    for (int i = 0; i < 16; ++i) { gv[i] = g1[c.lane + 64 * i]; bvv[i] = b1[c.lane + 64 * i]; }
    for (int m = c.gw; m < MTOK; m += c.ngw) {
        const float* xr = XP + (size_t)m * 1024 + c.lane; float v[16]; float s = 0.f;
#pragma unroll
        for (int i = 0; i < 16; ++i) { v[i] = xr[64 * i]; s += v[i]; }
        const float mean = wave_sum_dpp(s) * (1.0f / 1024.0f); float s2 = 0.f;
#pragma unroll
        for (int i = 0; i < 16; ++i) { v[i] -= mean; s2 += v[i] * v[i]; }
        const float rstd = 1.0f / sqrtf(wave_sum_dpp(s2) * (1.0f / 1024.0f) + LN_EPS);
        float acc[32];
#pragma unroll
        for (int e = 0; e < 32; ++e) acc[e] = 0.f;
#pragma unroll
        for (int i = 0; i < 16; ++i) { const int col = c.lane + 64 * i; const float xv = v[i] * rstd * gv[i] + bvv[i];
            X1[(size_t)m * 1024 + col] = xv; X1F[(size_t)m * 1024 + col] = (unsigned char)(__builtin_amdgcn_cvt_pk_fp8_f32(xv, xv, 0, false) & 0xff);
            const LAS float* wr_ = rw + col * RW_PITCH;
#pragma unroll
            for (int q = 0; q < 8; ++q) { const f32x4 w4 = *(const LAS f32x4*)(wr_ + 4 * q); acc[4 * q] += xv * w4[0]; acc[4 * q + 1] += xv * w4[1]; acc[4 * q + 2] += xv * w4[2]; acc[4 * q + 3] += xv * w4[3]; }
            __builtin_amdgcn_sched_barrier(0); }
#pragma unroll
        for (int e = 0; e < 32; ++e) acc[e] = wave_sum_dpp(acc[e]) + rbl[e];
        float tv[4]; int ti[4]; unsigned used = 0u;
#pragma unroll
        for (int k = 0; k < 4; ++k) { float bv = -INFINITY; int bi = 0;
#pragma unroll
            for (int e = 0; e < 32; ++e) { const bool ok = ((used >> e) & 1u) == 0u && acc[e] > bv; bv = ok ? acc[e] : bv; bi = ok ? e : bi; }
            tv[k] = bv; ti[k] = bi; used |= 1u << bi; }
        const float e1 = __expf(tv[1] - tv[0]), e2 = __expf(tv[2] - tv[0]), e3 = __expf(tv[3] - tv[0]); const float inv = 1.0f / (1.0f + e1 + e2 + e3);
        if (c.lane < 4 && (!dry || tv[0] == 12345.678f)) { const int e = c.lane == 0 ? ti[0] : c.lane == 1 ? ti[1] : c.lane == 2 ? ti[2] : ti[3]; const float w = (c.lane == 0 ? 1.0f : c.lane == 1 ? e1 : c.lane == 2 ? e2 : e3) * inv;
            const int pos = __hip_atomic_fetch_add(hist + e, 1, __ATOMIC_RELAXED, __HIP_MEMORY_SCOPE_WORKGROUP);
            TOKE[m * 4 + c.lane] = e | (pos << 8); TOKW[m * 4 + c.lane] = w; }
    }
    __syncthreads();
    if (c.tid < 32 && !dry) { const int base = atomicAdd(ctl + CW_COUNT + c.tid, hist[c.tid]); ctl[CW_WGBASE + c.bid * 32 + c.tid] = base; }
    __syncthreads();
}

__device__ __forceinline__ void phase10(const Params& p, const Ctx& c) {
    unsigned char* ws = p.ws; int* ctl = (int*)(ws + WS_CTL); const int* TOKE = (const int*)(ws + WS_TOKE); const float* TOKW = (const float*)(ws + WS_TOKW);
    int* SLOTOF = (int*)(ws + WS_SLOTOF); float* ROWW = (float*)(ws + WS_ROWW);
    LAS int* pst = (LAS int*)(c.lds + L_HIST + 128);
    if (c.tid == 0) { int acc = 0;
        for (int e = 0; e < 32; ++e) { const int cnt = __hip_atomic_load(ctl + CW_COUNT + e, __ATOMIC_RELAXED, __HIP_MEMORY_SCOPE_AGENT); const int nt = (cnt + 255) >> 8;
            pst[e] = acc * 256;
            if (c.bid == 0) for (int t = 0; t < nt; ++t) ctl[CW_TILE_E + acc + t] = e;
            acc += nt; }
        if (c.bid == 0) ctl[CW_NTILES] = acc; }
    __syncthreads();
    int* ROWTOK = (int*)(ws + WS_ROWTOK);
    for (int i = c.bid * NTHREADS + c.tid; i < MTOK * 4; i += c.G * NTHREADS) { const int m = i >> 2, wg = (m % c.ngw) >> 3;
        const int ew = TOKE[i], e = ew & 255; const int slot = pst[e] + ctl[CW_WGBASE + wg * 32 + e] + (ew >> 8); SLOTOF[i] = slot; ROWW[slot] = TOKW[i]; ROWTOK[slot] = m; }
}

__device__ __forceinline__ void phase14(const Params& p, const Ctx& c) {
    unsigned char* ws = p.ws; const float* __restrict__ X1 = (const float*)(ws + WS_X1); const bf16* __restrict__ YB = (const bf16*)(ws + WS_YBUF); const int* __restrict__ SLOTOF = (const int*)(ws + WS_SLOTOF);
    float* __restrict__ OUT = p.out; f32x4 g2v[4], b2v[4];
#pragma unroll
    for (int j = 0; j < 4; ++j) { g2v[j] = *(const f32x4*)(p.in[3] + 256 * j + 4 * c.lane); b2v[j] = *(const f32x4*)(p.in[4] + 256 * j + 4 * c.lane); }
    for (int m0 = 2 * c.gw; m0 < MTOK; m0 += 2 * c.ngw) {
        f32x4 v[2][4]; u32x2 yv[2][4][4];
#pragma unroll
        for (int u = 0; u < 2; ++u) { const int m = m0 + u; int sl[4];
#pragma unroll
            for (int k = 0; k < 4; ++k) sl[k] = SLOTOF[m * 4 + k];
#pragma unroll
            for (int j = 0; j < 4; ++j) { const int col = 256 * j + 4 * c.lane; v[u][j] = *(const f32x4*)(X1 + (size_t)m * 1024 + col);
#pragma unroll
                for (int k = 0; k < 4; ++k) yv[u][j][k] = *(const u32x2*)(YB + (size_t)sl[k] * 1024 + col); } }
#pragma unroll
        for (int u = 0; u < 2; ++u) { const int m = m0 + u; float s = 0.f;
#pragma unroll
            for (int j = 0; j < 4; ++j) { f32x4 a = v[u][j] * DN_ALPHA; const u32x2 y0 = yv[u][j][0], y1 = yv[u][j][1], y2 = yv[u][j][2], y3 = yv[u][j][3];
                a[0] += ((bflo(y0.x) + bflo(y1.x)) + bflo(y2.x)) + bflo(y3.x); a[1] += ((bfhi(y0.x) + bfhi(y1.x)) + bfhi(y2.x)) + bfhi(y3.x);
                a[2] += ((bflo(y0.y) + bflo(y1.y)) + bflo(y2.y)) + bflo(y3.y); a[3] += ((bfhi(y0.y) + bfhi(y1.y)) + bfhi(y2.y)) + bfhi(y3.y);
                v[u][j] = a; s += (a[0] + a[1]) + (a[2] + a[3]); }
            const float mean = wave_sum_dpp(s) * (1.0f / 1024.0f); float q = 0.f;
#pragma unroll
            for (int j = 0; j < 4; ++j) { v[u][j] = v[u][j] - mean; q += (v[u][j][0] * v[u][j][0] + v[u][j][1] * v[u][j][1]) + (v[u][j][2] * v[u][j][2] + v[u][j][3] * v[u][j][3]); }
            const float rstd = 1.0f / sqrtf(wave_sum_dpp(q) * (1.0f / 1024.0f) + LN_EPS);
#pragma unroll
            for (int j = 0; j < 4; ++j) *(f32x4*)(OUT + (size_t)m * 1024 + 256 * j + 4 * c.lane) = v[u][j] * rstd * g2v[j] + b2v[j]; }
    }
}

#define XB_TMO      128
#define XB_XCNT(j)  (256  + 64 * (j))
#define XB_XSUB(j)  (1280 + 64 * (j))
#define XB_XGEN(j)  (2304 + 64 * (j))
#define XB_TOP      3328
#define XB_TOPGEN   3392
#define XCD_BAR_WORDS 3456
#define XB_SPIN_CAP (1u << 18)

__device__ __forceinline__ unsigned xb_ld(unsigned* p)              { return __hip_atomic_load(p, __ATOMIC_RELAXED, __HIP_MEMORY_SCOPE_AGENT); }
__device__ __forceinline__ unsigned xb_add(unsigned* p, unsigned v) { return __hip_atomic_fetch_add(p, v, __ATOMIC_RELAXED, __HIP_MEMORY_SCOPE_AGENT); }
__device__ __forceinline__ unsigned xb_xcc_id() { return (unsigned)__builtin_amdgcn_s_getreg((3 << 11) | 20) & 0xFu; }
#define XB_SPIN(cond, bar) do { unsigned _sp = 0; while (cond) { __builtin_amdgcn_s_sleep(1); \
    if ((++_sp & 255u) == 0u) { if (xb_ld(&(bar)[XB_TMO])) break; if (_sp > XB_SPIN_CAP) { atomicAdd(&(bar)[XB_TMO], 1u); break; } } } } while (0)

struct XcdBarrier {
    unsigned* bar; unsigned x;
    volatile LAS unsigned* st;
};

__device__ __forceinline__ XcdBarrier xcd_barrier_post(unsigned* bar, volatile LAS unsigned* st) {
    XcdBarrier b; b.bar = bar; b.x = xb_xcc_id(); b.st = st;
    if (threadIdx.x == 0) (void)xb_add(&bar[XB_XCNT(b.x)], 1u);
    return b;
}
__device__ __forceinline__ void xcd_barrier_complete(unsigned* bar, unsigned x, unsigned& nloc, unsigned& nx) {
    const unsigned G = gridDim.x * gridDim.y * gridDim.z;
    unsigned sum, cnt, mine, sp = 0u;
    for (;;) {
        sum = 0u; cnt = 0u; mine = 0u;
#pragma unroll
        for (unsigned j = 0; j < 16; ++j) { const unsigned c = xb_ld(&bar[XB_XCNT(j)]); sum += c; cnt += (c > 0u) ? 1u : 0u; mine = (j == x) ? c : mine; }
        if (sum == G) break;
        __builtin_amdgcn_s_sleep(1);
        if ((++sp & 255u) == 0u) { if (xb_ld(&bar[XB_TMO])) break; if (sp > XB_SPIN_CAP) { atomicAdd(&bar[XB_TMO], 1u); break; } }
    }
    nloc = mine > 0u ? mine : 1u; nx = cnt > 0u ? cnt : 1u;
}

__device__ __forceinline__ void xcd_barrier(const XcdBarrier& b) {
    asm volatile("s_waitcnt vmcnt(0)" ::: "memory");
    __syncthreads();
    if (threadIdx.x == 0) {
        unsigned* bar = b.bar;
        __builtin_amdgcn_s_waitcnt(0);
        unsigned nloc = b.st[0], nx = b.st[1];
        if (nloc == 0u) { xcd_barrier_complete(bar, b.x, nloc, nx); b.st[0] = nloc; b.st[1] = nx; }
        const unsigned old = xb_add(&bar[XB_XSUB(b.x)], 1u);
        const unsigned gen = old / nloc;
        if (old + 1u == (gen + 1u) * nloc) {
            __builtin_amdgcn_fence(__ATOMIC_RELEASE, "agent");
            asm volatile("s_waitcnt vmcnt(0)" ::: "memory");
            const unsigned og = xb_add(&bar[XB_TOP], 1u);
            const unsigned tg = og / nx;
            if (og + 1u == (tg + 1u) * nx) xb_add(&bar[XB_TOPGEN], 1u);
            else XB_SPIN(xb_ld(&bar[XB_TOPGEN]) == tg, bar);
            __builtin_amdgcn_fence(__ATOMIC_ACQUIRE, "agent");
            xb_add(&bar[XB_XGEN(b.x)], 1u);
            asm volatile("s_waitcnt vmcnt(0)" ::: "memory");
        } else {
            XB_SPIN(xb_ld(&bar[XB_XGEN(b.x)]) == gen, bar);
            __builtin_amdgcn_fence(__ATOMIC_ACQUIRE, "agent");
            asm volatile("s_waitcnt vmcnt(0)" ::: "memory");
        }
    }
    __syncthreads();
}


constexpr int NPHASE = 15;
#ifndef MK_SPLIT
#define MK_SPLIT 0
#endif
__global__ void __launch_bounds__(NTHREADS, 2) fwd_megakernel(Params p) {
    extern __shared__ __attribute__((aligned(16))) unsigned char lds_raw[];
    Ctx c; c.lds = (LAS unsigned char*)lds_raw; c.tid = threadIdx.x; c.lane = c.tid & 63; c.wave = __builtin_amdgcn_readfirstlane(c.tid >> 6);
    c.G = gridDim.x; c.bid = blockIdx.x; c.gw = c.bid * NWAVES + c.wave; c.ngw = c.G * NWAVES;
    unsigned char* ws = p.ws;
    const int lo = p.ph_lo, hi = p.ph_hi;
#ifdef ONLY_PHASE
#define IN(k) ((k) == ONLY_PHASE && lo <= (k) && (k) < hi)
#else
#define IN(k) (lo <= (k) && (k) < hi)
#endif
#if MK_SPLIT
#define SEAM(k) do { } while (0)
#else
    cg::grid_group grid = cg::this_grid();
    { volatile LAS unsigned* st = (volatile LAS unsigned*)(c.lds + LDS_BYTES - 16); if (c.tid < 4) st[c.tid] = 0u; }
    __syncthreads();
    const XcdBarrier xbar = xcd_barrier_post((unsigned*)(ws + WS_CTL) + CW_XBAR, (volatile LAS unsigned*)(c.lds + LDS_BYTES - 16));
#define SEAM(k) do { if (IN(k) && IN((k) + 1)) { if ((k) == 0) grid.sync(); else xcd_barrier(xbar); } } while (0)
#endif
#ifndef DBL_PHASE
#define DBL_PHASE -1
#endif
#define PH(k, ...) if (IN(k)) { __VA_ARGS__; if (DBL_PHASE == (k)) { xcd_barrier(xbar); __VA_ARGS__; } }
    PH(0, phase0(p, c))
    SEAM(0);
    PH(1, { pg8::DenseOrder S; S.init(MTOK, 5376, 1024, c.G, c.bid, ws + WS_XB, ws + WS_WIN_T);
        pg8::EpiInProj E{(bf16*)(ws + WS_PRKV), (bf16*)(ws + WS_PLR), (bf16*)(ws + WS_PQ), (bf16*)(ws + WS_PK), (bf16*)(ws + WS_PAV), (bf16*)(ws + WS_PG)};
        pg8::gemm_phase<pg8::EpiInProj, pg8::DenseOrder, true, true>(c.lds, 1024, S, E); })
    SEAM(1);
    if (IN(2)) phase2(p, c);
    SEAM(2);
    PH(3, { kmean_items(p, c); pg8::DenseOrder S; S.init(MTOK, 1536, 256, c.G, c.bid, ws + WS_ALORA, ws + WS_WLORA_T);
        pg8::EpiPlainBf16 E{(bf16*)(ws + WS_LORA), 1536};
        pg8::gemm_phase<pg8::EpiPlainBf16, pg8::DenseOrder, true, true>(c.lds, 256, S, E); })
    SEAM(3);
    { PROBE_T0(5); if (IN(4)) scan_prep(p, c); PROBE_T1(5, ws); }
    SEAM(4);
    if (PROBE_ID == 6 && IN(5) && c.bid == 0 && c.wave == 0) {
        PROBE_T0(6); float r_[32];
#pragma unroll
        for (int i = 0; i < 32; ++i) r_[i] = (float)(c.lane + i);
        for (int k = 0; k < 640; ++k) {
#pragma unroll
            for (int i = 0; i < 32; ++i) asm volatile("v_fma_f32 %0, %0, %1, %0" : "+v"(r_[i]) : "v"(1.0001f)); }
        float s_ = 0.f;
#pragma unroll
        for (int i = 0; i < 32; ++i) s_ += r_[i];
        if (s_ == 12345.0f) ((float*)(ws + WS_CTL))[200] = s_;
        PROBE_T1(6, ws); }
    if (IN(5)) {
        { PROBE_T0(1); for (int bh = c.bid; bh < NB * NHEAD; bh += c.G) scan_chain(p, c, bh); PROBE_T1(1, ws); }
        unsigned long long _pt9 = 0; if (PROBE_ID == 9 && blockIdx.x == 100 && threadIdx.x == 0) _pt9 = __builtin_amdgcn_s_memrealtime();
        { int* ctl = (int*)(ws + WS_CTL); LAS int* qs = (LAS int*)(c.lds + 65536);
          for (;;) { if (c.tid == 0) *qs = atomicAdd(ctl + CW_ATTQ, 1);
              __syncthreads(); const int u = *qs; __syncthreads();
              if (u >= 1024) break;
              const int qb = 15 - (u >> 6), bh = u & 63; att::unit(p, c, bh >> 3, bh & 7, qb, (bf16*)(ws + WS_PQ)); } }
        if (PROBE_ID == 9 && blockIdx.x == 100 && threadIdx.x == 0) atomicAdd((unsigned*)(ws + WS_CTL) + CW_PROBE, (unsigned)(__builtin_amdgcn_s_memrealtime() - _pt9));
    }
    SEAM(5);
    PH(6, phase6(p, c))
    SEAM(6);
    PH(7, { pg8::DenseOrder S; S.init(MTOK, 1024, 512, c.G, c.bid, ws + WS_YRWKV, ws + WS_WR_T);
        pg8::EpiGateF32 E{(float*)(ws + WS_TMP), (const bf16*)(ws + WS_PG), 0};
        pg8::gemm_phase<pg8::EpiGateF32, pg8::DenseOrder, true, true>(c.lds, 512, S, E); })
    SEAM(7);
    PH(8, { pg8::DenseOrder S; S.init(MTOK, 1024, 512, c.G, c.bid, ws + WS_PQ, ws + WS_WA_T);
        pg8::EpiGateAddBf16 E{(const float*)(ws + WS_TMP), (const bf16*)(ws + WS_PG), 1024, (bf16*)(ws + WS_MERGED)};
        pg8::gemm_phase<pg8::EpiGateAddBf16, pg8::DenseOrder, true, true>(c.lds, 512, S, E); })
    SEAM(8);
    PH(9, { pg8::DenseOrder S; S.init(MTOK, 1024, 1024, c.G, c.bid, ws + WS_MERGED, ws + WS_WO_T);
        pg8::EpiResF32 E{(float*)(ws + WS_XPRE), p.in[0], DN_ALPHA};
        pg8::gemm_phase<pg8::EpiResF32, pg8::DenseOrder, true, true>(c.lds, 1024, S, E); })
    SEAM(9);
    if (IN(10)) { if (DBL_PHASE == 10) { phase9(p, c, true); } phase9(p, c); }
    SEAM(10);
    if (IN(11)) phase10(p, c);
    SEAM(11);
    PH(12, { const int* ctl = (const int*)(ws + WS_CTL);
        pg8::MoeOrder<true> S{(const int*)(ws + WS_ROWTOK), ctl + CW_TILE_E, ctl[CW_NTILES], 8, c.G, c.bid, (const char*)(ws + WS_X1B), (const char*)(ws + WS_W1T), (size_t)256 * 1024, (size_t)2048 * 1024};
        pg8::EpiSwiglu E{ws + WS_ACT, p.in[23], 1.0f / W1_SCALE};
        pg8::gemm_phase<pg8::EpiSwiglu, pg8::MoeOrder<true>, true, true, 1>(c.lds, 1024, S, E); })
    SEAM(12);
    PH(13, { const int* ctl = (const int*)(ws + WS_CTL);
        pg8::MoeOrder<false> S{nullptr, ctl + CW_TILE_E, ctl[CW_NTILES], 4, c.G, c.bid, (const char*)(ws + WS_ACT), (const char*)(ws + WS_W2T), (size_t)256 * 1024, (size_t)1024 * 1024};
        pg8::EpiMoe2 E{(bf16*)(ws + WS_YBUF), p.in[25], (const float*)(ws + WS_ROWW), 1.0f / W2_SCALE};
        pg8::gemm_phase<pg8::EpiMoe2, pg8::MoeOrder<false>, true, true, 1>(c.lds, 1024, S, E); })
    SEAM(13);
    PH(14, phase14(p, c))
#undef PH
    if (PROBE_ID != 0 && blockIdx.x == 0 && threadIdx.x == 0) { const unsigned ticks = __hip_atomic_load((unsigned*)(ws + WS_CTL) + CW_PROBE, __ATOMIC_RELAXED, __HIP_MEMORY_SCOPE_AGENT); const unsigned long long t0 = __builtin_amdgcn_s_memrealtime(); while (__builtin_amdgcn_s_memrealtime() - t0 < 10ull * ticks) __builtin_amdgcn_s_sleep(8); }
#undef IN
#undef SEAM
}

extern "C" void kernel_launch(void* const* d_in, const int* in_sizes, int n_in, void* d_out, int out_size, void* d_ws, size_t ws_size, hipStream_t stream) {
    static int grid = 0;
    if (grid == 0) {
        if (n_in != 26 || in_sizes[0] != MTOK * DMODEL || out_size != MTOK * DMODEL || ws_size < WS_END) {
            fprintf(stderr, "kernel_launch: unexpected shapes / workspace (n_in %d, in0 %d, out %d, ws %zu, need %zu); nothing launched\n", n_in, n_in > 0 ? in_sizes[0] : -1, out_size, ws_size, (size_t)WS_END); grid = -1; return; }
        int dev = 0, cus = 0, per_cu = 0;
        hipGetDevice(&dev); hipDeviceGetAttribute(&cus, hipDeviceAttributeMultiprocessorCount, dev);
        hipFuncSetAttribute((const void*)fwd_megakernel, hipFuncAttributeMaxDynamicSharedMemorySize, LDS_BYTES);
        hipOccupancyMaxActiveBlocksPerMultiprocessor(&per_cu, (const void*)fwd_megakernel, NTHREADS, LDS_BYTES);
        (void)hipGetLastError();
        if (per_cu < 1) { fprintf(stderr, "kernel_launch: occupancy query says %d blocks per CU\n", per_cu); per_cu = 1; }
        grid = cus;
    }
    if (grid < 0) return;
    hipMemsetAsync((char*)d_ws + WS_CTL, 0, CTL_BYTES, stream);
    Params p{};
    for (int i = 0; i < 26; ++i) p.in[i] = (const float*)d_in[i];
    p.out = (float*)d_out; p.ws = (unsigned char*)d_ws;
#if MK_SPLIT
    for (int ph = 0; ph < NPHASE; ++ph) { p.ph_lo = ph; p.ph_hi = ph + 1; hipLaunchKernelGGL(fwd_megakernel, dim3(grid), dim3(NTHREADS), LDS_BYTES, stream, p); }
#else
    p.ph_lo = 0; p.ph_hi = NPHASE;
    void* args[] = {&p};
    hipError_t e = hipLaunchCooperativeKernel((const void*)fwd_megakernel, dim3(grid), dim3(NTHREADS), args, LDS_BYTES, stream);
    if (e != hipSuccess) fprintf(stderr, "cooperative launch failed: %s (grid %d)\n", hipGetErrorString(e), grid);
#endif
}
```
